# Optimizing an MI355X kernel written in HIP

```python
import math, functools
import jax, jax.numpy as jnp
from jax import lax
import numpy as np

D_MODEL = 1024
BATCH = 4
SEQ = 8192
DEPTH = 4
DEC_BATCH = 16
DEC_SEQ = 4096
PAST_LEN = 128

N_META = 16
N_MIXERS = 2
N_HYENA_LAYERS = (DEPTH + 1) // 2
N_ATTN_LAYERS = DEPTH // 2
HYENA_ORDER = 2
SHORT_CONV = 3
FILTER_EMB = 33
FILTER_HIDDEN = 64
FILTER_BANDS = (FILTER_EMB - 1) // 2
DECAY_TARGET = 1e-2
FAST_DECAY_PCT = 0.3
SLOW_DECAY_PCT = 1.5
FILTER_OUT_SCALE = 0.02
N_HEADS = 16
N_KV_HEADS = 4
HEAD_DIM = D_MODEL // N_HEADS
GROUP = N_HEADS // N_KV_HEADS
WINDOW = 128
BLOCK = 128
REL_BUCKETS = 32
REL_MAX_DIST = 128
D_FF = 4 * D_MODEL
EPS = 1e-6
NEG = -1e30

kernel_name = 'hybrid_hyena_swa_encoder'


def _rmsnorm(x, g):
    xf = x.astype(jnp.float32)
    xf = xf * lax.rsqrt(jnp.mean(xf * xf, axis=-1, keepdims=True) + EPS)
    return xf.astype(x.dtype) * g


def _short_conv(u, w, b):
    up = jnp.pad(u, ((0, 0), (1, 1), (0, 0)))
    return up[:, :-2] * w[0] + up[:, 1:-1] * w[1] + up[:, 2:] * w[2] + b


def _hyena_filters(L, f_w1, f_b1, f_freq1, f_w2, f_b2, f_freq2, f_w3):
    t = jnp.linspace(0.0, 1.0, L, dtype=jnp.float32)[:, None]
    w = (2.0 * math.pi / L) * jnp.arange(L, dtype=jnp.float32)[:, None]
    f = jnp.linspace(1e-4, FILTER_BANDS - 1, FILTER_BANDS, dtype=jnp.float32)[None, :]
    z = jnp.concatenate([t, jnp.cos(f * w), -jnp.sin(f * w)], axis=-1).astype(f_w1.dtype)
    h = jnp.sin(f_freq1 * (z @ f_w1 + f_b1))
    h = jnp.sin(f_freq2 * (h @ f_w2 + f_b2))
    k = (h @ f_w3).astype(jnp.float32).reshape(L, HYENA_ORDER, 2, D_MODEL)
    max_decay = math.log(DECAY_TARGET) / FAST_DECAY_PCT
    min_decay = math.log(DECAY_TARGET) / SLOW_DECAY_PCT
    deltas = jnp.abs(jnp.linspace(min_decay, max_decay, D_MODEL, dtype=jnp.float32))
    decay = jnp.exp(-t * deltas)
    return k * decay[:, None, None, :]


def _bidir_long_conv(u, k_fwd, k_bwd, skip):
    B, L, D = u.shape
    n_fft = 2 * L
    kern = jnp.concatenate([k_fwd, jnp.zeros((1, D), k_fwd.dtype), k_bwd[:0:-1]], axis=0)
    kf = jnp.fft.rfft(kern, n=n_fft, axis=0)
    uf32 = u.astype(jnp.float32)
    uf = jnp.fft.rfft(uf32, n=n_fft, axis=1)
    y = jnp.fft.irfft(uf * kf[None], n=n_fft, axis=1)[:, :L]
    return (y + uf32 * skip.astype(jnp.float32)).astype(u.dtype)


def _hyena_mixer(xn, w_in, conv_w, conv_b, f_w1, f_b1, f_freq1, f_w2, f_b2, f_freq2, f_w3, skip, w_out):
    L = xn.shape[1]
    u = _short_conv(xn @ w_in, conv_w, conv_b)
    x1, x2, v = jnp.split(u, 3, axis=-1)
    filt = _hyena_filters(L, f_w1, f_b1, f_freq1, f_w2, f_b2, f_freq2, f_w3)
    z = v
    for o, gate in enumerate((x1, x2)):
        z = gate * _bidir_long_conv(z, filt[:, o, 0], filt[:, o, 1], skip[o])
    return z @ w_out


def _t5_bucket(rel):
    half = REL_BUCKETS // 2
    max_exact = half // 2
    n = jnp.abs(rel)
    large = max_exact + (jnp.log(jnp.maximum(n, 1).astype(jnp.float32) / max_exact)
                         / math.log(REL_MAX_DIST / max_exact) * (half - max_exact)).astype(jnp.int32)
    large = jnp.minimum(large, half - 1)
    return jnp.where(rel > 0, half, 0) + jnp.where(n < max_exact, n, large)


def _swa_mixer(xn, w_qkv, q_gain, k_gain, sink, w_out, rel_bias):
    B, L, _ = xn.shape
    nb = -(-L // BLOCK)
    Lp = nb * BLOCK
    qkv = xn @ w_qkv
    q, k, v = jnp.split(qkv, [N_HEADS * HEAD_DIM, (N_HEADS + N_KV_HEADS) * HEAD_DIM], axis=-1)
    q = _rmsnorm(q.reshape(B, L, N_KV_HEADS, GROUP, HEAD_DIM), q_gain) * (HEAD_DIM ** -0.5)
    k = _rmsnorm(k.reshape(B, L, N_KV_HEADS, HEAD_DIM), k_gain)
    v = v.reshape(B, L, N_KV_HEADS, HEAD_DIM)

    q_pos = jnp.arange(Lp, dtype=jnp.int32).reshape(nb, BLOCK)
    k_pos = (jnp.arange(nb, dtype=jnp.int32) * BLOCK - BLOCK)[:, None] + jnp.arange(3 * BLOCK, dtype=jnp.int32)[None, :]
    kp3 = k_pos[:, None, :]
    band_ok = (jnp.abs(kp3 - q_pos[:, :, None]) <= WINDOW) & (kp3 >= N_META) & (kp3 < L)
    band_rel = jnp.arange(3 * BLOCK, dtype=jnp.int32)[None, :] - BLOCK - jnp.arange(BLOCK, dtype=jnp.int32)[:, None]
    band_bias = rel_bias[_t5_bucket(band_rel)].astype(jnp.float32).transpose(2, 0, 1).reshape(
        N_KV_HEADS, GROUP, BLOCK, 3 * BLOCK)
    meta_rel = jnp.arange(N_META, dtype=jnp.int32)[None, None, :] - q_pos[:, :, None]
    meta_bias = rel_bias[_t5_bucket(meta_rel)].astype(jnp.float32).transpose(0, 3, 1, 2).reshape(
        nb, N_KV_HEADS, GROUP, BLOCK, N_META)
    sink_logit = jnp.broadcast_to(sink.astype(jnp.float32).reshape(1, N_KV_HEADS, GROUP, 1, 1),
                                  (nb, N_KV_HEADS, GROUP, BLOCK, 1))

    def one_sequence(qkv_one):
        q1, k1, v1 = qkv_one
        qb = jnp.pad(q1, ((0, Lp - L), (0, 0), (0, 0), (0, 0))).reshape(nb, BLOCK, N_KV_HEADS, GROUP, HEAD_DIM)
        pad = ((BLOCK, Lp - L + BLOCK), (0, 0), (0, 0))
        kp = jnp.pad(k1, pad).reshape(nb + 2, BLOCK, N_KV_HEADS, HEAD_DIM)
        vp = jnp.pad(v1, pad).reshape(nb + 2, BLOCK, N_KV_HEADS, HEAD_DIM)
        kb = jnp.concatenate([kp[:-2], kp[1:-1], kp[2:]], axis=1)
        vb = jnp.concatenate([vp[:-2], vp[1:-1], vp[2:]], axis=1)
        km, vm = k1[:N_META], v1[:N_META]
        s_meta = jnp.einsum('nqhgd,mhd->nhgqm', qb, km).astype(jnp.float32) + meta_bias
        s_band = jnp.einsum('nqhgd,nshd->nhgqs', qb, kb).astype(jnp.float32) + band_bias
        s_band = jnp.where(band_ok[:, None, None], s_band, NEG)
        p = jax.nn.softmax(jnp.concatenate([s_meta, s_band, sink_logit], axis=-1), axis=-1).astype(v1.dtype)
        o = (jnp.einsum('nhgqm,mhd->nqhgd', p[..., :N_META], vm)
             + jnp.einsum('nhgqs,nshd->nqhgd', p[..., N_META:N_META + 3 * BLOCK], vb))
        return o.reshape(Lp, N_HEADS * HEAD_DIM)[:L]

    o = lax.map(one_sequence, (q, k, v))
    return o @ w_out


def _sqrelu_mlp(xn, w_up, w_down):
    return jnp.square(jax.nn.relu(xn @ w_up)) @ w_down


def _trunk(x, meta_tokens, rel_bias, mix_norm, mlp_norm,
           hy_w_in, hy_conv_w, hy_conv_b, hy_f_w1, hy_f_b1, hy_f_freq1, hy_f_w2, hy_f_b2, hy_f_freq2,
           hy_f_w3, hy_skip, hy_w_out, at_w_qkv, at_q_norm, at_k_norm, at_sink, at_w_out,
           mlp_w_up, mlp_w_down):
    B = x.shape[0]
    meta = jnp.broadcast_to(meta_tokens[None].astype(x.dtype), (B, N_META, D_MODEL))
    h = jnp.concatenate([meta, x], axis=1)
    for i in range(DEPTH):
        j = i // N_MIXERS
        hn = _rmsnorm(h, mix_norm[i])
        if i % N_MIXERS == 0:
            h = h + _hyena_mixer(hn, hy_w_in[j], hy_conv_w[j], hy_conv_b[j], hy_f_w1[j], hy_f_b1[j],
                                 hy_f_freq1[j], hy_f_w2[j], hy_f_b2[j], hy_f_freq2[j], hy_f_w3[j],
                                 hy_skip[j], hy_w_out[j])
        else:
            h = h + _swa_mixer(hn, at_w_qkv[j], at_q_norm[j], at_k_norm[j], at_sink[j], at_w_out[j], rel_bias)
        h = h + _sqrelu_mlp(_rmsnorm(h, mlp_norm[i]), mlp_w_up[i], mlp_w_down[i])
    return h[:, N_META:]


def setup_inputs(seed: int = 0) -> dict:
    key = jax.random.key(seed)
    ks = iter(jax.random.split(key, 32))

    def nrm(shape, scale):
        return scale * jax.random.normal(next(ks), shape, jnp.float32)

    def gain(shape):
        return 1.0 + 0.1 * jax.random.normal(next(ks), shape, jnp.float32)

    NH, NA, D = N_HYENA_LAYERS, N_ATTN_LAYERS, D_MODEL
    qkv_cols = (N_HEADS + 2 * N_KV_HEADS) * HEAD_DIM
    return {
        'x_prompt': nrm((BATCH, SEQ, D), 1.0),
        'x_sample': nrm((DEC_BATCH, DEC_SEQ, D), 1.0),
        'meta_tokens': nrm((N_META, D), 1.0),
        'rel_bias': nrm((REL_BUCKETS, N_HEADS), 0.5),
        'mix_norm': gain((DEPTH, D)),
        'mlp_norm': gain((DEPTH, D)),
        'hy_w_in': nrm((NH, D, 3 * D), D ** -0.5),
        'hy_conv_w': nrm((NH, SHORT_CONV, 3 * D), SHORT_CONV ** -0.5),
        'hy_conv_b': nrm((NH, 3 * D), 0.02),
        'hy_f_w1': nrm((NH, FILTER_EMB, FILTER_HIDDEN), FILTER_EMB ** -0.5),
        'hy_f_b1': nrm((NH, FILTER_HIDDEN), 0.1),
        'hy_f_freq1': gain((NH, FILTER_HIDDEN)),
        'hy_f_w2': nrm((NH, FILTER_HIDDEN, FILTER_HIDDEN), FILTER_HIDDEN ** -0.5),
        'hy_f_b2': nrm((NH, FILTER_HIDDEN), 0.1),
        'hy_f_freq2': gain((NH, FILTER_HIDDEN)),
        'hy_f_w3': nrm((NH, FILTER_HIDDEN, HYENA_ORDER * 2 * D), FILTER_OUT_SCALE * FILTER_HIDDEN ** -0.5),
        'hy_skip': nrm((NH, HYENA_ORDER, D), 0.1),
        'hy_w_out': nrm((NH, D, D), D ** -0.5),
        'at_w_qkv': nrm((NA, D, qkv_cols), D ** -0.5),
        'at_q_norm': gain((NA, HEAD_DIM)),
        'at_k_norm': gain((NA, HEAD_DIM)),
        'at_sink': nrm((NA, N_HEADS), 1.0),
        'at_w_out': nrm((NA, N_HEADS * HEAD_DIM, D), (N_HEADS * HEAD_DIM) ** -0.5),
        'mlp_w_up': nrm((DEPTH, D, D_FF), D ** -0.5),
        'mlp_w_down': nrm((DEPTH, D_FF, D), D_FF ** -0.5),
    }


def reference(x_prompt, x_sample, meta_tokens, rel_bias, mix_norm, mlp_norm,
              hy_w_in, hy_conv_w, hy_conv_b, hy_f_w1, hy_f_b1, hy_f_freq1, hy_f_w2, hy_f_b2, hy_f_freq2,
              hy_f_w3, hy_skip, hy_w_out, at_w_qkv, at_q_norm, at_k_norm, at_sink, at_w_out,
              mlp_w_up, mlp_w_down):
    trunk = functools.partial(
        _trunk, meta_tokens=meta_tokens, rel_bias=rel_bias, mix_norm=mix_norm, mlp_norm=mlp_norm,
        hy_w_in=hy_w_in, hy_conv_w=hy_conv_w, hy_conv_b=hy_conv_b, hy_f_w1=hy_f_w1, hy_f_b1=hy_f_b1,
        hy_f_freq1=hy_f_freq1, hy_f_w2=hy_f_w2, hy_f_b2=hy_f_b2, hy_f_freq2=hy_f_freq2, hy_f_w3=hy_f_w3,
        hy_skip=hy_skip, hy_w_out=hy_w_out, at_w_qkv=at_w_qkv, at_q_norm=at_q_norm, at_k_norm=at_k_norm,
        at_sink=at_sink, at_w_out=at_w_out, mlp_w_up=mlp_w_up, mlp_w_down=mlp_w_down)
    y_prompt = trunk(x_prompt)
    y_sample = trunk(x_sample)
    return (y_prompt, y_sample)
```

```cpp
#include <hip/hip_runtime.h>
#include <hip/hip_cooperative_groups.h>
#include <cstdio>
#include <cstdint>
namespace cg = cooperative_groups;

#define LAS __attribute__((address_space(3)))
typedef unsigned short bf16_t;
typedef short bf16x8 __attribute__((ext_vector_type(8)));
typedef float f32x4 __attribute__((ext_vector_type(4)));
typedef float f32x2 __attribute__((ext_vector_type(2)));
typedef unsigned u32x4 __attribute__((ext_vector_type(4)));
typedef unsigned u32x2 __attribute__((ext_vector_type(2)));
typedef __bf16 bf16x2_t __attribute__((ext_vector_type(2)));
typedef unsigned long long u64;
typedef unsigned long long u64x2 __attribute__((ext_vector_type(2)));
constexpr float SS_SCALE = 1048576.0f, SS_INV = 1.0f / (1048576.0f * 1024.0f);
__device__ __forceinline__ float ss_rinv(u64 v) { return __builtin_amdgcn_rsqf((float)v * SS_INV + 1e-6f); }

constexpr int DM = 1024, DFF = 4096;
constexpr int L_P = 8208, L_S = 4112;
constexpr int LS_P = 8256, LS_S = 4160, XPAD = 48;
constexpr int ROWS_P = 32768, ROWS_MAIN = 98304, MREAL = 98624, MPAD = 98816;
constexpr int MT_ALL = MPAD / 256;
constexpr int MT_H0 = 192, MT_H1 = MT_ALL - MT_H0;
constexpr float EPS = 1e-6f;

constexpr size_t MiB = 1u << 20;
constexpr size_t WS_ROWSS = 1 * MiB;
constexpr size_t WS_METAH = 8 * MiB;
constexpr size_t WS_H2T = 10 * MiB;
constexpr size_t WS_W = 17 * MiB;
constexpr size_t WS_FK = 107 * MiB;
constexpr size_t WS_P = 211 * MiB;
constexpr size_t WS_R1 = 404 * MiB, WS_R2 = 599 * MiB, WS_R3 = 794 * MiB, WS_END = 989 * MiB;
constexpr size_t WS_VT = 703 * MiB;
constexpr size_t W_IN = 0, W_HOUT = 12 * MiB, W_QKV = 16 * MiB, W_AOUT = 22 * MiB, W_UP = 26 * MiB, W_DN = 58 * MiB;
constexpr int H2N = 12320;
constexpr int FK_OFFS_P = 8704, FK_LEN_P = 17408, FK_OFFS_S = 4608, FK_LEN_S = 9216;
constexpr size_t FK_SAMPLE_OFF = (size_t)2 * 1024 * FK_LEN_P;

struct Args { const float* in[25]; float* out; unsigned char* ws; int layer_lo, layer_hi; };

__device__ __forceinline__ unsigned cvtpk(float lo, float hi) { f32x2 v = {lo, hi}; bf16x2_t b = __builtin_convertvector(v, bf16x2_t); return __builtin_bit_cast(unsigned, b); }
__device__ __forceinline__ float bf2f(unsigned short x) { return __builtin_bit_cast(float, (unsigned)x << 16); }
__device__ __forceinline__ float bflo(unsigned x) { return __builtin_bit_cast(float, x << 16); }
__device__ __forceinline__ float bfhi(unsigned x) { return __builtin_bit_cast(float, x & 0xffff0000u); }
__device__ __forceinline__ int ltid() { int t = threadIdx.x; asm volatile("" : "+v"(t)); return t; }
__device__ __forceinline__ int lsg(int x) { asm volatile("" : "+s"(x)); return x; }
__device__ __forceinline__ int seq_L(int s) { return s < 4 ? L_P : L_S; }
__device__ __forceinline__ int seq_LS(int s) { return s < 4 ? LS_P : LS_S; }
__device__ __forceinline__ size_t seq_off_ch(int s) { return s < 4 ? (size_t)s * 1024 * LS_P : (size_t)4 * 1024 * LS_P + (size_t)(s - 4) * 1024 * LS_S; }
__device__ __forceinline__ int seq_row(int s, int p) { return p < 16 ? ROWS_MAIN + 16 * s + p : (s < 4 ? s * 8192 : 32768 + (s - 4) * 4096) + p - 16; }
__device__ __forceinline__ void row_decode(int row0, int& s, int& p0, int& L) {
    if (row0 < ROWS_P) { s = row0 >> 13; p0 = 16 + (row0 & 8191); L = L_P; }
    else if (row0 < ROWS_MAIN) { const int r = row0 - ROWS_P; s = 4 + (r >> 12); p0 = 16 + (r & 4095); L = L_S; }
    else { const int r = row0 - ROWS_MAIN; s = r >> 4; p0 = r & 15; L = s < 4 ? L_P : L_S; }
}
__device__ __forceinline__ float wave_sum(float v) {
#pragma unroll
    for (int o = 1; o < 64; o <<= 1) v += __shfl_xor(v, o);
    return v;
}
__device__ __forceinline__ void my_sincos(float x, float& s, float& c) {
    const float k = rintf(x * 0.636619772367581f);
    float r = fmaf(-k, 1.57079625129699707031f, x);
    r = fmaf(-k, 7.54978941586159635335e-08f, r);
    r = fmaf(-k, 5.39030285815811905290e-15f, r);
    const float r2 = r * r;
    const float sp = r + r * r2 * (-1.6666654611e-1f + r2 * (8.3321608736e-3f + r2 * -1.9515295891e-4f));
    const float cp = 1.0f - 0.5f * r2 + r2 * r2 * (4.166664568298827e-2f + r2 * (-1.388731625493765e-3f + r2 * 2.443315711809948e-5f));
    const int n = ((int)k) & 3;
    s = (n == 0) ? sp : (n == 1) ? cp : (n == 2) ? -sp : -cp;
    c = (n == 0) ? cp : (n == 1) ? -sp : (n == 2) ? -cp : sp;
}
__device__ __forceinline__ float my_sin(float x) { float s, c; my_sincos(x, s, c); return s; }
__device__ __forceinline__ int t5_bucket(int rel) {
    const int n = rel < 0 ? -rel : rel; int b;
    if (n < 8) b = n; else if (n < 12) b = 8; else if (n < 16) b = 9; else if (n < 23) b = 10; else if (n < 32) b = 11;
    else if (n < 46) b = 12; else if (n < 64) b = 13; else if (n < 91) b = 14; else b = 15;
    return (rel > 0 ? 16 : 0) + b;
}

namespace pg8 {
#define PG8_LAS __attribute__((address_space(3)))
constexpr int BM = 256, BK = 64, HALF = 128, HTB = HALF * BK * 2, STAGE_BYTES = 8 * HTB, NXCD = 8, WGM = 8;
__host__ __device__ __forceinline__ int lds_byte(int r, int c) { const int st = (r >> 4) * 2 + (c >> 5), rr = r & 15, cc = c & 31, ob = rr * 64 + cc * 2; return st * 1024 + (ob ^ (((ob >> 9) & 1) << 5)); }
__host__ __device__ __forceinline__ void stage_rc(int b, int& R, int& C) { const int st = b / 1024, sb = b % 1024, swz = sb ^ (((sb >> 9) & 1) << 5); R = (st >> 1) * 16 + swz / 64; C = (st & 1) * 32 + (swz % 64) / 2; }
__host__ __device__ __forceinline__ int perm32(int rho) { const int n = rho >> 4, i = rho & 15; return 8 * (i >> 2) + 4 * n + (i & 3); }
struct Unit { int pm, pn, ks; };
struct Gemm { const bf16_t* A; const bf16_t* Bt; int M, N, K; int lda, ldb; };
struct StaticOrder {
    int nM, nN, nwg, G, c, KS;
    __host__ __device__ void init(int M, int N, int G_, int c_) { nM = M / BM; nN = N / BM; nwg = nM * nN; G = G_; c = c_; KS = 1; }
    __host__ __device__ void init_ks(int M, int N, int KS_, int G_, int c_) { nM = M / BM; nN = N / BM; KS = KS_; nwg = nM * nN * KS; G = G_; c = c_; }
    __host__ __device__ bool next(int i, Unit& u) const {
        const long L = (long)i * G + c; if (L >= nwg) return false;
        u.ks = 0;
        if (KS > 1) { const int l = (int)L; u.ks = l % KS; const int t = l / KS; u.pm = t % nM; u.pn = t / nM; return true; }
        int wgid = (int)L; { const int q = nwg / NXCD, r = nwg % NXCD, xcd = wgid % NXCD, off = wgid / NXCD; wgid = (xcd < r ? xcd * (q + 1) : r * (q + 1) + (xcd - r) * q) + off; }
        const int nig = WGM * nN, gid = wgid / nig, fm = gid * WGM, gsz = (nM - fm) < WGM ? (nM - fm) : WGM;
        u.pm = fm + ((wgid % nig) % gsz); u.pn = (wgid % nig) / gsz; return true;
    }
};

template <class Epi, bool ALIGN_EPI = true>
__device__ __forceinline__ void gemm_phase(PG8_LAS unsigned char* lds, const Gemm g, const StaticOrder& S, const Epi& E) {
    const int tid = ltid(), wid = __builtin_amdgcn_readfirstlane(tid >> 6), lane = tid & 63, wr = wid >> 2, wc = wid & 3, fr = lane & 15, fq = lane >> 4;
    const int K = g.K, nt = K / BK;
    unsigned voffA[2], voffB[2];
#pragma unroll
    for (int i = 0; i < 2; ++i) { int R, C; stage_rc(tid * 16 + i * 8192, R, C); const int Rb = Epi::PERM ? ((R & ~31) + perm32(R & 31)) : R;
        voffA[i] = (unsigned)(R * g.lda + C) * 2u; voffB[i] = (unsigned)(Rb * g.ldb + C) * 2u; }
    const size_t kstep = (size_t)(BK * 2);
    const size_t hstepA = (size_t)HALF * g.lda * 2, hstepB = (size_t)HALF * g.ldb * 2;
    const size_t tstepA = 2 * hstepA, tstepB = 2 * hstepB, ksA = (size_t)K * 2;
    const unsigned ldsw = (unsigned)wid * 1024u;
    const int aoff = lds_byte(wr * 64 + fr, fq * 8), boff = lds_byte(wc * 32 + fr, fq * 8);
#define PG8_SA(b, h) (((b) * 2 + (h)) * HTB)
#define PG8_SB(b, h) ((4 + (b) * 2 + (h)) * HTB)
#define PG8_STAGE(bufoff, gbase, voff) do { _Pragma("unroll") for (int _i = 0; _i < 2; ++_i) \
        __builtin_amdgcn_global_load_lds((const unsigned*)((const char*)(gbase) + (voff)[_i]), (PG8_LAS unsigned*)(lds + (bufoff) + ldsw + _i * 8192), 16, 0, 0); } while (0)
#define PG8_LDA(dst, b, h) do { _Pragma("unroll") for (int m = 0; m < 4; ++m) _Pragma("unroll") for (int k = 0; k < 2; ++k) dst[m][k] = *(const PG8_LAS bf16x8*)(lds + PG8_SA(b, h) + aoff + m * 2048 + k * 1024); } while (0)
#define PG8_LDB(dst, b, h) do { _Pragma("unroll") for (int n = 0; n < 2; ++n) _Pragma("unroll") for (int k = 0; k < 2; ++k) dst[n][k] = *(const PG8_LAS bf16x8*)(lds + PG8_SB(b, h) + boff + n * 2048 + k * 1024); } while (0)
#define PG8_MMA(ai, bj, At, Bt) do { __builtin_amdgcn_s_setprio(1); _Pragma("unroll") for (int m = 0; m < 4; ++m) _Pragma("unroll") for (int n = 0; n < 2; ++n) _Pragma("unroll") for (int k = 0; k < 2; ++k) \
        acc[ai][bj][m][n] = Epi::SWAP ? __builtin_amdgcn_mfma_f32_16x16x32_bf16(Bt[n][k], At[m][k], acc[ai][bj][m][n], 0, 0, 0) \
                                      : __builtin_amdgcn_mfma_f32_16x16x32_bf16(At[m][k], Bt[n][k], acc[ai][bj][m][n], 0, 0, 0); __builtin_amdgcn_s_setprio(0); } while (0)
#define PG8_WAIT_V(n) asm volatile("s_waitcnt vmcnt(" #n ")" ::: "memory")
#define PG8_WAIT_L(n) asm volatile("s_waitcnt lgkmcnt(" #n ")" ::: "memory")
#define PG8_BAR __builtin_amdgcn_s_barrier()
#define PG8_SCHED __builtin_amdgcn_sched_barrier(0)
    Unit cur, nxt; int ui = 0;
    if (!S.next(0, cur)) return;
    f32x4 acc[2][2][4][2];
#pragma unroll
    for (int a = 0; a < 2; ++a)
#pragma unroll
        for (int b = 0; b < 2; ++b)
#pragma unroll
            for (int m = 0; m < 4; ++m)
#pragma unroll
                for (int n = 0; n < 2; ++n) acc[a][b][m][n] = (f32x4){0.f, 0.f, 0.f, 0.f};
    bf16x8 At[4][2], B0[2][2], B1[2][2];
    const char* cA = (const char*)g.A + (size_t)cur.pm * tstepA + (size_t)cur.ks * ksA; const char* cB = (const char*)g.Bt + (size_t)cur.pn * tstepB + (size_t)cur.ks * ksA;
    PG8_STAGE(PG8_SB(0, 0), cB, voffB); PG8_STAGE(PG8_SB(0, 1), cB + hstepB, voffB); PG8_STAGE(PG8_SA(0, 0), cA, voffA); PG8_STAGE(PG8_SA(0, 1), cA + hstepA, voffA);
    if (wr == 1) PG8_BAR;
    PG8_WAIT_V(2); PG8_BAR;
    PG8_STAGE(PG8_SB(1, 0), cB + kstep, voffB); PG8_STAGE(PG8_SA(1, 0), cA + kstep, voffA); PG8_STAGE(PG8_SB(1, 1), cB + hstepB + kstep, voffB);
    PG8_WAIT_V(6); PG8_BAR;
    for (;;) {
        const bool has_next = S.next(ui + 1, nxt);
        const char* nA = has_next ? (const char*)g.A + (size_t)nxt.pm * tstepA + (size_t)nxt.ks * ksA : cA; const char* nB = has_next ? (const char*)g.Bt + (size_t)nxt.pn * tstepB + (size_t)nxt.ks * ksA : cB;
        for (int t = 0; t < nt; t += 2) {
            const bool last = (t == nt - 2);
            const char* a1 = cA + (size_t)(t + 1) * kstep;
            const char* a2 = last ? nA : cA + (size_t)(t + 2) * kstep; const char* b2 = last ? nB : cB + (size_t)(t + 2) * kstep;
            const char* a3 = a2 + kstep; const char* b3 = b2 + kstep;
            PG8_LDB(B0, 0, 0); PG8_LDB(B1, 0, 1); PG8_SCHED; PG8_LDA(At, 0, 0); PG8_STAGE(PG8_SA(1, 1), a1 + hstepA, voffA);
            PG8_WAIT_V(8); PG8_WAIT_L(0); PG8_BAR; PG8_MMA(0, 0, At, B0); PG8_MMA(0, 1, At, B1); PG8_BAR; PG8_SCHED;
            PG8_LDA(At, 0, 1); PG8_STAGE(PG8_SB(0, 0), b2, voffB); PG8_STAGE(PG8_SB(0, 1), b2 + hstepB, voffB); PG8_STAGE(PG8_SA(0, 0), a2, voffA);
            PG8_WAIT_V(8); PG8_WAIT_L(0); PG8_BAR; PG8_MMA(1, 0, At, B0); PG8_MMA(1, 1, At, B1); PG8_BAR; PG8_SCHED;
            PG8_LDB(B0, 1, 0); PG8_LDB(B1, 1, 1); PG8_SCHED; PG8_LDA(At, 1, 0); PG8_STAGE(PG8_SA(0, 1), a2 + hstepA, voffA);
            PG8_WAIT_V(8); PG8_WAIT_L(0); PG8_BAR; PG8_MMA(0, 0, At, B0); PG8_MMA(0, 1, At, B1); PG8_BAR; PG8_SCHED;
            PG8_LDA(At, 1, 1); PG8_STAGE(PG8_SB(1, 0), b3, voffB); PG8_STAGE(PG8_SB(1, 1), b3 + hstepB, voffB); PG8_STAGE(PG8_SA(1, 0), a3, voffA);
            PG8_WAIT_V(8); PG8_WAIT_L(0); PG8_BAR; PG8_MMA(1, 0, At, B0); PG8_MMA(1, 1, At, B1); PG8_BAR; PG8_SCHED;
        }
        if constexpr (ALIGN_EPI) { if (wr == 0) PG8_BAR; }
        E(acc, cur, wr, wc, fr, fq);
        if (!has_next) break;
#pragma unroll
        for (int a = 0; a < 2; ++a)
#pragma unroll
            for (int b = 0; b < 2; ++b)
#pragma unroll
                for (int m = 0; m < 4; ++m)
#pragma unroll
                    for (int n = 0; n < 2; ++n) acc[a][b][m][n] = (f32x4){0.f, 0.f, 0.f, 0.f};
        cur = nxt; cA = nA; cB = nB; ++ui;
        if constexpr (ALIGN_EPI) { if (wr == 1) PG8_BAR; }
    }
    PG8_WAIT_V(0);
    if constexpr (!ALIGN_EPI) { if (wr == 0) PG8_BAR; }
    PG8_BAR;
#undef PG8_SA
#undef PG8_SB
#undef PG8_STAGE
#undef PG8_LDA
#undef PG8_LDB
#undef PG8_MMA
#undef PG8_WAIT_V
#undef PG8_WAIT_L
#undef PG8_BAR
#undef PG8_SCHED
}
}

struct EpiHyIn {
    static constexpr bool PERM = false, SWAP = false;
    bf16_t* XT; const u64* rowss;
    __device__ __forceinline__ void operator()(const f32x4 (&acc)[2][2][4][2], const pg8::Unit& u, int wr, int wc, int fr, int fq) const {
        constexpr size_t REGION = (size_t)(WS_R2 - WS_R1) / 2;
#pragma unroll
        for (int ai = 0; ai < 2; ++ai)
#pragma unroll
            for (int m = 0; m < 4; ++m) {
                const int row0 = u.pm * 256 + ai * 128 + wr * 64 + m * 16;
                if (row0 >= MREAL) continue;
                const u64x2 s01 = *(const u64x2*)(rowss + row0 + 4 * fq), s23 = *(const u64x2*)(rowss + row0 + 4 * fq + 2);
                f32x4 ri; ri[0] = ss_rinv(s01[0]); ri[1] = ss_rinv(s01[1]); ri[2] = ss_rinv(s23[0]); ri[3] = ss_rinv(s23[1]);
                int s, p0, L; row_decode(row0, s, p0, L);
                const size_t so = seq_off_ch(s); const int LS = seq_LS(s);
#pragma unroll
                for (int bj = 0; bj < 2; ++bj)
#pragma unroll
                    for (int n = 0; n < 2; ++n) {
                        const int col = u.pn * 256 + bj * 128 + wc * 32 + n * 16 + fr;
                        const int part = col >> 10, ch = col & 1023;
                        const f32x4 v = acc[ai][bj][m][n] * ri;
                        u32x2 w; w.x = cvtpk(v[0], v[1]); w.y = cvtpk(v[2], v[3]);
                        *(u32x2*)(XT + (size_t)part * REGION + so + (size_t)ch * LS + XPAD + p0 + 4 * fq) = w;
                    }
            }
    }
};
template <int MODE> struct EpiRow {
    static constexpr bool PERM = true, SWAP = true;
    bf16_t* O; bf16_t* VT; const u64* rowss; int row_base;
    __device__ __forceinline__ void operator()(const f32x4 (&acc)[2][2][4][2], const pg8::Unit& u, int wr, int wc, int fr, int fq) const {
#pragma unroll
        for (int ai = 0; ai < 2; ++ai)
#pragma unroll
            for (int m = 0; m < 4; ++m) {
                const int lrow = u.pm * 256 + ai * 128 + wr * 64 + m * 16 + fr, grow = row_base + lrow;
                if (grow >= MREAL) continue;
                const float ri = ss_rinv(rowss[grow]);
#pragma unroll
                for (int bj = 0; bj < 2; ++bj) {
                    const int col0 = u.pn * 256 + bj * 128 + wc * 32 + 8 * fq;
                    f32x4 v0 = acc[ai][bj][m][0] * ri, v1 = acc[ai][bj][m][1] * ri;
                    if (MODE == 1) {
#pragma unroll
                        for (int i = 0; i < 4; ++i) { const float a = fmaxf(v0[i], 0.f), b = fmaxf(v1[i], 0.f); v0[i] = a * a; v1[i] = b * b; }
                        u32x4 w; w.x = cvtpk(v0[0], v0[1]); w.y = cvtpk(v0[2], v0[3]); w.z = cvtpk(v1[0], v1[1]); w.w = cvtpk(v1[2], v1[3]);
                        *(u32x4*)(O + (size_t)lrow * DFF + col0) = w;
                    } else {
                        if (col0 < 1280) {
                            u32x4 w; w.x = cvtpk(v0[0], v0[1]); w.y = cvtpk(v0[2], v0[3]); w.z = cvtpk(v1[0], v1[1]); w.w = cvtpk(v1[2], v1[3]);
                            *(u32x4*)(O + (size_t)grow * 1280 + col0) = w;
                        } else {
                            int s, p, L; row_decode(grow, s, p, L);
                            const int LS = seq_LS(s);
                            bf16_t* dst = VT + seq_off_ch(s) / 4 + (size_t)(col0 - 1280) * LS + XPAD + p;
#pragma unroll
                            for (int i = 0; i < 4; ++i) { dst[(size_t)i * LS] = (bf16_t)(cvtpk(v0[i], 0.f) & 0xffffu); dst[(size_t)(4 + i) * LS] = (bf16_t)(cvtpk(v1[i], 0.f) & 0xffffu); }
                        }
                    }
                }
            }
    }
};
struct EpiResid {
    static constexpr bool PERM = true, SWAP = true;
    const float* srcA; const float* srcB; const float* srcM; int meta_mask;
    float* dstMain; float* dstM; bf16_t* P; u64* rowss_next; int row_base;
    __device__ __forceinline__ void operator()(const f32x4 (&acc)[2][2][4][2], const pg8::Unit& u, int wr, int wc, int fr, int fq) const {
#pragma unroll
        for (int ai = 0; ai < 2; ++ai)
#pragma unroll
            for (int m = 0; m < 4; ++m) {
                const int grow = row_base + u.pm * 256 + ai * 128 + wr * 64 + m * 16 + fr;
                const bool ok = grow < MREAL;
                float ss = 0.f;
                if (ok) {
                    const float* src; float* dst;
                    if (grow < ROWS_P) { src = srcA + (size_t)grow * DM; dst = dstMain + (size_t)grow * DM; }
                    else if (grow < ROWS_MAIN) { src = srcB + (size_t)(grow - ROWS_P) * DM; dst = dstMain + (size_t)grow * DM; }
                    else { const int mr = grow - ROWS_MAIN; src = srcM + (size_t)(mr & meta_mask) * DM; dst = dstM + (size_t)mr * DM; }
#pragma unroll
                    for (int bj = 0; bj < 2; ++bj) {
                        const int col0 = u.pn * 256 + bj * 128 + wc * 32 + 8 * fq;
                        const f32x4 h0 = *(const f32x4*)(src + col0) + acc[ai][bj][m][0];
                        const f32x4 h1 = *(const f32x4*)(src + col0 + 4) + acc[ai][bj][m][1];
                        *(f32x4*)(dst + col0) = h0; *(f32x4*)(dst + col0 + 4) = h1;
                        if (P) { u32x4 w; w.x = cvtpk(h0[0], h0[1]); w.y = cvtpk(h0[2], h0[3]); w.z = cvtpk(h1[0], h1[1]); w.w = cvtpk(h1[2], h1[3]);
                            *(u32x4*)(P + (size_t)grow * DM + col0) = w; }
                        ss += (h0[0] * h0[0] + h0[1] * h0[1]) + (h0[2] * h0[2] + h0[3] * h0[3]) + (h1[0] * h1[0] + h1[1] * h1[1]) + (h1[2] * h1[2] + h1[3] * h1[3]);
                    }
                }
                ss += __shfl_xor(ss, 16); ss += __shfl_xor(ss, 32);
                if (ok && fq == 0 && rowss_next) atomicAdd(rowss_next + grow, (u64)(ss * SS_SCALE));
            }
    }
};

struct EpiPartial {
    static constexpr bool PERM = true, SWAP = true;
    float* PART;
    __device__ __forceinline__ void operator()(const f32x4 (&acc)[2][2][4][2], const pg8::Unit& u, int wr, int wc, int fr, int fq) const {
#pragma unroll
        for (int ai = 0; ai < 2; ++ai)
#pragma unroll
            for (int m = 0; m < 4; ++m) {
                const int lrow = u.pm * 256 + ai * 128 + wr * 64 + m * 16 + fr;
                float* dst = PART + ((size_t)u.ks * 512 + lrow) * DM + u.pn * 256 + wc * 32 + 8 * fq;
#pragma unroll
                for (int bj = 0; bj < 2; ++bj) { *(f32x4*)(dst + bj * 128) = acc[ai][bj][m][0]; *(f32x4*)(dst + bj * 128 + 4) = acc[ai][bj][m][1]; }
            }
    }
};
constexpr int DOWN_KS = 16;
__device__ __forceinline__ void meta_reduce(const float* PART, float* metah, bf16_t* P, u64* rowss_next, int gw, int NGW, int lane) {
    for (int lrow = gw; lrow < MREAL - ROWS_MAIN; lrow += NGW) {
        float ss = 0.f;
#pragma unroll
        for (int k = 0; k < 4; ++k) {
            const int col = k * 256 + lane * 4;
            f32x4 sum = *(const f32x4*)(metah + (size_t)lrow * DM + col);
#pragma unroll
            for (int ks = 0; ks < DOWN_KS; ++ks) sum += *(const f32x4*)(PART + ((size_t)ks * 512 + lrow) * DM + col);
            *(f32x4*)(metah + (size_t)lrow * DM + col) = sum;
            if (P) { u32x2 pk; pk.x = cvtpk(sum[0], sum[1]); pk.y = cvtpk(sum[2], sum[3]); *(u32x2*)(P + (size_t)(ROWS_MAIN + lrow) * DM + col) = pk; }
            ss += (sum[0] * sum[0] + sum[1] * sum[1]) + (sum[2] * sum[2] + sum[3] * sum[3]);
        }
        ss = wave_sum(ss);
        if (lane == 0 && rowss_next) rowss_next[ROWS_MAIN + lrow] = (u64)(ss * SS_SCALE);
    }
}

__device__ __forceinline__ void transpose_item(const float* W, const float* gain, int K, int N, bf16_t* WT, LAS float* scr, int item, int lane) {
    const int nblk = N / 32, kb = item / nblk, nb = item % nblk, k0 = 64 * kb, n0 = 32 * nb;
#pragma unroll 8
    for (int i = 0; i < 32; ++i) { const int kk = 2 * i + (lane >> 5); float v = W[(size_t)(k0 + kk) * N + n0 + (lane & 31)]; if (gain) v *= gain[k0 + kk]; scr[kk * 33 + (lane & 31)] = v; }
    asm volatile("s_waitcnt lgkmcnt(0)" ::: "memory");
    const int c = lane & 7;
#pragma unroll
    for (int j = 0; j < 4; ++j) { const int n = (lane >> 3) + 8 * j; const LAS float* s = scr + (8 * c) * 33 + n;
        u32x4 o; o.x = cvtpk(s[0 * 33], s[1 * 33]); o.y = cvtpk(s[2 * 33], s[3 * 33]); o.z = cvtpk(s[4 * 33], s[5 * 33]); o.w = cvtpk(s[6 * 33], s[7 * 33]);
        *(u32x4*)(WT + (size_t)(n0 + n) * K + k0 + 8 * c) = o; }
    asm volatile("s_waitcnt lgkmcnt(0)" ::: "memory");
}
__device__ __forceinline__ void convert_matrix(const float* W, const float* gain, int K, int N, bf16_t* WT, LAS float* scr, int gw, int NGW, int lane) {
    const int nitems = (K / 64) * (N / 32);
    for (int it = gw; it < nitems; it += NGW) transpose_item(W, gain, K, N, WT, scr, it, lane);
}

__device__ __forceinline__ void h2_features(LAS unsigned char* lds, const Args& a, int gtid, int tid) {
    LAS float* hs = (LAS float*)lds;
    float* H2T = (float*)(a.ws + WS_H2T);
    const int total = 2 * H2N;
    const int idx = gtid < total ? gtid : total - 1;
    const int j = idx / H2N, np = idx % H2N;
    const int L = np < L_P ? L_P : L_S, n = np < L_P ? np : np - L_P;
    const float* w1 = a.in[9] + j * 33 * 64; const float* b1 = a.in[10] + j * 64; const float* fr1 = a.in[11] + j * 64;
    const float* w2 = a.in[12] + j * 64 * 64; const float* b2 = a.in[13] + j * 64; const float* fr2 = a.in[14] + j * 64;
    const float t = (float)n * (1.0f / (float)(L - 1));
    const float w = (6.283185307179586f / (float)L) * (float)n;
    float acc[64];
#pragma unroll
    for (int m = 0; m < 64; ++m) acc[m] = b1[m] + t * w1[m];
    for (int e = 0; e < 16; ++e) {
        const float f = 1e-4f + (float)e * ((15.0f - 1e-4f) / 15.0f);
        float s, c; my_sincos(f * w, s, c);
        const float* wc = w1 + (1 + e) * 64; const float* wsn = w1 + (17 + e) * 64;
#pragma unroll
        for (int m = 0; m < 64; ++m) acc[m] = fmaf(c, wc[m], fmaf(-s, wsn[m], acc[m]));
    }
#pragma unroll
    for (int m = 0; m < 64; ++m) hs[m * 512 + tid] = my_sin(fr1[m] * acc[m]);
#pragma unroll
    for (int m = 0; m < 64; ++m) acc[m] = b2[m];
    for (int e = 0; e < 64; ++e) {
        const float h = hs[e * 512 + tid]; const float* wr_ = w2 + e * 64;
#pragma unroll
        for (int m = 0; m < 64; ++m) acc[m] = fmaf(h, wr_[m], acc[m]);
    }
    if (gtid < total) {
#pragma unroll
        for (int m = 0; m < 64; ++m) H2T[((size_t)j * H2N + np) * 64 + m] = my_sin(fr2[m] * acc[m]);
    }
}

__device__ __forceinline__ void split8(const f32x4 a, const f32x4 b, bf16x8& hi, bf16x8& lo) {
    u32x4 h, l;
    h.x = cvtpk(a[0], a[1]); h.y = cvtpk(a[2], a[3]); h.z = cvtpk(b[0], b[1]); h.w = cvtpk(b[2], b[3]);
    l.x = cvtpk(a[0] - bflo(h.x), a[1] - bfhi(h.x)); l.y = cvtpk(a[2] - bflo(h.y), a[3] - bfhi(h.y));
    l.z = cvtpk(b[0] - bflo(h.z), b[1] - bfhi(h.z)); l.w = cvtpk(b[2] - bflo(h.w), b[3] - bfhi(h.w));
    hi = __builtin_bit_cast(bf16x8, h); lo = __builtin_bit_cast(bf16x8, l);
}
__device__ __forceinline__ void fk_compute(const Args& a, int j, int gw, int NGW, int lane) {
    const float* H2 = (const float*)(a.ws + WS_H2T) + (size_t)j * H2N * 64;
    const float* w3 = a.in[15] + (size_t)j * 64 * 4096;
    const float* skip = a.in[16] + j * 2 * 1024;
    bf16_t* FK = (bf16_t*)(a.ws + WS_FK);
    const int n16 = lane & 15, g = lane >> 4;
#pragma unroll 1
    for (int it = gw; it < 2048; it += NGW) {
        const int pq = it & 3, cht = (it >> 2) & 63, dir = (it >> 8) & 1, o = (it >> 9) & 1, set = it >> 10;
        const int L = set ? L_S : L_P, offs = set ? FK_OFFS_S : FK_OFFS_P, len = set ? FK_LEN_S : FK_LEN_P, nbase = set ? L_P : 0;
        bf16_t* base = FK + (set ? FK_SAMPLE_OFF : 0);
        const int ch = cht * 16 + n16;
        bf16x8 Bh0, Bl0, Bh1, Bl1;
        {
            const float* wp = w3 + (o * 2 + dir) * 1024 + ch;
            f32x4 w0, w1, w2, w3v;
#pragma unroll
            for (int i = 0; i < 4; ++i) { w0[i] = wp[(size_t)(8 * g + i) * 4096]; w1[i] = wp[(size_t)(8 * g + 4 + i) * 4096];
                w2[i] = wp[(size_t)(32 + 8 * g + i) * 4096]; w3v[i] = wp[(size_t)(36 + 8 * g + i) * 4096]; }
            split8(w0, w1, Bh0, Bl0); split8(w2, w3v, Bh1, Bl1);
        }
        const float mind = -3.0701134573253944f, maxd = -15.350567286626972f;
        const float delta = fabsf(mind + (maxd - mind) * ((float)ch * (1.0f / 1023.0f)));
        const float skipv = skip[o * 1024 + ch];
        const float tinv = 1.0f / (float)(L - 1);
        bf16_t* rowp = base + ((size_t)o * 1024 + ch) * len;
        const int tq = offs / 64;
#pragma unroll 2
        for (int tile = pq * tq; tile < (pq + 1) * tq; ++tile) {
            const int n0 = tile * 16 + dir;
            const int nr = n0 + n16, nrc = nr < L ? nr : L - 1;
            const float* hp = H2 + (size_t)(nbase + nrc) * 64 + 8 * g;
            const f32x4 h0 = *(const f32x4*)hp, h1 = *(const f32x4*)(hp + 4), h2 = *(const f32x4*)(hp + 32), h3 = *(const f32x4*)(hp + 36);
            bf16x8 Ah0, Al0, Ah1, Al1; split8(h0, h1, Ah0, Al0); split8(h2, h3, Ah1, Al1);
            f32x4 acc = (f32x4){0.f, 0.f, 0.f, 0.f};
            acc = __builtin_amdgcn_mfma_f32_16x16x32_bf16(Al0, Bh0, acc, 0, 0, 0);
            acc = __builtin_amdgcn_mfma_f32_16x16x32_bf16(Al1, Bh1, acc, 0, 0, 0);
            acc = __builtin_amdgcn_mfma_f32_16x16x32_bf16(Ah0, Bl0, acc, 0, 0, 0);
            acc = __builtin_amdgcn_mfma_f32_16x16x32_bf16(Ah1, Bl1, acc, 0, 0, 0);
            acc = __builtin_amdgcn_mfma_f32_16x16x32_bf16(Ah0, Bh0, acc, 0, 0, 0);
            acc = __builtin_amdgcn_mfma_f32_16x16x32_bf16(Ah1, Bh1, acc, 0, 0, 0);
            float v[4];
#pragma unroll
            for (int ii = 0; ii < 4; ++ii) {
                const int n = n0 + 4 * g + ii;
                float x = acc[ii] * __expf(-((float)n * tinv) * delta);
                if (dir == 0 && n == 0) x += skipv;
                v[ii] = n < L ? x : 0.f;
            }
            u32x2 pk;
            if (dir == 0) { pk.x = cvtpk(v[0], v[1]); pk.y = cvtpk(v[2], v[3]); *(u32x2*)(rowp + offs + n0 + 4 * g) = pk; }
            else { pk.x = cvtpk(v[3], v[2]); pk.y = cvtpk(v[1], v[0]); *(u32x2*)(rowp + offs - (n0 + 4 * g + 3)) = pk; }
        }
    }
}

__device__ __forceinline__ u32x2 cld8(const void* p) { u32x2 v; asm volatile("global_load_dwordx2 %0, %1, off sc0 sc1\n\ts_waitcnt vmcnt(0)" : "=v"(v) : "v"(p) : "memory"); return v; }
__device__ __forceinline__ u32x4 cld16(const void* p) { u32x4 v; asm volatile("global_load_dwordx4 %0, %1, off sc0 sc1\n\ts_waitcnt vmcnt(0)" : "=v"(v) : "v"(p) : "memory"); return v; }
__device__ __forceinline__ unsigned short cld2(const void* p) { unsigned v; asm volatile("global_load_ushort %0, %1, off sc0 sc1\n\ts_waitcnt vmcnt(0)" : "=v"(v) : "v"(p) : "memory"); return (unsigned short)v; }
__device__ __forceinline__ f32x4 gate4(const bf16_t* xrow, int m, int L, float w0, float w1, float w2, float bb) {
    const u32x2 raw = *(const u32x2*)(xrow + m);
    const float x0 = bflo(raw.x), x1 = bfhi(raw.x), x2 = bflo(raw.y), x3 = bfhi(raw.y);
    const float xm = m > 0 ? bf2f(xrow[m - 1]) : 0.f, xp = (m + 4 < L) ? bf2f(xrow[m + 4]) : 0.f;
    f32x4 r;
    r[0] = w0 * xm + w1 * x0 + w2 * x1 + bb; r[1] = w0 * x0 + w1 * x1 + w2 * x2 + bb;
    r[2] = w0 * x1 + w1 * x2 + w2 * x3 + bb; r[3] = w0 * x2 + w1 * x3 + w2 * xp + bb;
    return r;
}
struct GateRaw { u32x2 raw; unsigned halo; };
__device__ __forceinline__ GateRaw gate_load(const bf16_t* xrow, int m, int L) {
    GateRaw r; r.raw = *(const u32x2*)(xrow + m);
    const unsigned xm = m > 0 ? (unsigned)xrow[m - 1] : 0u, xp = (m + 4 < L) ? (unsigned)xrow[m + 4] : 0u;
    r.halo = xm | (xp << 16); return r;
}
__device__ __forceinline__ f32x4 gate_eval(const GateRaw& gr, float w0, float w1, float w2, float bb) {
    const float x0 = bflo(gr.raw.x), x1 = bfhi(gr.raw.x), x2 = bflo(gr.raw.y), x3 = bfhi(gr.raw.y), xm = bflo(gr.halo), xp = bfhi(gr.halo);
    f32x4 r;
    r[0] = w0 * xm + w1 * x0 + w2 * x1 + bb; r[1] = w0 * x0 + w1 * x1 + w2 * x2 + bb;
    r[2] = w0 * x1 + w1 * x2 + w2 * x3 + bb; r[3] = w0 * x2 + w1 * x3 + w2 * xp + bb;
    return r;
}
template <int NQ, int NB, int L>
__device__ __forceinline__ void conv_unit(LAS unsigned char* lds, const Args& a, int j, int seq0, int c, int tid) {
    constexpr int QS = 64, GS = QS * NQ, WS = 4 * GS, PADL = 224;
    constexpr int LS = (NQ == 4) ? LS_P : LS_S;
    constexpr int LPD = (NQ == 4) ? 8720 : 4616;
    constexpr int OFFS = (NQ == 4) ? FK_OFFS_P : FK_OFFS_S, LEN = (NQ == 4) ? FK_LEN_P : FK_LEN_S;
    constexpr int S_LO = -QS * (NQ - 1), S_HI = ((L - 1) / 32) * 32;
    constexpr int U_OFF = 0, FKL_OFF = 77824, RED_OFF = 112640;
    static_assert(NB * LPD * 2 <= FKL_OFF && FKL_OFF + LEN * 2 <= RED_OFF, "conv LDS map");
    const int lane = tid & 63, w = __builtin_amdgcn_readfirstlane(tid >> 6);
    const bf16_t* X1 = (const bf16_t*)(a.ws + WS_R1); const bf16_t* X2 = (const bf16_t*)(a.ws + WS_R2); bf16_t* V = (bf16_t*)(a.ws + WS_R3);
    const bf16_t* FK = (const bf16_t*)(a.ws + WS_FK) + ((NQ == 4) ? 0 : FK_SAMPLE_OFF);
    const float* cw = a.in[7] + (size_t)j * 3 * 3072; const float* cb = a.in[8] + (size_t)j * 3072;
    constexpr int NF = (LEN / 8 + 511) / 512;
    u32x4 fkr[NF];
    {
        const u32x4* src = (const u32x4*)(FK + (size_t)c * LEN);
#pragma unroll
        for (int it = 0; it < NF; ++it) { const int i = it * 512 + tid; fkr[it] = src[i < LEN / 8 ? i : 0]; }
    }
    {
        const float w0 = cw[2048 + c], w1 = cw[3072 + 2048 + c], w2 = cw[2 * 3072 + 2048 + c], bb = cb[2048 + c];
        constexpr int NCH = LPD / 8, NIT = (NB * NCH + 511) / 512;
        u32x4 raws[NIT]; unsigned halos[NIT];
#pragma unroll
        for (int it = 0; it < NIT; ++it) {
            const int idx = it * 512 + tid; const int b = idx / NCH, ch = idx % NCH, p = ch * 8 - PADL;
            raws[it] = (u32x4){0u, 0u, 0u, 0u}; halos[it] = 0u;
            if (idx < NB * NCH && p >= 0 && p < L) {
                const bf16_t* row = V + seq_off_ch(seq0 + b) + (size_t)c * LS + XPAD + p;
                raws[it] = *(const u32x4*)row;
                const unsigned xm = p > 0 ? (unsigned)row[-1] : 0u, xp = (p + 8 < L) ? (unsigned)row[8] : 0u;
                halos[it] = xm | (xp << 16);
            }
        }
#pragma unroll
        for (int it = 0; it < NIT; ++it) {
            const int idx = it * 512 + tid; const int b = idx / NCH, ch = idx % NCH, p = ch * 8 - PADL;
            u32x4 o = {0u, 0u, 0u, 0u};
            if (p >= 0 && p < L) {
                const u32x4 raw = raws[it];
                float x[10];
                x[0] = bflo(halos[it]); x[9] = bfhi(halos[it]);
                x[1] = bflo(raw.x); x[2] = bfhi(raw.x); x[3] = bflo(raw.y); x[4] = bfhi(raw.y); x[5] = bflo(raw.z); x[6] = bfhi(raw.z); x[7] = bflo(raw.w); x[8] = bfhi(raw.w);
                float y[8];
#pragma unroll
                for (int i = 0; i < 8; ++i) y[i] = w0 * x[i] + w1 * x[i + 1] + w2 * x[i + 2] + bb;
                o.x = cvtpk(y[0], y[1]); o.y = cvtpk(y[2], y[3]); o.z = cvtpk(y[4], y[5]); o.w = cvtpk(y[6], y[7]);
            }
            if (idx < NB * NCH) *(LAS u32x4*)(lds + U_OFF + (b * LPD + ch * 8) * 2) = o;
        }
    }
    const int n = lane & 15, g = lane >> 4;
    const int q = (NQ == 4) ? (n >> 2) : (n >> 3), b = (NQ == 4) ? (n & 3) : (n & 7);
    const int ub = U_OFF + (b * LPD + PADL + QS * q + 8 * g) * 2;
    const int ubm = U_OFF + (b * LPD + PADL + 8 * g) * 2;
    const int pe = (1 + n) & 1;
    const int abr = FKL_OFF + (LEN - 1 - OFFS - n + 8 * g - pe) * 2;
    const unsigned sh = pe * 16;
    const int mw = 16 + WS * w;
    const int d_lo = mw - S_HI, d_hi = mw + 3 * GS - S_LO;
    const size_t xrow_off = seq_off_ch(seq0 + b) + (size_t)c * LS + XPAD;
#define ARAW(d, lagoff) do { const LAS unsigned* _p = (const LAS unsigned*)(lds + abr - (lagoff) * 2); d[0] = _p[0]; d[1] = _p[1]; d[2] = _p[2]; d[3] = _p[3]; d[4] = _p[4]; } while (0)
#define AFIN(dst, d) do { u32x4 _o; _o.x = __builtin_amdgcn_alignbit(d[1], d[0], sh); _o.y = __builtin_amdgcn_alignbit(d[2], d[1], sh); \
        _o.z = __builtin_amdgcn_alignbit(d[3], d[2], sh); _o.w = __builtin_amdgcn_alignbit(d[4], d[3], sh); dst = __builtin_bit_cast(bf16x8, _o); } while (0)
#define GATHER(dst, lagoff) do { unsigned _d[5]; ARAW(_d, lagoff); AFIN(dst, _d); } while (0)
#pragma unroll 1
    for (int o = 0; o < 2; ++o) {
#pragma unroll
        for (int it = 0; it < NF; ++it) { const int i = it * 512 + tid; const u32x4 v = fkr[it]; u32x4 r;
            r.x = __builtin_amdgcn_alignbit(v.w, v.w, 16); r.y = __builtin_amdgcn_alignbit(v.z, v.z, 16);
            r.z = __builtin_amdgcn_alignbit(v.y, v.y, 16); r.w = __builtin_amdgcn_alignbit(v.x, v.x, 16);
            if (i < LEN / 8) *(LAS u32x4*)(lds + FKL_OFF + (LEN / 8 - 1 - i) * 16) = r; }
        __syncthreads();
        if (o == 0) {
            const u32x4* src = (const u32x4*)(FK + ((size_t)1024 + c) * LEN);
#pragma unroll
            for (int it = 0; it < NF; ++it) { const int i = it * 512 + tid; fkr[it] = src[i < LEN / 8 ? i : 0]; }
        }
        f32x4 acc[4][4];
#pragma unroll
        for (int gi = 0; gi < 4; ++gi)
#pragma unroll
            for (int t = 0; t < 4; ++t) acc[gi][t] = (f32x4){0.f, 0.f, 0.f, 0.f};
        bf16x8 A0, A1, A2, A3, Bc[4], Bn[4];
        GATHER(A0, d_lo); GATHER(A1, d_lo + 16); GATHER(A2, d_lo + 32); GATHER(A3, d_lo + 48);
        int baddr = ub + 2 * (mw - d_lo);
#pragma unroll
        for (int gi = 0; gi < 4; ++gi) Bc[gi] = *(const LAS bf16x8*)(lds + baddr + 2 * GS * gi);
#define CONV_STEP(BCUR, BNXT, DL, CHECK) do { \
            unsigned r2[5], r3[5]; ARAW(r2, (DL) + 64); ARAW(r3, (DL) + 80); \
            baddr -= 64; \
            _Pragma("unroll") for (int gi = 0; gi < 4; ++gi) BNXT[gi] = *(const LAS bf16x8*)(lds + baddr + 2 * GS * gi); \
            __builtin_amdgcn_s_setprio(1); \
            _Pragma("unroll") for (int gi = 0; gi < 4; ++gi) { \
                const int s0 = mw + GS * gi - (DL); \
                if (!(CHECK) || ((s0 >= S_LO) && (s0 <= S_HI))) { \
                    acc[gi][0] = __builtin_amdgcn_mfma_f32_16x16x32_bf16(A0, BCUR[gi], acc[gi][0], 0, 0, 0); \
                    acc[gi][1] = __builtin_amdgcn_mfma_f32_16x16x32_bf16(A1, BCUR[gi], acc[gi][1], 0, 0, 0); \
                    acc[gi][2] = __builtin_amdgcn_mfma_f32_16x16x32_bf16(A2, BCUR[gi], acc[gi][2], 0, 0, 0); \
                    acc[gi][3] = __builtin_amdgcn_mfma_f32_16x16x32_bf16(A3, BCUR[gi], acc[gi][3], 0, 0, 0); \
                } \
            } \
            __builtin_amdgcn_s_setprio(0); \
            A0 = A2; A1 = A3; AFIN(A2, r2); AFIN(A3, r3); } while (0)
        const int dl_a = mw + 3 * GS - S_HI, dl_b = mw - S_LO;
        static_assert(((3 * GS / 32) % 2 == 0) && (((S_HI - S_LO - 3 * GS) / 32 + 1) % 2 == 1), "conv step-count parity");
#pragma unroll 1
        for (int dl = d_lo; dl < dl_a; dl += 64) { CONV_STEP(Bc, Bn, dl, true); CONV_STEP(Bn, Bc, dl + 32, true); }
#pragma unroll 1
        for (int dl = dl_a; dl < dl_b; dl += 64) { CONV_STEP(Bc, Bn, dl, false); CONV_STEP(Bn, Bc, dl + 32, false); }
        CONV_STEP(Bc, Bn, dl_b, false);
#pragma unroll 1
        for (int dl = dl_b + 32; dl <= d_hi; dl += 64) { CONV_STEP(Bn, Bc, dl, true); CONV_STEP(Bc, Bn, dl + 32, true); }
#undef CONV_STEP
        const bf16_t* X = (o == 0 ? X1 : X2) + xrow_off;
        const float w0 = cw[o * 1024 + c], w1 = cw[3072 + o * 1024 + c], w2 = cw[2 * 3072 + o * 1024 + c], bb = cb[o * 1024 + c];
        GateRaw gt[4][4];
        {
            const int mb = mw + QS * q + 4 * g; const bf16_t* Xb = X + mb;
#pragma unroll
            for (int gi = 0; gi < 4; ++gi)
#pragma unroll
                for (int t = 0; t < 4; ++t) { constexpr int dummy = 0; (void)dummy; const int off = GS * gi + 16 * t;
                    GateRaw r; r.raw = *(const u32x2*)(Xb + off);
                    const unsigned xm = (unsigned)Xb[off - 1]; unsigned xp = (unsigned)Xb[off + 4];
                    if (mb + off + 4 >= L) xp = 0u;
                    r.halo = xm | (xp << 16); gt[gi][t] = r; }
        }
        const GateRaw gtm = gate_load(X, 4 * g, L);
        f32x4 macc = (f32x4){0.f, 0.f, 0.f, 0.f};
#pragma unroll 1
        for (int t = w; t <= S_HI / 32; t += 8) {
            bf16x8 Am; GATHER(Am, -32 * t);
            const bf16x8 B = *(const LAS bf16x8*)(lds + ubm + t * 64);
            macc = __builtin_amdgcn_mfma_f32_16x16x32_bf16(Am, B, macc, 0, 0, 0);
        }
        *(LAS f32x4*)(lds + RED_OFF + (w * 64 + lane) * 16) = macc;
        __syncthreads();
        if (w == 0 && q == 0) {
            f32x4 s = (f32x4){0.f, 0.f, 0.f, 0.f};
#pragma unroll
            for (int ww = 0; ww < 8; ++ww) s += *(const LAS f32x4*)(lds + RED_OFF + (ww * 64 + lane) * 16);
            const int m = 4 * g;
            const f32x4 z = gate_eval(gtm, w0, w1, w2, bb) * s;
            u32x2 pk; pk.x = cvtpk(z[0], z[1]); pk.y = cvtpk(z[2], z[3]);
            if (o == 0) *(LAS u32x2*)(lds + U_OFF + (b * LPD + PADL + m) * 2) = pk;
            else *(u32x2*)(V + xrow_off + m) = pk;
        }
#pragma unroll
        for (int gi = 0; gi < 4; ++gi)
#pragma unroll
            for (int t = 0; t < 4; ++t) {
                const int m = mw + GS * gi + 16 * t + QS * q + 4 * g;
                const f32x4 z = gate_eval(gt[gi][t], w0, w1, w2, bb) * acc[gi][t];
                u32x2 pk; pk.x = cvtpk(z[0], z[1]); pk.y = cvtpk(z[2], z[3]);
                if (o == 0) *(LAS u32x2*)(lds + U_OFF + (b * LPD + PADL + m) * 2) = pk;
                else *(u32x2*)(V + xrow_off + m) = pk;
            }
        __syncthreads();
    }
#undef GATHER
#undef ARAW
#undef AFIN
}
__device__ __forceinline__ void conv_phase(LAS unsigned char* lds, const Args& a, int j, int bid, int G, int tid) {
#pragma unroll 1
    for (int u0 = bid; u0 < 3072; u0 += G) {
        const int u = u0;
        int tl = tid; asm volatile("" : "+v"(tl));
        if (u < 1024) conv_unit<4, 4, L_P>(lds, a, j, 0, u, tl);
        else { const int v = u - 1024; conv_unit<2, 8, L_S>(lds, a, j, 4 + 8 * (v & 1), v >> 1, tl); }
    }
}

__device__ __forceinline__ void transpose_phase(LAS unsigned char* lds, const Args& a, int bid, int G, int tid) {
    const bf16_t* ZT = (const bf16_t*)(a.ws + WS_R3); bf16_t* OUT = (bf16_t*)(a.ws + WS_R1);
    constexpr int TP = 129, TS = 65, UP = 4 * TP * 4, US = 16 * TS * 4, TILEB = 256 * 72 * 2;
#define TR_DECODE(u, s, p0, np, c0) do { int _cq, _tt; if ((u) < UP) { _cq = (u) & 3; const int _v = (u) >> 2; s = _v / TP; _tt = _v % TP; } \
        else { const int _r = (u) - UP; _cq = _r & 3; const int _v = _r >> 2; s = 4 + _v / TS; _tt = _v % TS; } \
        p0 = _tt == 0 ? 0 : 16 + 64 * (_tt - 1); np = _tt == 0 ? 16 : 64; c0 = _cq * 256; } while (0)
#define TR_LOAD(u) do { int _s, _p0, _np, _c0; TR_DECODE(u, _s, _p0, _np, _c0); const int _LS = seq_LS(_s), _nq = _np / 4; \
        const bf16_t* _src = ZT + seq_off_ch(_s) + (size_t)_c0 * _LS + XPAD + _p0; \
        _Pragma("unroll") for (int _k = 0; _k < 8; ++_k) { const int _task = _k * 512 + tid; const int _ch = _task / _nq, _pc = _task % _nq; \
            rg[_k] = (_task < 256 * _nq) ? *(const u32x2*)(_src + (size_t)_ch * _LS + 4 * _pc) : (u32x2){0u, 0u}; } } while (0)
    u32x2 rg[8];
    int u = bid, par = 0;
    if (u < UP + US) TR_LOAD(u);
#pragma unroll 1
    for (; u < UP + US; u += G, par ^= 1) {
        int s, p0, np, c0; TR_DECODE(u, s, p0, np, c0);
        const int nq = np / 4; LAS unsigned char* tile = lds + par * TILEB;
#pragma unroll
        for (int k = 0; k < 8; ++k) { const int task = k * 512 + tid; const int ch = task / nq, pc = task % nq;
            if (task < 256 * nq) *(LAS u32x2*)(tile + (ch * 72 + 4 * pc) * 2) = rg[k]; }
        __syncthreads();
        if (u + G < UP + US) TR_LOAD(u + G);
        for (int task = tid; task < np * 32; task += 512) { const int pos = task % np, cc = task / np;
            const LAS unsigned short* t = (const LAS unsigned short*)(tile + ((8 * cc) * 72 + pos) * 2);
            u32x4 o; o.x = (unsigned)t[0] | ((unsigned)t[72] << 16); o.y = (unsigned)t[144] | ((unsigned)t[216] << 16);
            o.z = (unsigned)t[288] | ((unsigned)t[360] << 16); o.w = (unsigned)t[432] | ((unsigned)t[504] << 16);
            *(u32x4*)(OUT + (size_t)seq_row(s, p0 + pos) * DM + c0 + 8 * cc) = o; }
    }
    __syncthreads();
#undef TR_DECODE
#undef TR_LOAD
}

__device__ __forceinline__ void attn_phase(LAS unsigned char* lds, const Args& a, int j, int bid, int G, int tid) {
    constexpr int KN_OFF = 0, KSTR = 144, VT_OFF = 59904, VSTR = 848, BT_OFF = 114176;
    const bf16_t* QK = (const bf16_t*)(a.ws + WS_R1); const bf16_t* VTg = (const bf16_t*)(a.ws + WS_VT); bf16_t* O = (bf16_t*)(a.ws + WS_R3);
    const float* rel_bias = a.in[3]; const float* qg = a.in[19] + j * 64; const float* kg = a.in[20] + j * 64; const float* sink = a.in[21] + j * 16;
    const int lane = tid & 63, w = __builtin_amdgcn_readfirstlane(tid >> 6), r = lane & 15, g = lane >> 4;
    LAS float* BT = (LAS float*)(lds + BT_OFF);
    if (tid < 64) { float mq = fabsf(qg[tid]), mk = fabsf(kg[tid]);
#pragma unroll
        for (int o = 1; o < 64; o <<= 1) { mq = fmaxf(mq, __shfl_xor(mq, o)); mk = fmaxf(mk, __shfl_xor(mk, o)); }
        if (tid == 0) BT[16 * 257] = 8.0f * mq * mk; }
    __syncthreads();
    {
        const float shift0 = BT[16 * 257];
        for (int i = tid; i < 16 * 257; i += 512) { const int h = i / 257, rel = i % 257 - 128; BT[i] = (rel_bias[t5_bucket(rel) * 16 + h] - shift0) * 1.4426950408889634f; }
    }
    __syncthreads();
    constexpr int NU = (4 * 65 + 16 * 33) * 4;
    for (int u = bid; u < NU; u += G) {
        const int hk = u & 3; int v = u >> 2, seq, qb, L;
        if (v < 260) { seq = v / 65; qb = v % 65; L = L_P; } else { v -= 260; seq = 4 + v / 33; qb = v % 33; L = L_S; }
        const int start = qb * 128 - 128;
        {
            const bf16_t* vb = VTg + seq_off_ch(seq) / 4 + (size_t)(hk * 64) * seq_LS(seq) + XPAD;
            const int LS = seq_LS(seq);
            u32x4 kraw[7], vraw[7];
#pragma unroll
            for (int it = 0; it < 7; ++it) {
                const int idx = it * 512 + tid;
                { const int slot = idx >> 3, dc = idx & 7; const int pos = slot < 16 ? slot : start + slot - 16;
                  const bool valid = (idx < 416 * 8) && (slot < 16 || (slot < 400 && pos >= 16 && pos < L));
                  kraw[it] = (u32x4){0u, 0u, 0u, 0u};
                  if (valid) kraw[it] = *(const u32x4*)(QK + (size_t)seq_row(seq, pos) * 1280 + 1024 + hk * 64 + dc * 8); }
                { const int d = idx / 52, c8 = idx % 52; const int pos0 = c8 < 2 ? 8 * c8 : start + 8 * c8 - 16;
                  const bool valid = (idx < 64 * 52) && (c8 < 2 || (c8 < 50 && pos0 >= 16 && pos0 < L));
                  vraw[it] = (u32x4){0u, 0u, 0u, 0u};
                  if (valid) vraw[it] = *(const u32x4*)(vb + (size_t)d * LS + pos0); }
            }
#pragma unroll
            for (int it = 0; it < 7; ++it) {
                const int idx = it * 512 + tid;
                const int slot = idx >> 3, dc = idx & 7;
                const u32x4 raw = kraw[it];
                float x[8] = {bflo(raw.x), bfhi(raw.x), bflo(raw.y), bfhi(raw.y), bflo(raw.z), bfhi(raw.z), bflo(raw.w), bfhi(raw.w)};
                float ss = 0.f;
#pragma unroll
                for (int i = 0; i < 8; ++i) ss += x[i] * x[i];
                ss += __shfl_xor(ss, 1); ss += __shfl_xor(ss, 2); ss += __shfl_xor(ss, 4);
                const float ri = __builtin_amdgcn_rsqf(ss * (1.0f / 64.0f) + EPS);
                const f32x4 g0 = *(const f32x4*)(kg + dc * 8), g1 = *(const f32x4*)(kg + dc * 8 + 4);
                u32x4 o; o.x = cvtpk(x[0] * ri * g0[0], x[1] * ri * g0[1]); o.y = cvtpk(x[2] * ri * g0[2], x[3] * ri * g0[3]);
                o.z = cvtpk(x[4] * ri * g1[0], x[5] * ri * g1[1]); o.w = cvtpk(x[6] * ri * g1[2], x[7] * ri * g1[3]);
                if (idx < 416 * 8) *(LAS u32x4*)(lds + KN_OFF + slot * KSTR + dc * 16) = o;
                const int d = idx / 52, c8 = idx % 52;
                if (idx < 64 * 52) *(LAS u32x4*)(lds + VT_OFF + d * VSTR + c8 * 16) = vraw[it];
            }
        }
        __syncthreads();
        const int q0 = qb * 128 + 16 * w;
        if (q0 < L) {
            const int qpos = q0 + r;
            const int fb = (16 + 16 * w) >> 5, cb = fb < 1 ? 1 : fb;
            const bf16_t* qrow = QK + (size_t)seq_row(seq, qpos) * 1280 + hk * 256;
            u32x4 qn0 = *(const u32x4*)(qrow + 8 * g), qn1 = *(const u32x4*)(qrow + 32 + 8 * g);
#pragma unroll 1
            for (int hh = 0; hh < 4; ++hh) {
                const int head = hk * 4 + hh;
                bf16x8 qf0, qf1;
                {
                    const u32x4 r0 = qn0, r1 = qn1;
                    { const int hn = hh < 3 ? hh + 1 : 3;
                      qn0 = *(const u32x4*)(qrow + hn * 64 + 8 * g); qn1 = *(const u32x4*)(qrow + hn * 64 + 32 + 8 * g); }
                    float x[16] = {bflo(r0.x), bfhi(r0.x), bflo(r0.y), bfhi(r0.y), bflo(r0.z), bfhi(r0.z), bflo(r0.w), bfhi(r0.w),
                                   bflo(r1.x), bfhi(r1.x), bflo(r1.y), bfhi(r1.y), bflo(r1.z), bfhi(r1.z), bflo(r1.w), bfhi(r1.w)};
                    float ss = 0.f;
#pragma unroll
                    for (int i = 0; i < 16; ++i) ss += x[i] * x[i];
                    ss += __shfl_xor(ss, 16); ss += __shfl_xor(ss, 32);
                    const float ri = __builtin_amdgcn_rsqf(ss * (1.0f / 64.0f) + EPS) * (0.125f * 1.4426950408889634f);
                    const f32x4 ga = *(const f32x4*)(qg + 8 * g), gb = *(const f32x4*)(qg + 8 * g + 4), gc = *(const f32x4*)(qg + 32 + 8 * g), gd = *(const f32x4*)(qg + 36 + 8 * g);
                    u32x4 p0, p1;
                    p0.x = cvtpk(x[0] * ri * ga[0], x[1] * ri * ga[1]); p0.y = cvtpk(x[2] * ri * ga[2], x[3] * ri * ga[3]);
                    p0.z = cvtpk(x[4] * ri * gb[0], x[5] * ri * gb[1]); p0.w = cvtpk(x[6] * ri * gb[2], x[7] * ri * gb[3]);
                    p1.x = cvtpk(x[8] * ri * gc[0], x[9] * ri * gc[1]); p1.y = cvtpk(x[10] * ri * gc[2], x[11] * ri * gc[3]);
                    p1.z = cvtpk(x[12] * ri * gd[0], x[13] * ri * gd[1]); p1.w = cvtpk(x[14] * ri * gd[2], x[15] * ri * gd[3]);
                    qf0 = __builtin_bit_cast(bf16x8, p0); qf1 = __builtin_bit_cast(bf16x8, p1);
                }
                const LAS float* bt = BT + head * 257 + 128;
                const float shift = BT[16 * 257];
                const float sk = sink[head];
                float den = 0.f;
                f32x4 oacc[4];
#pragma unroll
                for (int dt = 0; dt < 4; ++dt) oacc[dt] = (f32x4){0.f, 0.f, 0.f, 0.f};
                const int lkoff = KN_OFF + (8 * (r >> 2) + (r & 3)) * KSTR + 16 * g;
                const int lvoff = VT_OFF + r * VSTR + 16 * g;
                const int lb = 8 * g - r;
#pragma unroll 2
                for (int i = 0; i < 10; ++i) {
                    const int chunk = i == 0 ? 0 : cb + i - 1;
                    const int kb = lkoff + 32 * chunk * KSTR;
                    const bf16x8 k00 = *(const LAS bf16x8*)(lds + kb), k01 = *(const LAS bf16x8*)(lds + kb + 64);
                    const bf16x8 k10 = *(const LAS bf16x8*)(lds + kb + 4 * KSTR), k11 = *(const LAS bf16x8*)(lds + kb + 4 * KSTR + 64);
                    f32x4 s0 = (f32x4){0.f, 0.f, 0.f, 0.f}, s1 = (f32x4){0.f, 0.f, 0.f, 0.f};
                    s0 = __builtin_amdgcn_mfma_f32_16x16x32_bf16(k00, qf0, s0, 0, 0, 0);
                    s1 = __builtin_amdgcn_mfma_f32_16x16x32_bf16(k10, qf0, s1, 0, 0, 0);
                    s0 = __builtin_amdgcn_mfma_f32_16x16x32_bf16(k01, qf1, s0, 0, 0, 0);
                    s1 = __builtin_amdgcn_mfma_f32_16x16x32_bf16(k11, qf1, s1, 0, 0, 0);
                    const int cs = start - 16 - q0 + 32 * chunk + lb;
                    float p[8];
                    const int pmin = start + 32 * chunk - 16;
                    const bool interior = (chunk > 0) && (pmin >= q0 + 15 - 128) && (pmin + 31 <= q0 + 128) && (pmin >= 16) && (pmin + 31 < L);
                    if (interior) {
#pragma unroll
                        for (int e = 0; e < 8; ++e) {
                            const float sv = e < 4 ? s0[e & 3] : s1[e & 3];
                            p[e] = __builtin_amdgcn_exp2f(sv + bt[cs + e]);
                            den += p[e];
                        }
                    } else {
                        const bool metal = (chunk == 0) && (g < 2);
#pragma unroll
                        for (int e = 0; e < 8; ++e) {
                            const float sv = e < 4 ? s0[e & 3] : s1[e & 3];
                            const int relb = cs + e, pos = relb + qpos;
                            const int relm = 8 * g + e - qpos;
                            const bool bvalid = ((unsigned)(relb + 128) <= 256u) && ((unsigned)(pos - 16) < (unsigned)(L - 16));
                            const int rel = metal ? relm : relb;
                            const bool valid = metal || bvalid;
                            const int relc = rel < -128 ? -128 : (rel > 128 ? 128 : rel);
                            const float val = __builtin_amdgcn_exp2f(sv + bt[relc]);
                            p[e] = valid ? val : 0.f;
                            den += p[e];
                        }
                    }
                    u32x4 pp; pp.x = cvtpk(p[0], p[1]); pp.y = cvtpk(p[2], p[3]); pp.z = cvtpk(p[4], p[5]); pp.w = cvtpk(p[6], p[7]);
                    const bf16x8 pa = __builtin_bit_cast(bf16x8, pp);
                    const int vbo = lvoff + 64 * chunk;
#pragma unroll
                    for (int dt = 0; dt < 4; ++dt) {
                        const bf16x8 vb = *(const LAS bf16x8*)(lds + vbo + dt * 16 * VSTR);
                        oacc[dt] = __builtin_amdgcn_mfma_f32_16x16x32_bf16(pa, vb, oacc[dt], 0, 0, 0);
                    }
                }
                den += __shfl_xor(den, 16); den += __shfl_xor(den, 32);
                den += __builtin_amdgcn_exp2f((sk - shift) * 1.4426950408889634f);
                const float inv = 1.0f / den;
#pragma unroll
                for (int ii = 0; ii < 4; ++ii) {
                    const float iv = __shfl(inv, 4 * g + ii);
                    bf16_t* op = O + (size_t)seq_row(seq, q0 + 4 * g + ii) * DM + head * 64 + r;
#pragma unroll
                    for (int dt = 0; dt < 4; ++dt) op[dt * 16] = (bf16_t)(cvtpk(oacc[dt][ii] * iv, 0.f) & 0xffffu);
                }
            }
        }
        __syncthreads();
    }
}

#define XB_TMO      128
#define XB_XCNT(j)  (256  + 64 * (j))
#define XB_XSUB(j)  (1280 + 64 * (j))
#define XB_XGEN(j)  (2304 + 64 * (j))
#define XB_TOP      3328
#define XB_TOPGEN   3392
#define XCD_BAR_WORDS 3456
#define XB_SPIN_CAP (1u << 18)

__device__ __forceinline__ unsigned xb_ld(unsigned* p)              { return __hip_atomic_load(p, __ATOMIC_RELAXED, __HIP_MEMORY_SCOPE_AGENT); }
__device__ __forceinline__ unsigned xb_add(unsigned* p, unsigned v) { return __hip_atomic_fetch_add(p, v, __ATOMIC_RELAXED, __HIP_MEMORY_SCOPE_AGENT); }
__device__ __forceinline__ unsigned xb_xcc_id() { return (unsigned)__builtin_amdgcn_s_getreg((3 << 11) | 20) & 0xFu; }
#define XB_SPIN(cond, bar) do { unsigned _sp = 0; while (cond) { __builtin_amdgcn_s_sleep(1); \
    if ((++_sp & 255u) == 0u) { if (xb_ld(&(bar)[XB_TMO])) break; if (_sp > XB_SPIN_CAP) { atomicAdd(&(bar)[XB_TMO], 1u); break; } } } } while (0)

struct XcdBarrier {
    unsigned* bar; unsigned x;
    volatile LAS unsigned* st;
};

__device__ __forceinline__ XcdBarrier xcd_barrier_post(unsigned* bar, volatile LAS unsigned* st) {
    XcdBarrier b; b.bar = bar; b.x = xb_xcc_id(); b.st = st;
    if (threadIdx.x == 0) (void)xb_add(&bar[XB_XCNT(b.x)], 1u);
    return b;
}
__device__ __forceinline__ void xcd_barrier_complete(unsigned* bar, unsigned x, unsigned& nloc, unsigned& nx) {
    const unsigned G = gridDim.x * gridDim.y * gridDim.z;
    unsigned sum, cnt, mine, sp = 0u;
    for (;;) {
        sum = 0u; cnt = 0u; mine = 0u;
#pragma unroll
        for (unsigned j = 0; j < 16; ++j) { const unsigned c = xb_ld(&bar[XB_XCNT(j)]); sum += c; cnt += (c > 0u) ? 1u : 0u; mine = (j == x) ? c : mine; }
        if (sum == G) break;
        __builtin_amdgcn_s_sleep(1);
        if ((++sp & 255u) == 0u) { if (xb_ld(&bar[XB_TMO])) break; if (sp > XB_SPIN_CAP) { atomicAdd(&bar[XB_TMO], 1u); break; } }
    }
    nloc = mine > 0u ? mine : 1u; nx = cnt > 0u ? cnt : 1u;
}

__device__ __forceinline__ void xcd_barrier(const XcdBarrier& b) {
    asm volatile("s_waitcnt vmcnt(0)" ::: "memory");
    __syncthreads();
    if (threadIdx.x == 0) {
        unsigned* bar = b.bar;
        __builtin_amdgcn_s_waitcnt(0);
        unsigned nloc = b.st[0], nx = b.st[1];
        if (nloc == 0u) { xcd_barrier_complete(bar, b.x, nloc, nx); b.st[0] = nloc; b.st[1] = nx; }
        const unsigned old = xb_add(&bar[XB_XSUB(b.x)], 1u);
        const unsigned gen = old / nloc;
        if (old + 1u == (gen + 1u) * nloc) {
            __builtin_amdgcn_fence(__ATOMIC_RELEASE, "agent");
            asm volatile("s_waitcnt vmcnt(0)" ::: "memory");
            const unsigned og = xb_add(&bar[XB_TOP], 1u);
            const unsigned tg = og / nx;
            if (og + 1u == (tg + 1u) * nx) xb_add(&bar[XB_TOPGEN], 1u);
            else XB_SPIN(xb_ld(&bar[XB_TOPGEN]) == tg, bar);
            __builtin_amdgcn_fence(__ATOMIC_ACQUIRE, "agent");
            xb_add(&bar[XB_XGEN(b.x)], 1u);
            asm volatile("s_waitcnt vmcnt(0)" ::: "memory");
        } else {
            XB_SPIN(xb_ld(&bar[XB_XGEN(b.x)]) == gen, bar);
            __builtin_amdgcn_fence(__ATOMIC_ACQUIRE, "agent");
            asm volatile("s_waitcnt vmcnt(0)" ::: "memory");
        }
    }
    __syncthreads();
}

constexpr int LDS_XB_OFF = 147456 - 64;
#ifndef PHMASK
#define PHMASK 0xFFFF
#endif
#define PH(b) if constexpr ((PHMASK >> (b)) & 1)
#define GRID_SYNC() do { XcdBarrier _b; { kargs_t _p = (kargs_t)__builtin_amdgcn_kernarg_segment_ptr(); asm volatile("" : "+s"(_p)); _b.bar = (unsigned*)_p->ws; } _b.x = xb_xcc_id(); _b.st = (volatile LAS unsigned*)(lds + LDS_XB_OFF); xcd_barrier(_b); } while (0)
#define GRID_SYNC_CG() do { asm volatile("s_waitcnt vmcnt(0) lgkmcnt(0)" ::: "memory"); grid.sync(); if ((threadIdx.x >> 6) == 0) { __builtin_amdgcn_fence(__ATOMIC_ACQUIRE, "agent"); asm volatile("s_waitcnt vmcnt(0)" ::: "memory"); } __syncthreads(); } while (0)
typedef const __attribute__((address_space(4))) Args* kargs_t;
__device__ __forceinline__ Args get_args() {
    kargs_t p = (kargs_t)__builtin_amdgcn_kernarg_segment_ptr();
    asm volatile("" : "+s"(p));
    Args a;
#pragma unroll
    for (int i = 0; i < 25; ++i) a.in[i] = p->in[i];
    a.out = p->out; a.ws = p->ws; a.layer_lo = p->layer_lo; a.layer_hi = p->layer_hi;
    return a;
}
__device__ __forceinline__ EpiResid make_resid(const Args& a, int layer, int which  , int rb) {
    u64* rowss = (u64*)(a.ws + WS_ROWSS); float* metah = (float*)(a.ws + WS_METAH);
    EpiResid e;
    const bool first = (layer == 0 && which == 0);
    e.srcA = first ? a.in[0] : a.out; e.srcB = first ? a.in[1] : a.out + (size_t)ROWS_P * DM; e.srcM = first ? a.in[2] : metah; e.meta_mask = first ? 15 : 0xffff;
    e.dstMain = a.out; e.dstM = metah;
    const int nxt = 2 * layer + 1 + which;
    e.P = nxt < 8 ? (bf16_t*)(a.ws + WS_P) : nullptr; e.rowss_next = nxt < 8 ? rowss + (size_t)nxt * MPAD : nullptr; e.row_base = rb;
    return e;
}
__global__ void __launch_bounds__(512, 2) fwd_megakernel(Args a_unused) {
    extern __shared__ __attribute__((aligned(16))) unsigned char lds_raw[];
    LAS unsigned char* lds = (LAS unsigned char*)lds_raw;
    cg::grid_group grid = cg::this_grid();
    const int G0 = gridDim.x, bid0 = blockIdx.x;
    volatile LAS unsigned* xst = (volatile LAS unsigned*)(lds + LDS_XB_OFF);
    if (threadIdx.x < 2) xst[threadIdx.x] = 0u;
    __syncthreads();
    (void)xcd_barrier_post((unsigned*)a_unused.ws, xst);

    const int layer_lo = a_unused.layer_lo, layer_hi = a_unused.layer_hi;
    if (layer_lo == 0) {
        const Args a = get_args(); const int tid = ltid(), G = lsg(G0), bid = lsg(bid0);
        const int lane = tid & 63, wave = __builtin_amdgcn_readfirstlane(tid >> 6);
        const int gw = bid * 8 + wave, NGW = G * 8;
        u64* rowss = (u64*)(a.ws + WS_ROWSS);
        bf16_t* Wb = (bf16_t*)(a.ws + WS_W);
        bf16_t* P = (bf16_t*)(a.ws + WS_P);
        for (size_t i = (size_t)bid * 512 + tid; i < (size_t)7 * MPAD; i += (size_t)G * 512) rowss[MPAD + i] = 0ull;
        PH(0) {
        LAS float* scr = (LAS float*)(lds + wave * 16384);
#pragma unroll 1
        for (int j = 0; j < 2; ++j) {
            convert_matrix(a.in[6] + (size_t)j * 1024 * 3072, a.in[4] + (2 * j) * 1024, 1024, 3072, (bf16_t*)((char*)Wb + W_IN + (size_t)j * 6 * MiB), scr, gw, NGW, lane);
            convert_matrix(a.in[17] + (size_t)j * 1024 * 1024, nullptr, 1024, 1024, (bf16_t*)((char*)Wb + W_HOUT + (size_t)j * 2 * MiB), scr, gw, NGW, lane);
            convert_matrix(a.in[18] + (size_t)j * 1024 * 1536, a.in[4] + (2 * j + 1) * 1024, 1024, 1536, (bf16_t*)((char*)Wb + W_QKV + (size_t)j * 3 * MiB), scr, gw, NGW, lane);
            convert_matrix(a.in[22] + (size_t)j * 1024 * 1024, nullptr, 1024, 1024, (bf16_t*)((char*)Wb + W_AOUT + (size_t)j * 2 * MiB), scr, gw, NGW, lane);
        }
#pragma unroll 1
        for (int i = 0; i < 4; ++i) {
            convert_matrix(a.in[23] + (size_t)i * 1024 * 4096, a.in[5] + i * 1024, 1024, 4096, (bf16_t*)((char*)Wb + W_UP + (size_t)i * 8 * MiB), scr, gw, NGW, lane);
            convert_matrix(a.in[24] + (size_t)i * 4096 * 1024, nullptr, 4096, 1024, (bf16_t*)((char*)Wb + W_DN + (size_t)i * 8 * MiB), scr, gw, NGW, lane);
        }
        for (int row0 = gw; row0 < MREAL; row0 += 4 * NGW) {
            f32x4 v[4][4];
#pragma unroll
            for (int rr = 0; rr < 4; ++rr) {
                const int row = row0 + rr * NGW, rowc = row < MREAL ? row : MREAL - 1;
                const float* src = rowc < ROWS_P ? a.in[0] + (size_t)rowc * DM : (rowc < ROWS_MAIN ? a.in[1] + (size_t)(rowc - ROWS_P) * DM : a.in[2] + (size_t)((rowc - ROWS_MAIN) & 15) * DM);
#pragma unroll
                for (int k = 0; k < 4; ++k) v[rr][k] = *(const f32x4*)(src + k * 256 + lane * 4);
            }
#pragma unroll
            for (int rr = 0; rr < 4; ++rr) {
                const int row = row0 + rr * NGW;
                float ss = 0.f;
#pragma unroll
                for (int k = 0; k < 4; ++k) { const f32x4 x = v[rr][k];
                    ss += (x[0] * x[0] + x[1] * x[1]) + (x[2] * x[2] + x[3] * x[3]);
                    u32x2 pk; pk.x = cvtpk(x[0], x[1]); pk.y = cvtpk(x[2], x[3]);
                    if (row < MREAL) *(u32x2*)(P + (size_t)row * DM + k * 256 + lane * 4) = pk; }
                ss = wave_sum(ss);
                if (lane == 0 && row < MREAL) rowss[row] = (u64)(ss * SS_SCALE);
            }
        }
        }
        __syncthreads();
        PH(1) if (bid * 512 < 2 * H2N) h2_features(lds, a, bid * 512 + tid, tid);
        GRID_SYNC_CG();
    }

#pragma unroll 1
    for (int layer = layer_lo; layer < layer_hi; ++layer) {
        if ((layer & 1) == 0) {
            {
                const Args a = get_args(); const int tid = ltid(), G = lsg(G0), bid = lsg(bid0); const int j = layer >> 1;
                PH(2) fk_compute(a, j, bid * 8 + __builtin_amdgcn_readfirstlane(tid >> 6), G * 8, tid & 63);
                PH(3) {
                pg8::Gemm g{(const bf16_t*)(a.ws + WS_P), (const bf16_t*)(a.ws + WS_W + W_IN + (size_t)j * 6 * MiB), MPAD, 3072, 1024, 1024, 1024}; pg8::StaticOrder S; S.init(MPAD, 3072, G, bid);
                EpiHyIn E{(bf16_t*)(a.ws + WS_R1), (const u64*)(a.ws + WS_ROWSS) + (size_t)(2 * layer) * MPAD};
                pg8::gemm_phase<EpiHyIn>(lds, g, S, E);
                }
            }
            GRID_SYNC();
            { const Args a = get_args(); const int tid = ltid(), G = lsg(G0), bid = lsg(bid0); PH(4) conv_phase(lds, a, layer >> 1, bid, G, tid); }
            GRID_SYNC();
            { const Args a = get_args(); const int tid = ltid(), G = lsg(G0), bid = lsg(bid0); PH(5) transpose_phase(lds, a, bid, G, tid); }
            GRID_SYNC();
            {
                const Args a = get_args(); const int tid = ltid(), G = lsg(G0), bid = lsg(bid0); const int j = layer >> 1;
                PH(6) {
                pg8::Gemm g{(const bf16_t*)(a.ws + WS_R1), (const bf16_t*)(a.ws + WS_W + W_HOUT + (size_t)j * 2 * MiB), MPAD, 1024, 1024, 1024, 1024}; pg8::StaticOrder S; S.init(MPAD, 1024, G, bid);
                const EpiResid er = make_resid(a, layer, 0, 0);
                pg8::gemm_phase<EpiResid>(lds, g, S, er);
                }
            }
            GRID_SYNC();
        } else {
            {
                const Args a = get_args(); const int tid = ltid(), G = lsg(G0), bid = lsg(bid0); const int j = layer >> 1;
                PH(7) {
                pg8::Gemm g{(const bf16_t*)(a.ws + WS_P), (const bf16_t*)(a.ws + WS_W + W_QKV + (size_t)j * 3 * MiB), MPAD, 1536, 1024, 1024, 1024}; pg8::StaticOrder S; S.init(MPAD, 1536, G, bid);
                EpiRow<0> E{(bf16_t*)(a.ws + WS_R1), (bf16_t*)(a.ws + WS_VT), (const u64*)(a.ws + WS_ROWSS) + (size_t)(2 * layer) * MPAD, 0};
                pg8::gemm_phase<EpiRow<0>>(lds, g, S, E);
                }
            }
            GRID_SYNC();
            { const Args a = get_args(); const int tid = ltid(), G = lsg(G0), bid = lsg(bid0); PH(8) attn_phase(lds, a, layer >> 1, bid, G, tid); }
            GRID_SYNC();
            {
                const Args a = get_args(); const int tid = ltid(), G = lsg(G0), bid = lsg(bid0); const int j = layer >> 1;
                PH(9) {
                pg8::Gemm g{(const bf16_t*)(a.ws + WS_R3), (const bf16_t*)(a.ws + WS_W + W_AOUT + (size_t)j * 2 * MiB), MPAD, 1024, 1024, 1024, 1024}; pg8::StaticOrder S; S.init(MPAD, 1024, G, bid);
                const EpiResid er = make_resid(a, layer, 0, 0);
                pg8::gemm_phase<EpiResid>(lds, g, S, er);
                }
            }
            GRID_SYNC();
        }
#pragma unroll 1
        for (int half = 0; half < 2; ++half) {
            const int rb = half * MT_H0 * 256; const int mrows = (half == 0 ? MT_H0 : MT_H1) * 256;
            {
                const Args a = get_args(); const int tid = ltid(), G = lsg(G0), bid = lsg(bid0);
                PH(10) {
                pg8::Gemm g{(const bf16_t*)(a.ws + WS_P) + (size_t)rb * DM, (const bf16_t*)(a.ws + WS_W + W_UP + (size_t)layer * 8 * MiB), mrows, 4096, 1024, 1024, 1024}; pg8::StaticOrder S; S.init(mrows, 4096, G, bid);
                EpiRow<1> E{(bf16_t*)(a.ws + WS_R1), nullptr, (const u64*)(a.ws + WS_ROWSS) + (size_t)(2 * layer + 1) * MPAD, rb};
                pg8::gemm_phase<EpiRow<1>>(lds, g, S, E);
                }
            }
            GRID_SYNC();
            {
                const Args a = get_args(); const int tid = ltid(), G = lsg(G0), bid = lsg(bid0);
                PH(11) {
                const int drows = MT_H0 * 256;
                pg8::Gemm g{(const bf16_t*)(a.ws + WS_R1), (const bf16_t*)(a.ws + WS_W + W_DN + (size_t)layer * 8 * MiB), drows, 1024, 4096, 4096, 4096}; pg8::StaticOrder S; S.init(drows, 1024, G, bid);
                const EpiResid e2 = make_resid(a, layer, 1, rb);
                pg8::gemm_phase<EpiResid>(lds, g, S, e2);
                }
            }
            if (half == 1) {
                {
                    const Args a = get_args(); const int G = lsg(G0), bid = lsg(bid0);
                    PH(11) {
                    pg8::Gemm g2{(const bf16_t*)(a.ws + WS_R1) + (size_t)(MT_H0 * 256) * DFF, (const bf16_t*)(a.ws + WS_W + W_DN + (size_t)layer * 8 * MiB), 512, 1024, 4096 / DOWN_KS, 4096, 4096};
                    pg8::StaticOrder S2; S2.init_ks(512, 1024, DOWN_KS, G, bid);
                    EpiPartial ep{(float*)(a.ws + WS_R3)};
                    pg8::gemm_phase<EpiPartial>(lds, g2, S2, ep);
                    }
                }
                GRID_SYNC();
                const Args a = get_args(); const int tid = ltid(), G = lsg(G0), bid = lsg(bid0);
                const int nxt = 2 * layer + 2;
                meta_reduce((const float*)(a.ws + WS_R3), (float*)(a.ws + WS_METAH), nxt < 8 ? (bf16_t*)(a.ws + WS_P) : nullptr,
                            nxt < 8 ? (u64*)(a.ws + WS_ROWSS) + (size_t)nxt * MPAD : nullptr, bid * 8 + (tid >> 6), G * 8, tid & 63);
            }
            if (!(layer == layer_hi - 1 && half == 1)) GRID_SYNC();
        }
    }
}

constexpr int LDS_BYTES = 147456;
extern "C" void kernel_launch(void* const* d_in, const int* in_sizes, int n_in, void* d_out, int out_size, void* d_ws, size_t ws_size, hipStream_t stream) {
    static int grid = 0;
    if (grid == 0) {
        if (n_in != 25 || ws_size < WS_END) { fprintf(stderr, "kernel_launch: unexpected n_in %d or ws_size %zu (need %zu)\n", n_in, ws_size, (size_t)WS_END); grid = -1; return; }
        int dev = 0, cus = 0, per_cu = 0;
        (void)hipGetDevice(&dev);
        (void)hipDeviceGetAttribute(&cus, hipDeviceAttributeMultiprocessorCount, dev);
        if (hipFuncSetAttribute((const void*)fwd_megakernel, hipFuncAttributeMaxDynamicSharedMemorySize, LDS_BYTES) != hipSuccess) { fprintf(stderr, "kernel_launch: hipFuncSetAttribute failed\n"); grid = -1; return; }
        if (hipOccupancyMaxActiveBlocksPerMultiprocessor(&per_cu, (const void*)fwd_megakernel, 512, LDS_BYTES) != hipSuccess || per_cu < 1) { fprintf(stderr, "kernel_launch: occupancy query gives %d\n", per_cu); per_cu = 1; }
        (void)hipGetLastError();
        grid = cus * 1;
        fprintf(stderr, "kernel_launch: cus %d per_cu %d grid %d\n", cus, per_cu, grid);
    }
    if (grid < 0) return;
    Args a{};
    for (int i = 0; i < 25; ++i) a.in[i] = (const float*)d_in[i];
    a.out = (float*)d_out; a.ws = (unsigned char*)d_ws;
#ifndef NSPLIT
#define NSPLIT 1
#endif
    (void)hipMemsetAsync(d_ws, 0, 16384, stream);
    for (int part = 0; part < NSPLIT; ++part) {
        a.layer_lo = part * (4 / NSPLIT); a.layer_hi = (part + 1) * (4 / NSPLIT);
        void* args[] = {&a};
        hipError_t e = hipLaunchCooperativeKernel((const void*)fwd_megakernel, dim3(grid), dim3(512), args, LDS_BYTES, stream);
        if (e != hipSuccess) fprintf(stderr, "cooperative launch failed: %s (grid %d)\n", hipGetErrorString(e), grid);
    }
}
```

```cpp
#include <hip/hip_runtime.h>
#include <hip/hip_cooperative_groups.h>
#include <cstdio>
#include <cstdint>
namespace cg = cooperative_groups;

#define LAS __attribute__((address_space(3)))
typedef unsigned short bf16_t;
typedef short bf16x8 __attribute__((ext_vector_type(8)));
typedef float f32x4 __attribute__((ext_vector_type(4)));
typedef float f32x2 __attribute__((ext_vector_type(2)));
typedef unsigned u32x4 __attribute__((ext_vector_type(4)));
typedef unsigned u32x2 __attribute__((ext_vector_type(2)));
typedef __bf16 bf16x2_t __attribute__((ext_vector_type(2)));
typedef unsigned long long u64;
typedef unsigned long long u64x2 __attribute__((ext_vector_type(2)));
constexpr float SS_SCALE = 1048576.0f, SS_INV = 1.0f / (1048576.0f * 1024.0f);
__device__ __forceinline__ float ss_rinv(u64 v) { return __builtin_amdgcn_rsqf((float)v * SS_INV + 1e-6f); }

constexpr int DM = 1024, DFF = 4096;
constexpr int L_P = 8208, L_S = 4112;
constexpr int LS_P = 8256, LS_S = 4160, XPAD = 48;
constexpr int ROWS_P = 32768, ROWS_MAIN = 98304, MREAL = 98624, MPAD = 98816;
constexpr int MT_ALL = MPAD / 256;
constexpr int MT_H0 = 192, MT_H1 = MT_ALL - MT_H0;
constexpr float EPS = 1e-6f;

constexpr size_t MiB = 1u << 20;
constexpr size_t WS_ROWSS = 1 * MiB;
constexpr size_t WS_METAH = 8 * MiB;
constexpr size_t WS_H2T = 10 * MiB;
constexpr size_t WS_W = 17 * MiB;
constexpr size_t WS_FK = 107 * MiB;
constexpr size_t WS_P = 211 * MiB;
constexpr size_t WS_R1 = 404 * MiB, WS_R2 = 599 * MiB, WS_R3 = 794 * MiB, WS_END = 989 * MiB;
constexpr size_t WS_VT = 703 * MiB;
constexpr size_t W_IN = 0, W_HOUT = 12 * MiB, W_QKV = 16 * MiB, W_AOUT = 22 * MiB, W_UP = 26 * MiB, W_DN = 58 * MiB;
constexpr int H2N = 12320;
constexpr int FK_OFFS_P = 8704, FK_LEN_P = 17408, FK_OFFS_S = 4608, FK_LEN_S = 9216;
constexpr size_t FK_SAMPLE_OFF = (size_t)2 * 1024 * FK_LEN_P;

struct Args { const float* in[25]; float* out; unsigned char* ws; int layer_lo, layer_hi; };

__device__ __forceinline__ unsigned cvtpk(float lo, float hi) { f32x2 v = {lo, hi}; bf16x2_t b = __builtin_convertvector(v, bf16x2_t); return __builtin_bit_cast(unsigned, b); }
__device__ __forceinline__ float bf2f(unsigned short x) { return __builtin_bit_cast(float, (unsigned)x << 16); }
__device__ __forceinline__ float bflo(unsigned x) { return __builtin_bit_cast(float, x << 16); }
__device__ __forceinline__ float bfhi(unsigned x) { return __builtin_bit_cast(float, x & 0xffff0000u); }
__device__ __forceinline__ int ltid() { int t = threadIdx.x; asm volatile("" : "+v"(t)); return t; }
__device__ __forceinline__ int lsg(int x) { asm volatile("" : "+s"(x)); return x; }
__device__ __forceinline__ int seq_L(int s) { return s < 4 ? L_P : L_S; }
__device__ __forceinline__ int seq_LS(int s) { return s < 4 ? LS_P : LS_S; }
__device__ __forceinline__ size_t seq_off_ch(int s) { return s < 4 ? (size_t)s * 1024 * LS_P : (size_t)4 * 1024 * LS_P + (size_t)(s - 4) * 1024 * LS_S; }
__device__ __forceinline__ int seq_row(int s, int p) { return p < 16 ? ROWS_MAIN + 16 * s + p : (s < 4 ? s * 8192 : 32768 + (s - 4) * 4096) + p - 16; }
__device__ __forceinline__ void row_decode(int row0, int& s, int& p0, int& L) {
    if (row0 < ROWS_P) { s = row0 >> 13; p0 = 16 + (row0 & 8191); L = L_P; }
    else if (row0 < ROWS_MAIN) { const int r = row0 - ROWS_P; s = 4 + (r >> 12); p0 = 16 + (r & 4095); L = L_S; }
    else { const int r = row0 - ROWS_MAIN; s = r >> 4; p0 = r & 15; L = s < 4 ? L_P : L_S; }
}
__device__ __forceinline__ float wave_sum(float v) {
#pragma unroll
    for (int o = 1; o < 64; o <<= 1) v += __shfl_xor(v, o);
    return v;
}
__device__ __forceinline__ void my_sincos(float x, float& s, float& c) {
    const float k = rintf(x * 0.636619772367581f);
    float r = fmaf(-k, 1.57079625129699707031f, x);
    r = fmaf(-k, 7.54978941586159635335e-08f, r);
    r = fmaf(-k, 5.39030285815811905290e-15f, r);
    const float r2 = r * r;
    const float sp = r + r * r2 * (-1.6666654611e-1f + r2 * (8.3321608736e-3f + r2 * -1.9515295891e-4f));
    const float cp = 1.0f - 0.5f * r2 + r2 * r2 * (4.166664568298827e-2f + r2 * (-1.388731625493765e-3f + r2 * 2.443315711809948e-5f));
    const int n = ((int)k) & 3;
    s = (n == 0) ? sp : (n == 1) ? cp : (n == 2) ? -sp : -cp;
    c = (n == 0) ? cp : (n == 1) ? -sp : (n == 2) ? -cp : sp;
}
__device__ __forceinline__ float my_sin(float x) { float s, c; my_sincos(x, s, c); return s; }
__device__ __forceinline__ int t5_bucket(int rel) {
    const int n = rel < 0 ? -rel : rel; int b;
    if (n < 8) b = n; else if (n < 12) b = 8; else if (n < 16) b = 9; else if (n < 23) b = 10; else if (n < 32) b = 11;
    else if (n < 46) b = 12; else if (n < 64) b = 13; else if (n < 91) b = 14; else b = 15;
    return (rel > 0 ? 16 : 0) + b;
}

namespace pg8 {
#define PG8_LAS __attribute__((address_space(3)))
constexpr int BM = 256, BK = 64, HALF = 128, HTB = HALF * BK * 2, STAGE_BYTES = 8 * HTB, NXCD = 8, WGM = 8;
__host__ __device__ __forceinline__ int lds_byte(int r, int c) { const int st = (r >> 4) * 2 + (c >> 5), rr = r & 15, cc = c & 31, ob = rr * 64 + cc * 2; return st * 1024 + (ob ^ (((ob >> 9) & 1) << 5)); }
__host__ __device__ __forceinline__ void stage_rc(int b, int& R, int& C) { const int st = b / 1024, sb = b % 1024, swz = sb ^ (((sb >> 9) & 1) << 5); R = (st >> 1) * 16 + swz / 64; C = (st & 1) * 32 + (swz % 64) / 2; }
__host__ __device__ __forceinline__ int perm32(int rho) { const int n = rho >> 4, i = rho & 15; return 8 * (i >> 2) + 4 * n + (i & 3); }
struct Unit { int pm, pn, ks; };
struct Gemm { const bf16_t* A; const bf16_t* Bt; int M, N, K; int lda, ldb; };
struct StaticOrder {
    int nM, nN, nwg, G, c, KS;
    __host__ __device__ void init(int M, int N, int G_, int c_) { nM = M / BM; nN = N / BM; nwg = nM * nN; G = G_; c = c_; KS = 1; }
    __host__ __device__ void init_ks(int M, int N, int KS_, int G_, int c_) { nM = M / BM; nN = N / BM; KS = KS_; nwg = nM * nN * KS; G = G_; c = c_; }
    __host__ __device__ bool next(int i, Unit& u) const {
        const long L = (long)i * G + c; if (L >= nwg) return false;
        u.ks = 0;
        if (KS > 1) { const int l = (int)L; u.ks = l % KS; const int t = l / KS; u.pm = t % nM; u.pn = t / nM; return true; }
        int wgid = (int)L; { const int q = nwg / NXCD, r = nwg % NXCD, xcd = wgid % NXCD, off = wgid / NXCD; wgid = (xcd < r ? xcd * (q + 1) : r * (q + 1) + (xcd - r) * q) + off; }
        const int nig = WGM * nN, gid = wgid / nig, fm = gid * WGM, gsz = (nM - fm) < WGM ? (nM - fm) : WGM;
        u.pm = fm + ((wgid % nig) % gsz); u.pn = (wgid % nig) / gsz; return true;
    }
};

template <class Epi, bool ALIGN_EPI = true>
__device__ __forceinline__ void gemm_phase(PG8_LAS unsigned char* lds, const Gemm g, const StaticOrder& S, const Epi& E) {
    const int tid = ltid(), wid = __builtin_amdgcn_readfirstlane(tid >> 6), lane = tid & 63, wr = wid >> 2, wc = wid & 3, fr = lane & 15, fq = lane >> 4;
    const int K = g.K, nt = K / BK;
    unsigned voffA[2], voffB[2];
#pragma unroll
    for (int i = 0; i < 2; ++i) { int R, C; stage_rc(tid * 16 + i * 8192, R, C); const int Rb = Epi::PERM ? ((R & ~31) + perm32(R & 31)) : R;
        voffA[i] = (unsigned)(R * g.lda + C) * 2u; voffB[i] = (unsigned)(Rb * g.ldb + C) * 2u; }
    const size_t kstep = (size_t)(BK * 2);
    const size_t hstepA = (size_t)HALF * g.lda * 2, hstepB = (size_t)HALF * g.ldb * 2;
    const size_t tstepA = 2 * hstepA, tstepB = 2 * hstepB, ksA = (size_t)K * 2;
    const unsigned ldsw = (unsigned)wid * 1024u;
    const int aoff = lds_byte(wr * 64 + fr, fq * 8), boff = lds_byte(wc * 32 + fr, fq * 8);
#define PG8_SA(b, h) (((b) * 2 + (h)) * HTB)
#define PG8_SB(b, h) ((4 + (b) * 2 + (h)) * HTB)
#define PG8_STAGE(bufoff, gbase, voff) do { _Pragma("unroll") for (int _i = 0; _i < 2; ++_i) \
        __builtin_amdgcn_global_load_lds((const unsigned*)((const char*)(gbase) + (voff)[_i]), (PG8_LAS unsigned*)(lds + (bufoff) + ldsw + _i * 8192), 16, 0, 0); } while (0)
#define PG8_LDA(dst, b, h) do { _Pragma("unroll") for (int m = 0; m < 4; ++m) _Pragma("unroll") for (int k = 0; k < 2; ++k) dst[m][k] = *(const PG8_LAS bf16x8*)(lds + PG8_SA(b, h) + aoff + m * 2048 + k * 1024); } while (0)
#define PG8_LDB(dst, b, h) do { _Pragma("unroll") for (int n = 0; n < 2; ++n) _Pragma("unroll") for (int k = 0; k < 2; ++k) dst[n][k] = *(const PG8_LAS bf16x8*)(lds + PG8_SB(b, h) + boff + n * 2048 + k * 1024); } while (0)
#define PG8_MMA(ai, bj, At, Bt) do { __builtin_amdgcn_s_setprio(1); _Pragma("unroll") for (int m = 0; m < 4; ++m) _Pragma("unroll") for (int n = 0; n < 2; ++n) _Pragma("unroll") for (int k = 0; k < 2; ++k) \
        acc[ai][bj][m][n] = Epi::SWAP ? __builtin_amdgcn_mfma_f32_16x16x32_bf16(Bt[n][k], At[m][k], acc[ai][bj][m][n], 0, 0, 0) \
                                      : __builtin_amdgcn_mfma_f32_16x16x32_bf16(At[m][k], Bt[n][k], acc[ai][bj][m][n], 0, 0, 0); __builtin_amdgcn_s_setprio(0); } while (0)
#define PG8_WAIT_V(n) asm volatile("s_waitcnt vmcnt(" #n ")" ::: "memory")
#define PG8_WAIT_L(n) asm volatile("s_waitcnt lgkmcnt(" #n ")" ::: "memory")
#define PG8_BAR __builtin_amdgcn_s_barrier()
#define PG8_SCHED __builtin_amdgcn_sched_barrier(0)
    Unit cur, nxt; int ui = 0;
    if (!S.next(0, cur)) return;
    f32x4 acc[2][2][4][2];
#pragma unroll
    for (int a = 0; a < 2; ++a)
#pragma unroll
        for (int b = 0; b < 2; ++b)
#pragma unroll
            for (int m = 0; m < 4; ++m)
#pragma unroll
                for (int n = 0; n < 2; ++n) acc[a][b][m][n] = (f32x4){0.f, 0.f, 0.f, 0.f};
    bf16x8 At[4][2], B0[2][2], B1[2][2];
    const char* cA = (const char*)g.A + (size_t)cur.pm * tstepA + (size_t)cur.ks * ksA; const char* cB = (const char*)g.Bt + (size_t)cur.pn * tstepB + (size_t)cur.ks * ksA;
    PG8_STAGE(PG8_SB(0, 0), cB, voffB); PG8_STAGE(PG8_SB(0, 1), cB + hstepB, voffB); PG8_STAGE(PG8_SA(0, 0), cA, voffA); PG8_STAGE(PG8_SA(0, 1), cA + hstepA, voffA);
    if (wr == 1) PG8_BAR;
    PG8_WAIT_V(2); PG8_BAR;
    PG8_STAGE(PG8_SB(1, 0), cB + kstep, voffB); PG8_STAGE(PG8_SA(1, 0), cA + kstep, voffA); PG8_STAGE(PG8_SB(1, 1), cB + hstepB + kstep, voffB);
    PG8_WAIT_V(6); PG8_BAR;
    for (;;) {
        const bool has_next = S.next(ui + 1, nxt);
        const char* nA = has_next ? (const char*)g.A + (size_t)nxt.pm * tstepA + (size_t)nxt.ks * ksA : cA; const char* nB = has_next ? (const char*)g.Bt + (size_t)nxt.pn * tstepB + (size_t)nxt.ks * ksA : cB;
        for (int t = 0; t < nt; t += 2) {
            const bool last = (t == nt - 2);
            const char* a1 = cA + (size_t)(t + 1) * kstep;
            const char* a2 = last ? nA : cA + (size_t)(t + 2) * kstep; const char* b2 = last ? nB : cB + (size_t)(t + 2) * kstep;
            const char* a3 = a2 + kstep; const char* b3 = b2 + kstep;
            PG8_LDB(B0, 0, 0); PG8_LDB(B1, 0, 1); PG8_SCHED; PG8_LDA(At, 0, 0); PG8_STAGE(PG8_SA(1, 1), a1 + hstepA, voffA);
            PG8_WAIT_V(8); PG8_WAIT_L(0); PG8_BAR; PG8_MMA(0, 0, At, B0); PG8_MMA(0, 1, At, B1); PG8_BAR; PG8_SCHED;
            PG8_LDA(At, 0, 1); PG8_STAGE(PG8_SB(0, 0), b2, voffB); PG8_STAGE(PG8_SB(0, 1), b2 + hstepB, voffB); PG8_STAGE(PG8_SA(0, 0), a2, voffA);
            PG8_WAIT_V(8); PG8_WAIT_L(0); PG8_BAR; PG8_MMA(1, 0, At, B0); PG8_MMA(1, 1, At, B1); PG8_BAR; PG8_SCHED;
            PG8_LDB(B0, 1, 0); PG8_LDB(B1, 1, 1); PG8_SCHED; PG8_LDA(At, 1, 0); PG8_STAGE(PG8_SA(0, 1), a2 + hstepA, voffA);
            PG8_WAIT_V(8); PG8_WAIT_L(0); PG8_BAR; PG8_MMA(0, 0, At, B0); PG8_MMA(0, 1, At, B1); PG8_BAR; PG8_SCHED;
            PG8_LDA(At, 1, 1); PG8_STAGE(PG8_SB(1, 0), b3, voffB); PG8_STAGE(PG8_SB(1, 1), b3 + hstepB, voffB); PG8_STAGE(PG8_SA(1, 0), a3, voffA);
            PG8_WAIT_V(8); PG8_WAIT_L(0); PG8_BAR; PG8_MMA(1, 0, At, B0); PG8_MMA(1, 1, At, B1); PG8_BAR; PG8_SCHED;
        }
        if constexpr (ALIGN_EPI) { if (wr == 0) PG8_BAR; }
        E(acc, cur, wr, wc, fr, fq);
        if (!has_next) break;
#pragma unroll
        for (int a = 0; a < 2; ++a)
#pragma unroll
            for (int b = 0; b < 2; ++b)
#pragma unroll
                for (int m = 0; m < 4; ++m)
#pragma unroll
                    for (int n = 0; n < 2; ++n) acc[a][b][m][n] = (f32x4){0.f, 0.f, 0.f, 0.f};
        cur = nxt; cA = nA; cB = nB; ++ui;
        if constexpr (ALIGN_EPI) { if (wr == 1) PG8_BAR; }
    }
    PG8_WAIT_V(0);
    if constexpr (!ALIGN_EPI) { if (wr == 0) PG8_BAR; }
    PG8_BAR;
#undef PG8_SA
#undef PG8_SB
#undef PG8_STAGE
#undef PG8_LDA
#undef PG8_LDB
#undef PG8_MMA
#undef PG8_WAIT_V
#undef PG8_WAIT_L
#undef PG8_BAR
#undef PG8_SCHED
}
}

struct EpiHyIn {
    static constexpr bool PERM = false, SWAP = false;
    bf16_t* XT; const u64* rowss;
    __device__ __forceinline__ void operator()(const f32x4 (&acc)[2][2][4][2], const pg8::Unit& u, int wr, int wc, int fr, int fq) const {
        constexpr size_t REGION = (size_t)(WS_R2 - WS_R1) / 2;
#pragma unroll
        for (int ai = 0; ai < 2; ++ai)
#pragma unroll
            for (int m = 0; m < 4; ++m) {
                const int row0 = u.pm * 256 + ai * 128 + wr * 64 + m * 16;
                if (row0 >= MREAL) continue;
                const u64x2 s01 = *(const u64x2*)(rowss + row0 + 4 * fq), s23 = *(const u64x2*)(rowss + row0 + 4 * fq + 2);
                f32x4 ri; ri[0] = ss_rinv(s01[0]); ri[1] = ss_rinv(s01[1]); ri[2] = ss_rinv(s23[0]); ri[3] = ss_rinv(s23[1]);
                int s, p0, L; row_decode(row0, s, p0, L);
                const size_t so = seq_off_ch(s); const int LS = seq_LS(s);
#pragma unroll
                for (int bj = 0; bj < 2; ++bj)
#pragma unroll
                    for (int n = 0; n < 2; ++n) {
                        const int col = u.pn * 256 + bj * 128 + wc * 32 + n * 16 + fr;
                        const int part = col >> 10, ch = col & 1023;
                        const f32x4 v = acc[ai][bj][m][n] * ri;
                        u32x2 w; w.x = cvtpk(v[0], v[1]); w.y = cvtpk(v[2], v[3]);
                        *(u32x2*)(XT + (size_t)part * REGION + so + (size_t)ch * LS + XPAD + p0 + 4 * fq) = w;
                    }
            }
    }
};
template <int MODE> struct EpiRow {
    static constexpr bool PERM = true, SWAP = true;
    bf16_t* O; bf16_t* VT; const u64* rowss; int row_base;
    __device__ __forceinline__ void operator()(const f32x4 (&acc)[2][2][4][2], const pg8::Unit& u, int wr, int wc, int fr, int fq) const {
#pragma unroll
        for (int ai = 0; ai < 2; ++ai)
#pragma unroll
            for (int m = 0; m < 4; ++m) {
                const int lrow = u.pm * 256 + ai * 128 + wr * 64 + m * 16 + fr, grow = row_base + lrow;
                if (grow >= MREAL) continue;
                const float ri = ss_rinv(rowss[grow]);
#pragma unroll
                for (int bj = 0; bj < 2; ++bj) {
                    const int col0 = u.pn * 256 + bj * 128 + wc * 32 + 8 * fq;
                    f32x4 v0 = acc[ai][bj][m][0] * ri, v1 = acc[ai][bj][m][1] * ri;
                    if (MODE == 1) {
#pragma unroll
                        for (int i = 0; i < 4; ++i) { const float a = fmaxf(v0[i], 0.f), b = fmaxf(v1[i], 0.f); v0[i] = a * a; v1[i] = b * b; }
                        u32x4 w; w.x = cvtpk(v0[0], v0[1]); w.y = cvtpk(v0[2], v0[3]); w.z = cvtpk(v1[0], v1[1]); w.w = cvtpk(v1[2], v1[3]);
                        *(u32x4*)(O + (size_t)lrow * DFF + col0) = w;
                    } else {
                        if (col0 < 1280) {
                            u32x4 w; w.x = cvtpk(v0[0], v0[1]); w.y = cvtpk(v0[2], v0[3]); w.z = cvtpk(v1[0], v1[1]); w.w = cvtpk(v1[2], v1[3]);
                            *(u32x4*)(O + (size_t)grow * 1280 + col0) = w;
                        } else {
                            int s, p, L; row_decode(grow, s, p, L);
                            const int LS = seq_LS(s);
                            bf16_t* dst = VT + seq_off_ch(s) / 4 + (size_t)(col0 - 1280) * LS + XPAD + p;
#pragma unroll
                            for (int i = 0; i < 4; ++i) { dst[(size_t)i * LS] = (bf16_t)(cvtpk(v0[i], 0.f) & 0xffffu); dst[(size_t)(4 + i) * LS] = (bf16_t)(cvtpk(v1[i], 0.f) & 0xffffu); }
                        }
                    }
                }
            }
    }
};
struct EpiResid {
    static constexpr bool PERM = true, SWAP = true;
    const float* srcA; const float* srcB; const float* srcM; int meta_mask;
    float* dstMain; float* dstM; bf16_t* P; u64* rowss_next; int row_base;
    __device__ __forceinline__ void operator()(const f32x4 (&acc)[2][2][4][2], const pg8::Unit& u, int wr, int wc, int fr, int fq) const {
#pragma unroll
        for (int ai = 0; ai < 2; ++ai)
#pragma unroll
            for (int m = 0; m < 4; ++m) {
                const int grow = row_base + u.pm * 256 + ai * 128 + wr * 64 + m * 16 + fr;
                const bool ok = grow < MREAL;
                float ss = 0.f;
                if (ok) {
                    const float* src; float* dst;
                    if (grow < ROWS_P) { src = srcA + (size_t)grow * DM; dst = dstMain + (size_t)grow * DM; }
                    else if (grow < ROWS_MAIN) { src = srcB + (size_t)(grow - ROWS_P) * DM; dst = dstMain + (size_t)grow * DM; }
                    else { const int mr = grow - ROWS_MAIN; src = srcM + (size_t)(mr & meta_mask) * DM; dst = dstM + (size_t)mr * DM; }
#pragma unroll
                    for (int bj = 0; bj < 2; ++bj) {
                        const int col0 = u.pn * 256 + bj * 128 + wc * 32 + 8 * fq;
                        const f32x4 h0 = *(const f32x4*)(src + col0) + acc[ai][bj][m][0];
                        const f32x4 h1 = *(const f32x4*)(src + col0 + 4) + acc[ai][bj][m][1];
                        *(f32x4*)(dst + col0) = h0; *(f32x4*)(dst + col0 + 4) = h1;
                        if (P) { u32x4 w; w.x = cvtpk(h0[0], h0[1]); w.y = cvtpk(h0[2], h0[3]); w.z = cvtpk(h1[0], h1[1]); w.w = cvtpk(h1[2], h1[3]);
                            *(u32x4*)(P + (size_t)grow * DM + col0) = w; }
                        ss += (h0[0] * h0[0] + h0[1] * h0[1]) + (h0[2] * h0[2] + h0[3] * h0[3]) + (h1[0] * h1[0] + h1[1] * h1[1]) + (h1[2] * h1[2] + h1[3] * h1[3]);
                    }
                }
                ss += __shfl_xor(ss, 16); ss += __shfl_xor(ss, 32);
                if (ok && fq == 0 && rowss_next) atomicAdd(rowss_next + grow, (u64)(ss * SS_SCALE));
            }
    }
};

struct EpiPartial {
    static constexpr bool PERM = true, SWAP = true;
    float* PART;
    __device__ __forceinline__ void operator()(const f32x4 (&acc)[2][2][4][2], const pg8::Unit& u, int wr, int wc, int fr, int fq) const {
#pragma unroll
        for (int ai = 0; ai < 2; ++ai)
#pragma unroll
            for (int m = 0; m < 4; ++m) {
                const int lrow = u.pm * 256 + ai * 128 + wr * 64 + m * 16 + fr;
                float* dst = PART + ((size_t)u.ks * 512 + lrow) * DM + u.pn * 256 + wc * 32 + 8 * fq;
#pragma unroll
                for (int bj = 0; bj < 2; ++bj) { *(f32x4*)(dst + bj * 128) = acc[ai][bj][m][0]; *(f32x4*)(dst + bj * 128 + 4) = acc[ai][bj][m][1]; }
            }
    }
};
constexpr int DOWN_KS = 16;
__device__ __forceinline__ void meta_reduce(const float* PART, float* metah, bf16_t* P, u64* rowss_next, int gw, int NGW, int lane) {
    for (int lrow = gw; lrow < MREAL - ROWS_MAIN; lrow += NGW) {
        float ss = 0.f;
#pragma unroll
        for (int k = 0; k < 4; ++k) {
            const int col = k * 256 + lane * 4;
            f32x4 sum = *(const f32x4*)(metah + (size_t)lrow * DM + col);
#pragma unroll
            for (int ks = 0; ks < DOWN_KS; ++ks) sum += *(const f32x4*)(PART + ((size_t)ks * 512 + lrow) * DM + col);
            *(f32x4*)(metah + (size_t)lrow * DM + col) = sum;
            if (P) { u32x2 pk; pk.x = cvtpk(sum[0], sum[1]); pk.y = cvtpk(sum[2], sum[3]); *(u32x2*)(P + (size_t)(ROWS_MAIN + lrow) * DM + col) = pk; }
            ss += (sum[0] * sum[0] + sum[1] * sum[1]) + (sum[2] * sum[2] + sum[3] * sum[3]);
        }
        ss = wave_sum(ss);
        if (lane == 0 && rowss_next) rowss_next[ROWS_MAIN + lrow] = (u64)(ss * SS_SCALE);
    }
}

__device__ __forceinline__ void transpose_item(const float* W, const float* gain, int K, int N, bf16_t* WT, LAS float* scr, int item, int lane) {
    const int nblk = N / 32, kb = item / nblk, nb = item % nblk, k0 = 64 * kb, n0 = 32 * nb;
#pragma unroll 8
    for (int i = 0; i < 32; ++i) { const int kk = 2 * i + (lane >> 5); float v = W[(size_t)(k0 + kk) * N + n0 + (lane & 31)]; if (gain) v *= gain[k0 + kk]; scr[kk * 33 + (lane & 31)] = v; }
    asm volatile("s_waitcnt lgkmcnt(0)" ::: "memory");
    const int c = lane & 7;
#pragma unroll
    for (int j = 0; j < 4; ++j) { const int n = (lane >> 3) + 8 * j; const LAS float* s = scr + (8 * c) * 33 + n;
        u32x4 o; o.x = cvtpk(s[0 * 33], s[1 * 33]); o.y = cvtpk(s[2 * 33], s[3 * 33]); o.z = cvtpk(s[4 * 33], s[5 * 33]); o.w = cvtpk(s[6 * 33], s[7 * 33]);
        *(u32x4*)(WT + (size_t)(n0 + n) * K + k0 + 8 * c) = o; }
    asm volatile("s_waitcnt lgkmcnt(0)" ::: "memory");
}
__device__ __forceinline__ void convert_matrix(const float* W, const float* gain, int K, int N, bf16_t* WT, LAS float* scr, int gw, int NGW, int lane) {
    const int nitems = (K / 64) * (N / 32);
    for (int it = gw; it < nitems; it += NGW) transpose_item(W, gain, K, N, WT, scr, it, lane);
}

__device__ __forceinline__ void h2_features(LAS unsigned char* lds, const Args& a, int j, int npr, int tid) {
    LAS float* hs = (LAS float*)lds;
    float* H2T = (float*)(a.ws + WS_H2T);
    const bool hvalid = npr < H2N;
    const int np = hvalid ? npr : H2N - 1;
    const int L = np < L_P ? L_P : L_S, n = np < L_P ? np : np - L_P;
    const float* w1 = a.in[9] + j * 33 * 64; const float* b1 = a.in[10] + j * 64; const float* fr1 = a.in[11] + j * 64;
    const float* w2 = a.in[12] + j * 64 * 64; const float* b2 = a.in[13] + j * 64; const float* fr2 = a.in[14] + j * 64;
    const float t = (float)n * (1.0f / (float)(L - 1));
    const float w = (6.283185307179586f / (float)L) * (float)n;
    float acc[64];
#pragma unroll
    for (int m = 0; m < 64; ++m) acc[m] = b1[m] + t * w1[m];
    for (int e = 0; e < 16; ++e) {
        const float f = 1e-4f + (float)e * ((15.0f - 1e-4f) / 15.0f);
        float s, c; my_sincos(f * w, s, c);
        const float* wc = w1 + (1 + e) * 64; const float* wsn = w1 + (17 + e) * 64;
#pragma unroll
        for (int m = 0; m < 64; ++m) acc[m] = fmaf(c, wc[m], fmaf(-s, wsn[m], acc[m]));
    }
#pragma unroll
    for (int m = 0; m < 64; ++m) hs[m * 64 + tid] = my_sin(fr1[m] * acc[m]);
#pragma unroll
    for (int m = 0; m < 64; ++m) acc[m] = b2[m];
    for (int e = 0; e < 64; ++e) {
        const float h = hs[e * 64 + tid]; const float* wr_ = w2 + e * 64;
#pragma unroll
        for (int m = 0; m < 64; ++m) acc[m] = fmaf(h, wr_[m], acc[m]);
    }
    if (hvalid) {
#pragma unroll
        for (int m = 0; m < 64; ++m) H2T[((size_t)j * H2N + np) * 64 + m] = my_sin(fr2[m] * acc[m]);
    }
}

__device__ __forceinline__ void split8(const f32x4 a, const f32x4 b, bf16x8& hi, bf16x8& lo) {
    u32x4 h, l;
    h.x = cvtpk(a[0], a[1]); h.y = cvtpk(a[2], a[3]); h.z = cvtpk(b[0], b[1]); h.w = cvtpk(b[2], b[3]);
    l.x = cvtpk(a[0] - bflo(h.x), a[1] - bfhi(h.x)); l.y = cvtpk(a[2] - bflo(h.y), a[3] - bfhi(h.y));
    l.z = cvtpk(b[0] - bflo(h.z), b[1] - bfhi(h.z)); l.w = cvtpk(b[2] - bflo(h.w), b[3] - bfhi(h.w));
    hi = __builtin_bit_cast(bf16x8, h); lo = __builtin_bit_cast(bf16x8, l);
}
__device__ __forceinline__ void fk_compute(const Args& a, int j, int gw, int NGW, int lane) {
    const float* H2 = (const float*)(a.ws + WS_H2T) + (size_t)j * H2N * 64;
    const float* w3 = a.in[15] + (size_t)j * 64 * 4096;
    const float* skip = a.in[16] + j * 2 * 1024;
    bf16_t* FK = (bf16_t*)(a.ws + WS_FK);
    const int n16 = lane & 15, g = lane >> 4;
#pragma unroll 1
    for (int it = gw; it < 2048; it += NGW) {
        const int pq = it & 3, cht = (it >> 2) & 63, dir = (it >> 8) & 1, o = (it >> 9) & 1, set = it >> 10;
        const int L = set ? L_S : L_P, offs = set ? FK_OFFS_S : FK_OFFS_P, len = set ? FK_LEN_S : FK_LEN_P, nbase = set ? L_P : 0;
        bf16_t* base = FK + (set ? FK_SAMPLE_OFF : 0);
        const int ch = cht * 16 + n16;
        bf16x8 Bh0, Bl0, Bh1, Bl1;
        {
            const float* wp = w3 + (o * 2 + dir) * 1024 + ch;
            f32x4 w0, w1, w2, w3v;
#pragma unroll
            for (int i = 0; i < 4; ++i) { w0[i] = wp[(size_t)(8 * g + i) * 4096]; w1[i] = wp[(size_t)(8 * g + 4 + i) * 4096];
                w2[i] = wp[(size_t)(32 + 8 * g + i) * 4096]; w3v[i] = wp[(size_t)(36 + 8 * g + i) * 4096]; }
            split8(w0, w1, Bh0, Bl0); split8(w2, w3v, Bh1, Bl1);
        }
        const float mind = -3.0701134573253944f, maxd = -15.350567286626972f;
        const float delta = fabsf(mind + (maxd - mind) * ((float)ch * (1.0f / 1023.0f)));
        const float skipv = skip[o * 1024 + ch];
        const float tinv = 1.0f / (float)(L - 1);
        bf16_t* rowp = base + ((size_t)o * 1024 + ch) * len;
        const int tq = offs / 64;
#pragma unroll 2
        for (int tile = pq * tq; tile < (pq + 1) * tq; ++tile) {
            const int n0 = tile * 16 + dir;
            const int nr = n0 + n16, nrc = nr < L ? nr : L - 1;
            const float* hp = H2 + (size_t)(nbase + nrc) * 64 + 8 * g;
            const f32x4 h0 = *(const f32x4*)hp, h1 = *(const f32x4*)(hp + 4), h2 = *(const f32x4*)(hp + 32), h3 = *(const f32x4*)(hp + 36);
            bf16x8 Ah0, Al0, Ah1, Al1; split8(h0, h1, Ah0, Al0); split8(h2, h3, Ah1, Al1);
            f32x4 acc = (f32x4){0.f, 0.f, 0.f, 0.f};
            acc = __builtin_amdgcn_mfma_f32_16x16x32_bf16(Al0, Bh0, acc, 0, 0, 0);
            acc = __builtin_amdgcn_mfma_f32_16x16x32_bf16(Al1, Bh1, acc, 0, 0, 0);
            acc = __builtin_amdgcn_mfma_f32_16x16x32_bf16(Ah0, Bl0, acc, 0, 0, 0);
            acc = __builtin_amdgcn_mfma_f32_16x16x32_bf16(Ah1, Bl1, acc, 0, 0, 0);
            acc = __builtin_amdgcn_mfma_f32_16x16x32_bf16(Ah0, Bh0, acc, 0, 0, 0);
            acc = __builtin_amdgcn_mfma_f32_16x16x32_bf16(Ah1, Bh1, acc, 0, 0, 0);
            float v[4];
#pragma unroll
            for (int ii = 0; ii < 4; ++ii) {
                const int n = n0 + 4 * g + ii;
                float x = acc[ii] * __expf(-((float)n * tinv) * delta);
                if (dir == 0 && n == 0) x += skipv;
                v[ii] = n < L ? x : 0.f;
            }
            u32x2 pk;
            if (dir == 0) { pk.x = cvtpk(v[0], v[1]); pk.y = cvtpk(v[2], v[3]); *(u32x2*)(rowp + offs + n0 + 4 * g) = pk; }
            else { pk.x = cvtpk(v[3], v[2]); pk.y = cvtpk(v[1], v[0]); *(u32x2*)(rowp + offs - (n0 + 4 * g + 3)) = pk; }
        }
    }
}

__device__ __forceinline__ u32x2 cld8(const void* p) { u32x2 v; asm volatile("global_load_dwordx2 %0, %1, off sc0 sc1\n\ts_waitcnt vmcnt(0)" : "=v"(v) : "v"(p) : "memory"); return v; }
__device__ __forceinline__ u32x4 cld16(const void* p) { u32x4 v; asm volatile("global_load_dwordx4 %0, %1, off sc0 sc1\n\ts_waitcnt vmcnt(0)" : "=v"(v) : "v"(p) : "memory"); return v; }
__device__ __forceinline__ unsigned short cld2(const void* p) { unsigned v; asm volatile("global_load_ushort %0, %1, off sc0 sc1\n\ts_waitcnt vmcnt(0)" : "=v"(v) : "v"(p) : "memory"); return (unsigned short)v; }
__device__ __forceinline__ f32x4 gate4(const bf16_t* xrow, int m, int L, float w0, float w1, float w2, float bb) {
    const u32x2 raw = *(const u32x2*)(xrow + m);
    const float x0 = bflo(raw.x), x1 = bfhi(raw.x), x2 = bflo(raw.y), x3 = bfhi(raw.y);
    const float xm = m > 0 ? bf2f(xrow[m - 1]) : 0.f, xp = (m + 4 < L) ? bf2f(xrow[m + 4]) : 0.f;
    f32x4 r;
    r[0] = w0 * xm + w1 * x0 + w2 * x1 + bb; r[1] = w0 * x0 + w1 * x1 + w2 * x2 + bb;
    r[2] = w0 * x1 + w1 * x2 + w2 * x3 + bb; r[3] = w0 * x2 + w1 * x3 + w2 * xp + bb;
    return r;
}
struct GateRaw { u32x2 raw; unsigned halo; };
__device__ __forceinline__ GateRaw gate_load(const bf16_t* xrow, int m, int L) {
    GateRaw r; r.raw = *(const u32x2*)(xrow + m);
    const unsigned xm = m > 0 ? (unsigned)xrow[m - 1] : 0u, xp = (m + 4 < L) ? (unsigned)xrow[m + 4] : 0u;
    r.halo = xm | (xp << 16); return r;
}
__device__ __forceinline__ f32x4 gate_eval(const GateRaw& gr, float w0, float w1, float w2, float bb) {
    const float x0 = bflo(gr.raw.x), x1 = bfhi(gr.raw.x), x2 = bflo(gr.raw.y), x3 = bfhi(gr.raw.y), xm = bflo(gr.halo), xp = bfhi(gr.halo);
    f32x4 r;
    r[0] = w0 * xm + w1 * x0 + w2 * x1 + bb; r[1] = w0 * x0 + w1 * x1 + w2 * x2 + bb;
    r[2] = w0 * x1 + w1 * x2 + w2 * x3 + bb; r[3] = w0 * x2 + w1 * x3 + w2 * xp + bb;
    return r;
}
template <int NQ, int NB, int L>
__device__ __forceinline__ void conv_unit(LAS unsigned char* lds, const Args& a, int j, int seq0, int c, int tid) {
    constexpr int QS = 64, GS = QS * NQ, WS = 4 * GS, PADL = 224;
    constexpr int LS = (NQ == 4) ? LS_P : LS_S;
    constexpr int LPD = (NQ == 4) ? 8720 : 4616;
    constexpr int OFFS = (NQ == 4) ? FK_OFFS_P : FK_OFFS_S, LEN = (NQ == 4) ? FK_LEN_P : FK_LEN_S;
    constexpr int S_LO = -QS * (NQ - 1), S_HI = ((L - 1) / 32) * 32;
    constexpr int U_OFF = 0, FKL_OFF = 77824, RED_OFF = 112640;
    static_assert(NB * LPD * 2 <= FKL_OFF && FKL_OFF + LEN * 2 <= RED_OFF, "conv LDS map");
    const int lane = tid & 63, w = __builtin_amdgcn_readfirstlane(tid >> 6);
    const bf16_t* X1 = (const bf16_t*)(a.ws + WS_R1); const bf16_t* X2 = (const bf16_t*)(a.ws + WS_R2); bf16_t* V = (bf16_t*)(a.ws + WS_R3);
    const bf16_t* FK = (const bf16_t*)(a.ws + WS_FK) + ((NQ == 4) ? 0 : FK_SAMPLE_OFF);
    const float* cw = a.in[7] + (size_t)j * 3 * 3072; const float* cb = a.in[8] + (size_t)j * 3072;
    constexpr int NF = (LEN / 8 + 511) / 512;
    u32x4 fkr[NF];
    {
        const u32x4* src = (const u32x4*)(FK + (size_t)c * LEN);
#pragma unroll
        for (int it = 0; it < NF; ++it) { const int i = it * 512 + tid; fkr[it] = src[i < LEN / 8 ? i : 0]; }
    }
    {
        const float w0 = cw[2048 + c], w1 = cw[3072 + 2048 + c], w2 = cw[2 * 3072 + 2048 + c], bb = cb[2048 + c];
        constexpr int NCH = LPD / 8, NIT = (NB * NCH + 511) / 512;
        u32x4 raws[NIT]; unsigned halos[NIT];
#pragma unroll
        for (int it = 0; it < NIT; ++it) {
            const int idx = it * 512 + tid; const int b = idx / NCH, ch = idx % NCH, p = ch * 8 - PADL;
            raws[it] = (u32x4){0u, 0u, 0u, 0u}; halos[it] = 0u;
            if (idx < NB * NCH && p >= 0 && p < L) {
                const bf16_t* row = V + seq_off_ch(seq0 + b) + (size_t)c * LS + XPAD + p;
                raws[it] = *(const u32x4*)row;
                const unsigned xm = p > 0 ? (unsigned)row[-1] : 0u, xp = (p + 8 < L) ? (unsigned)row[8] : 0u;
                halos[it] = xm | (xp << 16);
            }
        }
#pragma unroll
        for (int it = 0; it < NIT; ++it) {
            const int idx = it * 512 + tid; const int b = idx / NCH, ch = idx % NCH, p = ch * 8 - PADL;
            u32x4 o = {0u, 0u, 0u, 0u};
            if (p >= 0 && p < L) {
                const u32x4 raw = raws[it];
                float x[10];
                x[0] = bflo(halos[it]); x[9] = bfhi(halos[it]);
                x[1] = bflo(raw.x); x[2] = bfhi(raw.x); x[3] = bflo(raw.y); x[4] = bfhi(raw.y); x[5] = bflo(raw.z); x[6] = bfhi(raw.z); x[7] = bflo(raw.w); x[8] = bfhi(raw.w);
                float y[8];
#pragma unroll
                for (int i = 0; i < 8; ++i) y[i] = w0 * x[i] + w1 * x[i + 1] + w2 * x[i + 2] + bb;
                o.x = cvtpk(y[0], y[1]); o.y = cvtpk(y[2], y[3]); o.z = cvtpk(y[4], y[5]); o.w = cvtpk(y[6], y[7]);
            }
            if (idx < NB * NCH) *(LAS u32x4*)(lds + U_OFF + (b * LPD + ch * 8) * 2) = o;
        }
    }
    const int n = lane & 15, g = lane >> 4;
    const int q = (NQ == 4) ? (n >> 2) : (n >> 3), b = (NQ == 4) ? (n & 3) : (n & 7);
    const int ub = U_OFF + (b * LPD + PADL + QS * q + 8 * g) * 2;
    const int ubm = U_OFF + (b * LPD + PADL + 8 * g) * 2;
    const int pe = (1 + n) & 1;
    const int abr = FKL_OFF + (LEN - 1 - OFFS - n + 8 * g - pe) * 2;
    const unsigned sh = pe * 16;
    const int mw = 16 + WS * w;
    const int d_lo = mw - S_HI, d_hi = mw + 3 * GS - S_LO;
    const size_t xrow_off = seq_off_ch(seq0 + b) + (size_t)c * LS + XPAD;
#define ARAW(d, lagoff) do { const LAS unsigned* _p = (const LAS unsigned*)(lds + abr - (lagoff) * 2); d[0] = _p[0]; d[1] = _p[1]; d[2] = _p[2]; d[3] = _p[3]; d[4] = _p[4]; } while (0)
#define AFIN(dst, d) do { u32x4 _o; _o.x = __builtin_amdgcn_alignbit(d[1], d[0], sh); _o.y = __builtin_amdgcn_alignbit(d[2], d[1], sh); \
        _o.z = __builtin_amdgcn_alignbit(d[3], d[2], sh); _o.w = __builtin_amdgcn_alignbit(d[4], d[3], sh); dst = __builtin_bit_cast(bf16x8, _o); } while (0)
#define GATHER(dst, lagoff) do { unsigned _d[5]; ARAW(_d, lagoff); AFIN(dst, _d); } while (0)
#pragma unroll 1
    for (int o = 0; o < 2; ++o) {
#pragma unroll
        for (int it = 0; it < NF; ++it) { const int i = it * 512 + tid; const u32x4 v = fkr[it]; u32x4 r;
            r.x = __builtin_amdgcn_alignbit(v.w, v.w, 16); r.y = __builtin_amdgcn_alignbit(v.z, v.z, 16);
            r.z = __builtin_amdgcn_alignbit(v.y, v.y, 16); r.w = __builtin_amdgcn_alignbit(v.x, v.x, 16);
            if (i < LEN / 8) *(LAS u32x4*)(lds + FKL_OFF + (LEN / 8 - 1 - i) * 16) = r; }
        __syncthreads();
        if (o == 0) {
            const u32x4* src = (const u32x4*)(FK + ((size_t)1024 + c) * LEN);
#pragma unroll
            for (int it = 0; it < NF; ++it) { const int i = it * 512 + tid; fkr[it] = src[i < LEN / 8 ? i : 0]; }
        }
        f32x4 acc[4][4];
#pragma unroll
        for (int gi = 0; gi < 4; ++gi)
#pragma unroll
            for (int t = 0; t < 4; ++t) acc[gi][t] = (f32x4){0.f, 0.f, 0.f, 0.f};
        bf16x8 A0, A1, A2, A3, Bc[4], Bn[4];
        GATHER(A0, d_lo); GATHER(A1, d_lo + 16); GATHER(A2, d_lo + 32); GATHER(A3, d_lo + 48);
        int baddr = ub + 2 * (mw - d_lo);
#pragma unroll
        for (int gi = 0; gi < 4; ++gi) Bc[gi] = *(const LAS bf16x8*)(lds + baddr + 2 * GS * gi);
#define CONV_STEP(BCUR, BNXT, DL, CHECK) do { \
            unsigned r2[5], r3[5]; ARAW(r2, (DL) + 64); ARAW(r3, (DL) + 80); \
            baddr -= 64; \
            _Pragma("unroll") for (int gi = 0; gi < 4; ++gi) BNXT[gi] = *(const LAS bf16x8*)(lds + baddr + 2 * GS * gi); \
            __builtin_amdgcn_s_setprio(1); \
            _Pragma("unroll") for (int gi = 0; gi < 4; ++gi) { \
                const int s0 = mw + GS * gi - (DL); \
                if (!(CHECK) || ((s0 >= S_LO) && (s0 <= S_HI))) { \
                    acc[gi][0] = __builtin_amdgcn_mfma_f32_16x16x32_bf16(A0, BCUR[gi], acc[gi][0], 0, 0, 0); \
                    acc[gi][1] = __builtin_amdgcn_mfma_f32_16x16x32_bf16(A1, BCUR[gi], acc[gi][1], 0, 0, 0); \
                    acc[gi][2] = __builtin_amdgcn_mfma_f32_16x16x32_bf16(A2, BCUR[gi], acc[gi][2], 0, 0, 0); \
                    acc[gi][3] = __builtin_amdgcn_mfma_f32_16x16x32_bf16(A3, BCUR[gi], acc[gi][3], 0, 0, 0); \
                } \
            } \
            __builtin_amdgcn_s_setprio(0); \
            A0 = A2; A1 = A3; AFIN(A2, r2); AFIN(A3, r3); } while (0)
        const int dl_a = mw + 3 * GS - S_HI, dl_b = mw - S_LO;
        static_assert(((3 * GS / 32) % 2 == 0) && (((S_HI - S_LO - 3 * GS) / 32 + 1) % 2 == 1), "conv step-count parity");
#pragma unroll 1
        for (int dl = d_lo; dl < dl_a; dl += 64) { CONV_STEP(Bc, Bn, dl, true); CONV_STEP(Bn, Bc, dl + 32, true); }
#pragma unroll 1
        for (int dl = dl_a; dl < dl_b; dl += 64) { CONV_STEP(Bc, Bn, dl, false); CONV_STEP(Bn, Bc, dl + 32, false); }
        CONV_STEP(Bc, Bn, dl_b, false);
#pragma unroll 1
        for (int dl = dl_b + 32; dl <= d_hi; dl += 64) { CONV_STEP(Bn, Bc, dl, true); CONV_STEP(Bc, Bn, dl + 32, true); }
#undef CONV_STEP
        const bf16_t* X = (o == 0 ? X1 : X2) + xrow_off;
        const float w0 = cw[o * 1024 + c], w1 = cw[3072 + o * 1024 + c], w2 = cw[2 * 3072 + o * 1024 + c], bb = cb[o * 1024 + c];
        GateRaw gt[4][4];
        {
            const int mb = mw + QS * q + 4 * g; const bf16_t* Xb = X + mb;
#pragma unroll
            for (int gi = 0; gi < 4; ++gi)
#pragma unroll
                for (int t = 0; t < 4; ++t) { constexpr int dummy = 0; (void)dummy; const int off = GS * gi + 16 * t;
                    GateRaw r; r.raw = *(const u32x2*)(Xb + off);
                    const unsigned xm = (unsigned)Xb[off - 1]; unsigned xp = (unsigned)Xb[off + 4];
                    if (mb + off + 4 >= L) xp = 0u;
                    r.halo = xm | (xp << 16); gt[gi][t] = r; }
        }
        const GateRaw gtm = gate_load(X, 4 * g, L);
        f32x4 macc = (f32x4){0.f, 0.f, 0.f, 0.f};
#pragma unroll 1
        for (int t = w; t <= S_HI / 32; t += 8) {
            bf16x8 Am; GATHER(Am, -32 * t);
            const bf16x8 B = *(const LAS bf16x8*)(lds + ubm + t * 64);
            macc = __builtin_amdgcn_mfma_f32_16x16x32_bf16(Am, B, macc, 0, 0, 0);
        }
        *(LAS f32x4*)(lds + RED_OFF + (w * 64 + lane) * 16) = macc;
        __syncthreads();
        if (w == 0 && q == 0) {
            f32x4 s = (f32x4){0.f, 0.f, 0.f, 0.f};
#pragma unroll
            for (int ww = 0; ww < 8; ++ww) s += *(const LAS f32x4*)(lds + RED_OFF + (ww * 64 + lane) * 16);
            const int m = 4 * g;
            const f32x4 z = gate_eval(gtm, w0, w1, w2, bb) * s;
            u32x2 pk; pk.x = cvtpk(z[0], z[1]); pk.y = cvtpk(z[2], z[3]);
            if (o == 0) *(LAS u32x2*)(lds + U_OFF + (b * LPD + PADL + m) * 2) = pk;
            else *(u32x2*)(V + xrow_off + m) = pk;
        }
#pragma unroll
        for (int gi = 0; gi < 4; ++gi)
#pragma unroll
            for (int t = 0; t < 4; ++t) {
                const int m = mw + GS * gi + 16 * t + QS * q + 4 * g;
                const f32x4 z = gate_eval(gt[gi][t], w0, w1, w2, bb) * acc[gi][t];
                u32x2 pk; pk.x = cvtpk(z[0], z[1]); pk.y = cvtpk(z[2], z[3]);
                if (o == 0) *(LAS u32x2*)(lds + U_OFF + (b * LPD + PADL + m) * 2) = pk;
                else *(u32x2*)(V + xrow_off + m) = pk;
            }
        __syncthreads();
    }
#undef GATHER
#undef ARAW
#undef AFIN
}
__device__ __forceinline__ void conv_phase(LAS unsigned char* lds, const Args& a, int j, int bid, int G, int tid) {
#pragma unroll 1
    for (int u0 = bid; u0 < 3072; u0 += G) {
        const int u = u0;
        int tl = tid; asm volatile("" : "+v"(tl));
        if (u < 1024) conv_unit<4, 4, L_P>(lds, a, j, 0, u, tl);
        else { const int v = u - 1024; conv_unit<2, 8, L_S>(lds, a, j, 4 + 8 * (v & 1), v >> 1, tl); }
    }
}

__device__ __forceinline__ void transpose_phase(LAS unsigned char* lds, const Args& a, int bid, int G, int tid) {
    const bf16_t* ZT = (const bf16_t*)(a.ws + WS_R3); bf16_t* OUT = (bf16_t*)(a.ws + WS_R1);
    constexpr int TP = 129, TS = 65, UP = 4 * TP * 4, US = 16 * TS * 4, TILEB = 256 * 72 * 2;
#define TR_DECODE(u, s, p0, np, c0) do { int _cq, _tt; if ((u) < UP) { _cq = (u) & 3; const int _v = (u) >> 2; s = _v / TP; _tt = _v % TP; } \
        else { const int _r = (u) - UP; _cq = _r & 3; const int _v = _r >> 2; s = 4 + _v / TS; _tt = _v % TS; } \
        p0 = _tt == 0 ? 0 : 16 + 64 * (_tt - 1); np = _tt == 0 ? 16 : 64; c0 = _cq * 256; } while (0)
#define TR_LOAD(u) do { int _s, _p0, _np, _c0; TR_DECODE(u, _s, _p0, _np, _c0); const int _LS = seq_LS(_s), _nq = _np / 4; \
        const bf16_t* _src = ZT + seq_off_ch(_s) + (size_t)_c0 * _LS + XPAD + _p0; \
        _Pragma("unroll") for (int _k = 0; _k < 8; ++_k) { const int _task = _k * 512 + tid; const int _ch = _task / _nq, _pc = _task % _nq; \
            rg[_k] = (_task < 256 * _nq) ? *(const u32x2*)(_src + (size_t)_ch * _LS + 4 * _pc) : (u32x2){0u, 0u}; } } while (0)
    u32x2 rg[8];
    int u = bid, par = 0;
    if (u < UP + US) TR_LOAD(u);
#pragma unroll 1
    for (; u < UP + US; u += G, par ^= 1) {
        int s, p0, np, c0; TR_DECODE(u, s, p0, np, c0);
        const int nq = np / 4; LAS unsigned char* tile = lds + par * TILEB;
#pragma unroll
        for (int k = 0; k < 8; ++k) { const int task = k * 512 + tid; const int ch = task / nq, pc = task % nq;
            if (task < 256 * nq) *(LAS u32x2*)(tile + (ch * 72 + 4 * pc) * 2) = rg[k]; }
        __syncthreads();
        if (u + G < UP + US) TR_LOAD(u + G);
        for (int task = tid; task < np * 32; task += 512) { const int pos = task % np, cc = task / np;
            const LAS unsigned short* t = (const LAS unsigned short*)(tile + ((8 * cc) * 72 + pos) * 2);
            u32x4 o; o.x = (unsigned)t[0] | ((unsigned)t[72] << 16); o.y = (unsigned)t[144] | ((unsigned)t[216] << 16);
            o.z = (unsigned)t[288] | ((unsigned)t[360] << 16); o.w = (unsigned)t[432] | ((unsigned)t[504] << 16);
            *(u32x4*)(OUT + (size_t)seq_row(s, p0 + pos) * DM + c0 + 8 * cc) = o; }
    }
    __syncthreads();
#undef TR_DECODE
#undef TR_LOAD
}

__device__ __forceinline__ void attn_phase(LAS unsigned char* lds, const Args& a, int j, int bid, int G, int tid) {
    constexpr int KN_OFF = 0, KSTR = 144, VT_OFF = 59904, VSTR = 848, BT_OFF = 114176;
    const bf16_t* QK = (const bf16_t*)(a.ws + WS_R1); const bf16_t* VTg = (const bf16_t*)(a.ws + WS_VT); bf16_t* O = (bf16_t*)(a.ws + WS_R3);
    const float* rel_bias = a.in[3]; const float* qg = a.in[19] + j * 64; const float* kg = a.in[20] + j * 64; const float* sink = a.in[21] + j * 16;
    const int lane = tid & 63, w = __builtin_amdgcn_readfirstlane(tid >> 6), r = lane & 15, g = lane >> 4;
    LAS float* BT = (LAS float*)(lds + BT_OFF);
    if (tid < 64) { float mq = fabsf(qg[tid]), mk = fabsf(kg[tid]);
#pragma unroll
        for (int o = 1; o < 64; o <<= 1) { mq = fmaxf(mq, __shfl_xor(mq, o)); mk = fmaxf(mk, __shfl_xor(mk, o)); }
        if (tid == 0) BT[16 * 257] = 8.0f * mq * mk; }
    __syncthreads();
    {
        const float shift0 = BT[16 * 257];
        for (int i = tid; i < 16 * 257; i += 512) { const int h = i / 257, rel = i % 257 - 128; BT[i] = (rel_bias[t5_bucket(rel) * 16 + h] - shift0) * 1.4426950408889634f; }
    }
    __syncthreads();
    constexpr int NU = (4 * 65 + 16 * 33) * 4;
    for (int u = bid; u < NU; u += G) {
        const int hk = u & 3; int v = u >> 2, seq, qb, L;
        if (v < 260) { seq = v / 65; qb = v % 65; L = L_P; } else { v -= 260; seq = 4 + v / 33; qb = v % 33; L = L_S; }
        const int start = qb * 128 - 128;
        {
            const bf16_t* vb = VTg + seq_off_ch(seq) / 4 + (size_t)(hk * 64) * seq_LS(seq) + XPAD;
            const int LS = seq_LS(seq);
            u32x4 kraw[7], vraw[7];
#pragma unroll
            for (int it = 0; it < 7; ++it) {
                const int idx = it * 512 + tid;
                { const int slot = idx >> 3, dc = idx & 7; const int pos = slot < 16 ? slot : start + slot - 16;
                  const bool valid = (idx < 416 * 8) && (slot < 16 || (slot < 400 && pos >= 16 && pos < L));
                  kraw[it] = (u32x4){0u, 0u, 0u, 0u};
                  if (valid) kraw[it] = *(const u32x4*)(QK + (size_t)seq_row(seq, pos) * 1280 + 1024 + hk * 64 + dc * 8); }
                { const int d = idx / 52, c8 = idx % 52; const int pos0 = c8 < 2 ? 8 * c8 : start + 8 * c8 - 16;
                  const bool valid = (idx < 64 * 52) && (c8 < 2 || (c8 < 50 && pos0 >= 16 && pos0 < L));
                  vraw[it] = (u32x4){0u, 0u, 0u, 0u};
                  if (valid) vraw[it] = *(const u32x4*)(vb + (size_t)d * LS + pos0); }
            }
#pragma unroll
            for (int it = 0; it < 7; ++it) {
                const int idx = it * 512 + tid;
                const int slot = idx >> 3, dc = idx & 7;
                const u32x4 raw = kraw[it];
                float x[8] = {bflo(raw.x), bfhi(raw.x), bflo(raw.y), bfhi(raw.y), bflo(raw.z), bfhi(raw.z), bflo(raw.w), bfhi(raw.w)};
                float ss = 0.f;
#pragma unroll
                for (int i = 0; i < 8; ++i) ss += x[i] * x[i];
                ss += __shfl_xor(ss, 1); ss += __shfl_xor(ss, 2); ss += __shfl_xor(ss, 4);
                const float ri = __builtin_amdgcn_rsqf(ss * (1.0f / 64.0f) + EPS);
                const f32x4 g0 = *(const f32x4*)(kg + dc * 8), g1 = *(const f32x4*)(kg + dc * 8 + 4);
                u32x4 o; o.x = cvtpk(x[0] * ri * g0[0], x[1] * ri * g0[1]); o.y = cvtpk(x[2] * ri * g0[2], x[3] * ri * g0[3]);
                o.z = cvtpk(x[4] * ri * g1[0], x[5] * ri * g1[1]); o.w = cvtpk(x[6] * ri * g1[2], x[7] * ri * g1[3]);
                if (idx < 416 * 8) *(LAS u32x4*)(lds + KN_OFF + slot * KSTR + dc * 16) = o;
                const int d = idx / 52, c8 = idx % 52;
                if (idx < 64 * 52) *(LAS u32x4*)(lds + VT_OFF + d * VSTR + c8 * 16) = vraw[it];
            }
        }
        __syncthreads();
        const int q0 = qb * 128 + 16 * w;
        if (q0 < L) {
            const int qpos = q0 + r;
            const int fb = (16 + 16 * w) >> 5, cb = fb < 1 ? 1 : fb;
            const bf16_t* qrow = QK + (size_t)seq_row(seq, qpos) * 1280 + hk * 256;
            u32x4 qn0 = *(const u32x4*)(qrow + 8 * g), qn1 = *(const u32x4*)(qrow + 32 + 8 * g);
#pragma unroll 1
            for (int hh = 0; hh < 4; ++hh) {
                const int head = hk * 4 + hh;
                bf16x8 qf0, qf1;
                {
                    const u32x4 r0 = qn0, r1 = qn1;
                    { const int hn = hh < 3 ? hh + 1 : 3;
                      qn0 = *(const u32x4*)(qrow + hn * 64 + 8 * g); qn1 = *(const u32x4*)(qrow + hn * 64 + 32 + 8 * g); }
                    float x[16] = {bflo(r0.x), bfhi(r0.x), bflo(r0.y), bfhi(r0.y), bflo(r0.z), bfhi(r0.z), bflo(r0.w), bfhi(r0.w),
                                   bflo(r1.x), bfhi(r1.x), bflo(r1.y), bfhi(r1.y), bflo(r1.z), bfhi(r1.z), bflo(r1.w), bfhi(r1.w)};
                    float ss = 0.f;
#pragma unroll
                    for (int i = 0; i < 16; ++i) ss += x[i] * x[i];
                    ss += __shfl_xor(ss, 16); ss += __shfl_xor(ss, 32);
                    const float ri = __builtin_amdgcn_rsqf(ss * (1.0f / 64.0f) + EPS) * (0.125f * 1.4426950408889634f);
                    const f32x4 ga = *(const f32x4*)(qg + 8 * g), gb = *(const f32x4*)(qg + 8 * g + 4), gc = *(const f32x4*)(qg + 32 + 8 * g), gd = *(const f32x4*)(qg + 36 + 8 * g);
                    u32x4 p0, p1;
                    p0.x = cvtpk(x[0] * ri * ga[0], x[1] * ri * ga[1]); p0.y = cvtpk(x[2] * ri * ga[2], x[3] * ri * ga[3]);
                    p0.z = cvtpk(x[4] * ri * gb[0], x[5] * ri * gb[1]); p0.w = cvtpk(x[6] * ri * gb[2], x[7] * ri * gb[3]);
                    p1.x = cvtpk(x[8] * ri * gc[0], x[9] * ri * gc[1]); p1.y = cvtpk(x[10] * ri * gc[2], x[11] * ri * gc[3]);
                    p1.z = cvtpk(x[12] * ri * gd[0], x[13] * ri * gd[1]); p1.w = cvtpk(x[14] * ri * gd[2], x[15] * ri * gd[3]);
                    qf0 = __builtin_bit_cast(bf16x8, p0); qf1 = __builtin_bit_cast(bf16x8, p1);
                }
                const LAS float* bt = BT + head * 257 + 128;
                const float shift = BT[16 * 257];
                const float sk = sink[head];
                float den = 0.f;
                f32x4 oacc[4];
#pragma unroll
                for (int dt = 0; dt < 4; ++dt) oacc[dt] = (f32x4){0.f, 0.f, 0.f, 0.f};
                const int lkoff = KN_OFF + (8 * (r >> 2) + (r & 3)) * KSTR + 16 * g;
                const int lvoff = VT_OFF + r * VSTR + 16 * g;
                const int lb = 8 * g - r;
#pragma unroll 2
                for (int i = 0; i < 10; ++i) {
                    const int chunk = i == 0 ? 0 : cb + i - 1;
                    const int kb = lkoff + 32 * chunk * KSTR;
                    const bf16x8 k00 = *(const LAS bf16x8*)(lds + kb), k01 = *(const LAS bf16x8*)(lds + kb + 64);
                    const bf16x8 k10 = *(const LAS bf16x8*)(lds + kb + 4 * KSTR), k11 = *(const LAS bf16x8*)(lds + kb + 4 * KSTR + 64);
                    f32x4 s0 = (f32x4){0.f, 0.f, 0.f, 0.f}, s1 = (f32x4){0.f, 0.f, 0.f, 0.f};
                    s0 = __builtin_amdgcn_mfma_f32_16x16x32_bf16(k00, qf0, s0, 0, 0, 0);
                    s1 = __builtin_amdgcn_mfma_f32_16x16x32_bf16(k10, qf0, s1, 0, 0, 0);
                    s0 = __builtin_amdgcn_mfma_f32_16x16x32_bf16(k01, qf1, s0, 0, 0, 0);
                    s1 = __builtin_amdgcn_mfma_f32_16x16x32_bf16(k11, qf1, s1, 0, 0, 0);
                    const int cs = start - 16 - q0 + 32 * chunk + lb;
                    float p[8];
                    const int pmin = start + 32 * chunk - 16;
                    const bool interior = (chunk > 0) && (pmin >= q0 + 15 - 128) && (pmin + 31 <= q0 + 128) && (pmin >= 16) && (pmin + 31 < L);
                    if (interior) {
#pragma unroll
                        for (int e = 0; e < 8; ++e) {
                            const float sv = e < 4 ? s0[e & 3] : s1[e & 3];
                            p[e] = __builtin_amdgcn_exp2f(sv + bt[cs + e]);
                            den += p[e];
                        }
                    } else {
                        const bool metal = (chunk == 0) && (g < 2);
#pragma unroll
                        for (int e = 0; e < 8; ++e) {
                            const float sv = e < 4 ? s0[e & 3] : s1[e & 3];
                            const int relb = cs + e, pos = relb + qpos;
                            const int relm = 8 * g + e - qpos;
                            const bool bvalid = ((unsigned)(relb + 128) <= 256u) && ((unsigned)(pos - 16) < (unsigned)(L - 16));
                            const int rel = metal ? relm : relb;
                            const bool valid = metal || bvalid;
                            const int relc = rel < -128 ? -128 : (rel > 128 ? 128 : rel);
                            const float val = __builtin_amdgcn_exp2f(sv + bt[relc]);
                            p[e] = valid ? val : 0.f;
                            den += p[e];
                        }
                    }
                    u32x4 pp; pp.x = cvtpk(p[0], p[1]); pp.y = cvtpk(p[2], p[3]); pp.z = cvtpk(p[4], p[5]); pp.w = cvtpk(p[6], p[7]);
                    const bf16x8 pa = __builtin_bit_cast(bf16x8, pp);
                    const int vbo = lvoff + 64 * chunk;
#pragma unroll
                    for (int dt = 0; dt < 4; ++dt) {
                        const bf16x8 vb = *(const LAS bf16x8*)(lds + vbo + dt * 16 * VSTR);
                        oacc[dt] = __builtin_amdgcn_mfma_f32_16x16x32_bf16(pa, vb, oacc[dt], 0, 0, 0);
                    }
                }
                den += __shfl_xor(den, 16); den += __shfl_xor(den, 32);
                den += __builtin_amdgcn_exp2f((sk - shift) * 1.4426950408889634f);
                const float inv = 1.0f / den;
#pragma unroll
                for (int ii = 0; ii < 4; ++ii) {
                    const float iv = __shfl(inv, 4 * g + ii);
                    bf16_t* op = O + (size_t)seq_row(seq, q0 + 4 * g + ii) * DM + head * 64 + r;
#pragma unroll
                    for (int dt = 0; dt < 4; ++dt) op[dt * 16] = (bf16_t)(cvtpk(oacc[dt][ii] * iv, 0.f) & 0xffffu);
                }
            }
        }
        __syncthreads();
    }
}

#define XB_TMO      128
#define XB_XCNT(j)  (256  + 64 * (j))
#define XB_XSUB(j)  (1280 + 64 * (j))
#define XB_XGEN(j)  (2304 + 64 * (j))
#define XB_TOP      3328
#define XB_TOPGEN   3392
#define XCD_BAR_WORDS 3456
#define XB_SPIN_CAP (1u << 18)

__device__ __forceinline__ unsigned xb_ld(unsigned* p)              { return __hip_atomic_load(p, __ATOMIC_RELAXED, __HIP_MEMORY_SCOPE_AGENT); }
__device__ __forceinline__ unsigned xb_add(unsigned* p, unsigned v) { return __hip_atomic_fetch_add(p, v, __ATOMIC_RELAXED, __HIP_MEMORY_SCOPE_AGENT); }
__device__ __forceinline__ unsigned xb_xcc_id() { return (unsigned)__builtin_amdgcn_s_getreg((3 << 11) | 20) & 0xFu; }
#define XB_SPIN(cond, bar) do { unsigned _sp = 0; while (cond) { __builtin_amdgcn_s_sleep(1); \
    if ((++_sp & 255u) == 0u) { if (xb_ld(&(bar)[XB_TMO])) break; if (_sp > XB_SPIN_CAP) { atomicAdd(&(bar)[XB_TMO], 1u); break; } } } } while (0)

struct XcdBarrier {
    unsigned* bar; unsigned x;
    volatile LAS unsigned* st;
};

__device__ __forceinline__ XcdBarrier xcd_barrier_post(unsigned* bar, volatile LAS unsigned* st) {
    XcdBarrier b; b.bar = bar; b.x = xb_xcc_id(); b.st = st;
    if (threadIdx.x == 0) (void)xb_add(&bar[XB_XCNT(b.x)], 1u);
    return b;
}
__device__ __forceinline__ void xcd_barrier_complete(unsigned* bar, unsigned x, unsigned& nloc, unsigned& nx) {
    const unsigned G = gridDim.x * gridDim.y * gridDim.z;
    unsigned sum, cnt, mine, sp = 0u;
    for (;;) {
        sum = 0u; cnt = 0u; mine = 0u;
#pragma unroll
        for (unsigned j = 0; j < 16; ++j) { const unsigned c = xb_ld(&bar[XB_XCNT(j)]); sum += c; cnt += (c > 0u) ? 1u : 0u; mine = (j == x) ? c : mine; }
        if (sum == G) break;
        __builtin_amdgcn_s_sleep(1);
        if ((++sp & 255u) == 0u) { if (xb_ld(&bar[XB_TMO])) break; if (sp > XB_SPIN_CAP) { atomicAdd(&bar[XB_TMO], 1u); break; } }
    }
    nloc = mine > 0u ? mine : 1u; nx = cnt > 0u ? cnt : 1u;
}

__device__ __forceinline__ void xcd_barrier(const XcdBarrier& b) {
    asm volatile("s_waitcnt vmcnt(0)" ::: "memory");
    __syncthreads();
    if (threadIdx.x == 0) {
        unsigned* bar = b.bar;
        __builtin_amdgcn_s_waitcnt(0);
        unsigned nloc = b.st[0], nx = b.st[1];
        if (nloc == 0u) { xcd_barrier_complete(bar, b.x, nloc, nx); b.st[0] = nloc; b.st[1] = nx; }
        const unsigned old = xb_add(&bar[XB_XSUB(b.x)], 1u);
        const unsigned gen = old / nloc;
        if (old + 1u == (gen + 1u) * nloc) {
            __builtin_amdgcn_fence(__ATOMIC_RELEASE, "agent");
            asm volatile("s_waitcnt vmcnt(0)" ::: "memory");
            const unsigned og = xb_add(&bar[XB_TOP], 1u);
            const unsigned tg = og / nx;
            if (og + 1u == (tg + 1u) * nx) xb_add(&bar[XB_TOPGEN], 1u);
            else XB_SPIN(xb_ld(&bar[XB_TOPGEN]) == tg, bar);
            __builtin_amdgcn_fence(__ATOMIC_ACQUIRE, "agent");
            xb_add(&bar[XB_XGEN(b.x)], 1u);
            asm volatile("s_waitcnt vmcnt(0)" ::: "memory");
        } else {
            XB_SPIN(xb_ld(&bar[XB_XGEN(b.x)]) == gen, bar);
            __builtin_amdgcn_fence(__ATOMIC_ACQUIRE, "agent");
            asm volatile("s_waitcnt vmcnt(0)" ::: "memory");
        }
    }
    __syncthreads();
}

constexpr int LDS_XB_OFF = 147456 - 64;
#ifndef PHMASK
#define PHMASK 0xFFFF
#endif
#define PH(b) if constexpr ((PHMASK >> (b)) & 1)
#define GRID_SYNC() do { XcdBarrier _b; { kargs_t _p = (kargs_t)__builtin_amdgcn_kernarg_segment_ptr(); asm volatile("" : "+s"(_p)); _b.bar = (unsigned*)_p->ws; } _b.x = xb_xcc_id(); _b.st = (volatile LAS unsigned*)(lds + LDS_XB_OFF); xcd_barrier(_b); } while (0)
#define GRID_SYNC_CG() do { asm volatile("s_waitcnt vmcnt(0) lgkmcnt(0)" ::: "memory"); grid.sync(); if ((threadIdx.x >> 6) == 0) { __builtin_amdgcn_fence(__ATOMIC_ACQUIRE, "agent"); asm volatile("s_waitcnt vmcnt(0)" ::: "memory"); } __syncthreads(); } while (0)
typedef const __attribute__((address_space(4))) Args* kargs_t;
__device__ __forceinline__ Args get_args() {
    kargs_t p = (kargs_t)__builtin_amdgcn_kernarg_segment_ptr();
    asm volatile("" : "+s"(p));
    Args a;
#pragma unroll
    for (int i = 0; i < 25; ++i) a.in[i] = p->in[i];
    a.out = p->out; a.ws = p->ws; a.layer_lo = p->layer_lo; a.layer_hi = p->layer_hi;
    return a;
}
__device__ __forceinline__ EpiResid make_resid(const Args& a, int layer, int which  , int rb) {
    u64* rowss = (u64*)(a.ws + WS_ROWSS); float* metah = (float*)(a.ws + WS_METAH);
    EpiResid e;
    const bool first = (layer == 0 && which == 0);
    e.srcA = first ? a.in[0] : a.out; e.srcB = first ? a.in[1] : a.out + (size_t)ROWS_P * DM; e.srcM = first ? a.in[2] : metah; e.meta_mask = first ? 15 : 0xffff;
    e.dstMain = a.out; e.dstM = metah;
    const int nxt = 2 * layer + 1 + which;
    e.P = nxt < 8 ? (bf16_t*)(a.ws + WS_P) : nullptr; e.rowss_next = nxt < 8 ? rowss + (size_t)nxt * MPAD : nullptr; e.row_base = rb;
    return e;
}
__global__ void __launch_bounds__(512, 2) fwd_megakernel(Args a_unused) {
    extern __shared__ __attribute__((aligned(16))) unsigned char lds_raw[];
    LAS unsigned char* lds = (LAS unsigned char*)lds_raw;
    cg::grid_group grid = cg::this_grid();
    const int G0 = gridDim.x, bid0 = blockIdx.x;
    volatile LAS unsigned* xst = (volatile LAS unsigned*)(lds + LDS_XB_OFF);
    if (threadIdx.x < 2) xst[threadIdx.x] = 0u;
    __syncthreads();
    (void)xcd_barrier_post((unsigned*)a_unused.ws, xst);

    const int layer_lo = a_unused.layer_lo, layer_hi = a_unused.layer_hi;
    if (layer_lo == 0) {
        const Args a = get_args(); const int tid = ltid(), G = lsg(G0), bid = lsg(bid0);
        const int lane = tid & 63, wave = __builtin_amdgcn_readfirstlane(tid >> 6);
        const int gw = bid * 7 + wave, NGW = G * 7;
        u64* rowss = (u64*)(a.ws + WS_ROWSS);
        bf16_t* Wb = (bf16_t*)(a.ws + WS_W);
        bf16_t* P = (bf16_t*)(a.ws + WS_P);
        for (size_t i = (size_t)bid * 512 + tid; i < (size_t)7 * MPAD; i += (size_t)G * 512) rowss[MPAD + i] = 0ull;
        if (wave == 7) {
            PH(1) for (int task = bid; task < 2 * 193; task += G) h2_features(lds + 7 * 16384, a, task / 193, (task % 193) * 64 + lane, lane);
        } else
        PH(0) {
        LAS float* scr = (LAS float*)(lds + wave * 16384);
#pragma unroll 1
        for (int j = 0; j < 2; ++j) {
            convert_matrix(a.in[6] + (size_t)j * 1024 * 3072, a.in[4] + (2 * j) * 1024, 1024, 3072, (bf16_t*)((char*)Wb + W_IN + (size_t)j * 6 * MiB), scr, gw, NGW, lane);
            convert_matrix(a.in[17] + (size_t)j * 1024 * 1024, nullptr, 1024, 1024, (bf16_t*)((char*)Wb + W_HOUT + (size_t)j * 2 * MiB), scr, gw, NGW, lane);
            convert_matrix(a.in[18] + (size_t)j * 1024 * 1536, a.in[4] + (2 * j + 1) * 1024, 1024, 1536, (bf16_t*)((char*)Wb + W_QKV + (size_t)j * 3 * MiB), scr, gw, NGW, lane);
            convert_matrix(a.in[22] + (size_t)j * 1024 * 1024, nullptr, 1024, 1024, (bf16_t*)((char*)Wb + W_AOUT + (size_t)j * 2 * MiB), scr, gw, NGW, lane);
        }
#pragma unroll 1
        for (int i = 0; i < 4; ++i) {
            convert_matrix(a.in[23] + (size_t)i * 1024 * 4096, a.in[5] + i * 1024, 1024, 4096, (bf16_t*)((char*)Wb + W_UP + (size_t)i * 8 * MiB), scr, gw, NGW, lane);
            convert_matrix(a.in[24] + (size_t)i * 4096 * 1024, nullptr, 4096, 1024, (bf16_t*)((char*)Wb + W_DN + (size_t)i * 8 * MiB), scr, gw, NGW, lane);
        }
        for (int row0 = gw; row0 < MREAL; row0 += 4 * NGW) {
            f32x4 v[4][4];
#pragma unroll
            for (int rr = 0; rr < 4; ++rr) {
                const int row = row0 + rr * NGW, rowc = row < MREAL ? row : MREAL - 1;
                const float* src = rowc < ROWS_P ? a.in[0] + (size_t)rowc * DM : (rowc < ROWS_MAIN ? a.in[1] + (size_t)(rowc - ROWS_P) * DM : a.in[2] + (size_t)((rowc - ROWS_MAIN) & 15) * DM);
#pragma unroll
                for (int k = 0; k < 4; ++k) v[rr][k] = *(const f32x4*)(src + k * 256 + lane * 4);
            }
#pragma unroll
            for (int rr = 0; rr < 4; ++rr) {
                const int row = row0 + rr * NGW;
                float ss = 0.f;
#pragma unroll
                for (int k = 0; k < 4; ++k) { const f32x4 x = v[rr][k];
                    ss += (x[0] * x[0] + x[1] * x[1]) + (x[2] * x[2] + x[3] * x[3]);
                    u32x2 pk; pk.x = cvtpk(x[0], x[1]); pk.y = cvtpk(x[2], x[3]);
                    if (row < MREAL) *(u32x2*)(P + (size_t)row * DM + k * 256 + lane * 4) = pk; }
                ss = wave_sum(ss);
                if (lane == 0 && row < MREAL) rowss[row] = (u64)(ss * SS_SCALE);
            }
        }
        }
        GRID_SYNC_CG();
    }

#pragma unroll 1
    for (int layer = layer_lo; layer < layer_hi; ++layer) {
        if ((layer & 1) == 0) {
            {
                const Args a = get_args(); const int tid = ltid(), G = lsg(G0), bid = lsg(bid0); const int j = layer >> 1;
                PH(2) fk_compute(a, j, bid * 8 + __builtin_amdgcn_readfirstlane(tid >> 6), G * 8, tid & 63);
                PH(3) {
                pg8::Gemm g{(const bf16_t*)(a.ws + WS_P), (const bf16_t*)(a.ws + WS_W + W_IN + (size_t)j * 6 * MiB), MPAD, 3072, 1024, 1024, 1024}; pg8::StaticOrder S; S.init(MPAD, 3072, G, bid);
                EpiHyIn E{(bf16_t*)(a.ws + WS_R1), (const u64*)(a.ws + WS_ROWSS) + (size_t)(2 * layer) * MPAD};
                pg8::gemm_phase<EpiHyIn>(lds, g, S, E);
                }
            }
            GRID_SYNC();
            { const Args a = get_args(); const int tid = ltid(), G = lsg(G0), bid = lsg(bid0); PH(4) conv_phase(lds, a, layer >> 1, bid, G, tid); }
            GRID_SYNC();
            { const Args a = get_args(); const int tid = ltid(), G = lsg(G0), bid = lsg(bid0); PH(5) transpose_phase(lds, a, bid, G, tid); }
            GRID_SYNC();
            {
                const Args a = get_args(); const int tid = ltid(), G = lsg(G0), bid = lsg(bid0); const int j = layer >> 1;
                PH(6) {
                pg8::Gemm g{(const bf16_t*)(a.ws + WS_R1), (const bf16_t*)(a.ws + WS_W + W_HOUT + (size_t)j * 2 * MiB), MPAD, 1024, 1024, 1024, 1024}; pg8::StaticOrder S; S.init(MPAD, 1024, G, bid);
                const EpiResid er = make_resid(a, layer, 0, 0);
                pg8::gemm_phase<EpiResid>(lds, g, S, er);
                }
            }
            GRID_SYNC();
        } else {
            {
                const Args a = get_args(); const int tid = ltid(), G = lsg(G0), bid = lsg(bid0); const int j = layer >> 1;
                PH(7) {
                pg8::Gemm g{(const bf16_t*)(a.ws + WS_P), (const bf16_t*)(a.ws + WS_W + W_QKV + (size_t)j * 3 * MiB), MPAD, 1536, 1024, 1024, 1024}; pg8::StaticOrder S; S.init(MPAD, 1536, G, bid);
                EpiRow<0> E{(bf16_t*)(a.ws + WS_R1), (bf16_t*)(a.ws + WS_VT), (const u64*)(a.ws + WS_ROWSS) + (size_t)(2 * layer) * MPAD, 0};
                pg8::gemm_phase<EpiRow<0>>(lds, g, S, E);
                }
            }
            GRID_SYNC();
            { const Args a = get_args(); const int tid = ltid(), G = lsg(G0), bid = lsg(bid0); PH(8) attn_phase(lds, a, layer >> 1, bid, G, tid); }
            GRID_SYNC();
            {
                const Args a = get_args(); const int tid = ltid(), G = lsg(G0), bid = lsg(bid0); const int j = layer >> 1;
                PH(9) {
                pg8::Gemm g{(const bf16_t*)(a.ws + WS_R3), (const bf16_t*)(a.ws + WS_W + W_AOUT + (size_t)j * 2 * MiB), MPAD, 1024, 1024, 1024, 1024}; pg8::StaticOrder S; S.init(MPAD, 1024, G, bid);
                const EpiResid er = make_resid(a, layer, 0, 0);
                pg8::gemm_phase<EpiResid>(lds, g, S, er);
                }
            }
            GRID_SYNC();
        }
#pragma unroll 1
        for (int half = 0; half < 2; ++half) {
            const int rb = half * MT_H0 * 256; const int mrows = (half == 0 ? MT_H0 : MT_H1) * 256;
            {
                const Args a = get_args(); const int tid = ltid(), G = lsg(G0), bid = lsg(bid0);
                PH(10) {
                pg8::Gemm g{(const bf16_t*)(a.ws + WS_P) + (size_t)rb * DM, (const bf16_t*)(a.ws + WS_W + W_UP + (size_t)layer * 8 * MiB), mrows, 4096, 1024, 1024, 1024}; pg8::StaticOrder S; S.init(mrows, 4096, G, bid);
                EpiRow<1> E{(bf16_t*)(a.ws + WS_R1), nullptr, (const u64*)(a.ws + WS_ROWSS) + (size_t)(2 * layer + 1) * MPAD, rb};
                pg8::gemm_phase<EpiRow<1>>(lds, g, S, E);
                }
            }
            GRID_SYNC();
            {
                const Args a = get_args(); const int tid = ltid(), G = lsg(G0), bid = lsg(bid0);
                PH(11) {
                const int drows = MT_H0 * 256;
                pg8::Gemm g{(const bf16_t*)(a.ws + WS_R1), (const bf16_t*)(a.ws + WS_W + W_DN + (size_t)layer * 8 * MiB), drows, 1024, 4096, 4096, 4096}; pg8::StaticOrder S; S.init(drows, 1024, G, bid);
                const EpiResid e2 = make_resid(a, layer, 1, rb);
                pg8::gemm_phase<EpiResid>(lds, g, S, e2);
                }
            }
            if (half == 1) {
                {
                    const Args a = get_args(); const int G = lsg(G0), bid = lsg(bid0);
                    PH(11) {
                    pg8::Gemm g2{(const bf16_t*)(a.ws + WS_R1) + (size_t)(MT_H0 * 256) * DFF, (const bf16_t*)(a.ws + WS_W + W_DN + (size_t)layer * 8 * MiB), 512, 1024, 4096 / DOWN_KS, 4096, 4096};
                    pg8::StaticOrder S2; S2.init_ks(512, 1024, DOWN_KS, G, bid);
                    EpiPartial ep{(float*)(a.ws + WS_R3)};
                    pg8::gemm_phase<EpiPartial>(lds, g2, S2, ep);
                    }
                }
                GRID_SYNC();
                const Args a = get_args(); const int tid = ltid(), G = lsg(G0), bid = lsg(bid0);
                const int nxt = 2 * layer + 2;
                meta_reduce((const float*)(a.ws + WS_R3), (float*)(a.ws + WS_METAH), nxt < 8 ? (bf16_t*)(a.ws + WS_P) : nullptr,
                            nxt < 8 ? (u64*)(a.ws + WS_ROWSS) + (size_t)nxt * MPAD : nullptr, bid * 8 + (tid >> 6), G * 8, tid & 63);
            }
            if (!(layer == layer_hi - 1 && half == 1)) GRID_SYNC();
        }
    }
}

constexpr int LDS_BYTES = 147456;
extern "C" void kernel_launch(void* const* d_in, const int* in_sizes, int n_in, void* d_out, int out_size, void* d_ws, size_t ws_size, hipStream_t stream) {
    static int grid = 0;
    if (grid == 0) {
        if (n_in != 25 || ws_size < WS_END) { fprintf(stderr, "kernel_launch: unexpected n_in %d or ws_size %zu (need %zu)\n", n_in, ws_size, (size_t)WS_END); grid = -1; return; }
        int dev = 0, cus = 0, per_cu = 0;
        (void)hipGetDevice(&dev);
        (void)hipDeviceGetAttribute(&cus, hipDeviceAttributeMultiprocessorCount, dev);
        if (hipFuncSetAttribute((const void*)fwd_megakernel, hipFuncAttributeMaxDynamicSharedMemorySize, LDS_BYTES) != hipSuccess) { fprintf(stderr, "kernel_launch: hipFuncSetAttribute failed\n"); grid = -1; return; }
        if (hipOccupancyMaxActiveBlocksPerMultiprocessor(&per_cu, (const void*)fwd_megakernel, 512, LDS_BYTES) != hipSuccess || per_cu < 1) { fprintf(stderr, "kernel_launch: occupancy query gives %d\n", per_cu); per_cu = 1; }
        (void)hipGetLastError();
        grid = cus * 1;
        fprintf(stderr, "kernel_launch: cus %d per_cu %d grid %d\n", cus, per_cu, grid);
    }
    if (grid < 0) return;
    Args a{};
    for (int i = 0; i < 25; ++i) a.in[i] = (const float*)d_in[i];
    a.out = (float*)d_out; a.ws = (unsigned char*)d_ws;
#ifndef NSPLIT
#define NSPLIT 1
#endif
    (void)hipMemsetAsync(d_ws, 0, 16384, stream);
    for (int part = 0; part < NSPLIT; ++part) {
        a.layer_lo = part * (4 / NSPLIT); a.layer_hi = (part + 1) * (4 / NSPLIT);
        void* args[] = {&a};
        hipError_t e = hipLaunchCooperativeKernel((const void*)fwd_megakernel, dim3(grid), dim3(512), args, LDS_BYTES, stream);
        if (e != hipSuccess) fprintf(stderr, "cooperative launch failed: %s (grid %d)\n", hipGetErrorString(e), grid);
    }
}
```

```cpp
#include <hip/hip_runtime.h>
#include <hip/hip_cooperative_groups.h>
#include <cstdio>
#include <cstdint>
namespace cg = cooperative_groups;

#define LAS __attribute__((address_space(3)))
typedef unsigned short bf16_t;
typedef short bf16x8 __attribute__((ext_vector_type(8)));
typedef float f32x4 __attribute__((ext_vector_type(4)));
typedef float f32x2 __attribute__((ext_vector_type(2)));
typedef unsigned u32x4 __attribute__((ext_vector_type(4)));
typedef unsigned u32x2 __attribute__((ext_vector_type(2)));
typedef __bf16 bf16x2_t __attribute__((ext_vector_type(2)));
typedef unsigned long long u64;
typedef unsigned long long u64x2 __attribute__((ext_vector_type(2)));
constexpr float SS_SCALE = 1048576.0f, SS_INV = 1.0f / (1048576.0f * 1024.0f);
__device__ __forceinline__ float ss_rinv(u64 v) { return __builtin_amdgcn_rsqf((float)v * SS_INV + 1e-6f); }

constexpr int DM = 1024, DFF = 4096;
constexpr int L_P = 8208, L_S = 4112;
constexpr int LS_P = 8256, LS_S = 4160, XPAD = 48;
constexpr int ROWS_P = 32768, ROWS_MAIN = 98304, MREAL = 98624, MPAD = 98816;
constexpr int MT_ALL = MPAD / 256;
constexpr int MT_H0 = 192, MT_H1 = MT_ALL - MT_H0;
constexpr float EPS = 1e-6f;

constexpr size_t MiB = 1u << 20;
constexpr size_t WS_ROWSS = 1 * MiB;
constexpr size_t WS_METAH = 8 * MiB;
constexpr size_t WS_H2T = 10 * MiB;
constexpr size_t WS_W = 17 * MiB;
constexpr size_t WS_FK = 107 * MiB;
constexpr size_t WS_P = 211 * MiB;
constexpr size_t WS_R1 = 404 * MiB, WS_R2 = 599 * MiB, WS_R3 = 794 * MiB, WS_END = 989 * MiB;
constexpr size_t WS_VT = 703 * MiB;
constexpr size_t W_IN = 0, W_HOUT = 12 * MiB, W_QKV = 16 * MiB, W_AOUT = 22 * MiB, W_UP = 26 * MiB, W_DN = 58 * MiB;
constexpr int H2N = 12320;
constexpr int FK_OFFS_P = 8704, FK_LEN_P = 17408, FK_OFFS_S = 4608, FK_LEN_S = 9216;
constexpr size_t FK_SAMPLE_OFF = (size_t)2 * 1024 * FK_LEN_P;

struct Args { const float* in[25]; float* out; unsigned char* ws; int layer_lo, layer_hi; };

__device__ __forceinline__ unsigned cvtpk(float lo, float hi) { f32x2 v = {lo, hi}; bf16x2_t b = __builtin_convertvector(v, bf16x2_t); return __builtin_bit_cast(unsigned, b); }
__device__ __forceinline__ float bf2f(unsigned short x) { return __builtin_bit_cast(float, (unsigned)x << 16); }
__device__ __forceinline__ float bflo(unsigned x) { return __builtin_bit_cast(float, x << 16); }
__device__ __forceinline__ float bfhi(unsigned x) { return __builtin_bit_cast(float, x & 0xffff0000u); }
__device__ __forceinline__ int ltid() { int t = threadIdx.x; asm volatile("" : "+v"(t)); return t; }
__device__ __forceinline__ int lsg(int x) { asm volatile("" : "+s"(x)); return x; }
__device__ __forceinline__ int seq_L(int s) { return s < 4 ? L_P : L_S; }
__device__ __forceinline__ int seq_LS(int s) { return s < 4 ? LS_P : LS_S; }
__device__ __forceinline__ size_t seq_off_ch(int s) { return s < 4 ? (size_t)s * 1024 * LS_P : (size_t)4 * 1024 * LS_P + (size_t)(s - 4) * 1024 * LS_S; }
__device__ __forceinline__ int seq_row(int s, int p) { return p < 16 ? ROWS_MAIN + 16 * s + p : (s < 4 ? s * 8192 : 32768 + (s - 4) * 4096) + p - 16; }
__device__ __forceinline__ void row_decode(int row0, int& s, int& p0, int& L) {
    if (row0 < ROWS_P) { s = row0 >> 13; p0 = 16 + (row0 & 8191); L = L_P; }
    else if (row0 < ROWS_MAIN) { const int r = row0 - ROWS_P; s = 4 + (r >> 12); p0 = 16 + (r & 4095); L = L_S; }
    else { const int r = row0 - ROWS_MAIN; s = r >> 4; p0 = r & 15; L = s < 4 ? L_P : L_S; }
}
__device__ __forceinline__ float wave_sum(float v) {
#pragma unroll
    for (int o = 1; o < 64; o <<= 1) v += __shfl_xor(v, o);
    return v;
}
__device__ __forceinline__ void my_sincos(float x, float& s, float& c) {
    const float k = rintf(x * 0.636619772367581f);
    float r = fmaf(-k, 1.57079625129699707031f, x);
    r = fmaf(-k, 7.54978941586159635335e-08f, r);
    r = fmaf(-k, 5.39030285815811905290e-15f, r);
    const float r2 = r * r;
    const float sp = r + r * r2 * (-1.6666654611e-1f + r2 * (8.3321608736e-3f + r2 * -1.9515295891e-4f));
    const float cp = 1.0f - 0.5f * r2 + r2 * r2 * (4.166664568298827e-2f + r2 * (-1.388731625493765e-3f + r2 * 2.443315711809948e-5f));
    const int n = ((int)k) & 3;
    s = (n == 0) ? sp : (n == 1) ? cp : (n == 2) ? -sp : -cp;
    c = (n == 0) ? cp : (n == 1) ? -sp : (n == 2) ? -cp : sp;
}
__device__ __forceinline__ float my_sin(float x) { float s, c; my_sincos(x, s, c); return s; }
__device__ __forceinline__ int t5_bucket(int rel) {
    const int n = rel < 0 ? -rel : rel; int b;
    if (n < 8) b = n; else if (n < 12) b = 8; else if (n < 16) b = 9; else if (n < 23) b = 10; else if (n < 32) b = 11;
    else if (n < 46) b = 12; else if (n < 64) b = 13; else if (n < 91) b = 14; else b = 15;
    return (rel > 0 ? 16 : 0) + b;
}

namespace pg8 {
#define PG8_LAS __attribute__((address_space(3)))
constexpr int BM = 256, BK = 64, HALF = 128, HTB = HALF * BK * 2, STAGE_BYTES = 8 * HTB, NXCD = 8, WGM = 8;
__host__ __device__ __forceinline__ int lds_byte(int r, int c) { const int st = (r >> 4) * 2 + (c >> 5), rr = r & 15, cc = c & 31, ob = rr * 64 + cc * 2; return st * 1024 + (ob ^ (((ob >> 9) & 1) << 5)); }
__host__ __device__ __forceinline__ void stage_rc(int b, int& R, int& C) { const int st = b / 1024, sb = b % 1024, swz = sb ^ (((sb >> 9) & 1) << 5); R = (st >> 1) * 16 + swz / 64; C = (st & 1) * 32 + (swz % 64) / 2; }
__host__ __device__ __forceinline__ int perm32(int rho) { const int n = rho >> 4, i = rho & 15; return 8 * (i >> 2) + 4 * n + (i & 3); }
struct Unit { int pm, pn, ks; };
struct Gemm { const bf16_t* A; const bf16_t* Bt; int M, N, K; int lda, ldb; };
struct StaticOrder {
    int nM, nN, nwg, G, c, KS;
    __host__ __device__ void init(int M, int N, int G_, int c_) { nM = M / BM; nN = N / BM; nwg = nM * nN; G = G_; c = c_; KS = 1; }
    __host__ __device__ void init_ks(int M, int N, int KS_, int G_, int c_) { nM = M / BM; nN = N / BM; KS = KS_; nwg = nM * nN * KS; G = G_; c = c_; }
    __host__ __device__ bool next(int i, Unit& u) const {
        const long L = (long)i * G + c; if (L >= nwg) return false;
        u.ks = 0;
        if (KS > 1) { const int l = (int)L; u.ks = l % KS; const int t = l / KS; u.pm = t % nM; u.pn = t / nM; return true; }
        int wgid = (int)L; { const int q = nwg / NXCD, r = nwg % NXCD, xcd = wgid % NXCD, off = wgid / NXCD; wgid = (xcd < r ? xcd * (q + 1) : r * (q + 1) + (xcd - r) * q) + off; }
        const int nig = WGM * nN, gid = wgid / nig, fm = gid * WGM, gsz = (nM - fm) < WGM ? (nM - fm) : WGM;
        u.pm = fm + ((wgid % nig) % gsz); u.pn = (wgid % nig) / gsz; return true;
    }
};

template <class Epi, bool ALIGN_EPI = true>
__device__ __forceinline__ void gemm_phase(PG8_LAS unsigned char* lds, const Gemm g, const StaticOrder& S, const Epi& E) {
    const int tid = ltid(), wid = __builtin_amdgcn_readfirstlane(tid >> 6), lane = tid & 63, wr = wid >> 2, wc = wid & 3, fr = lane & 15, fq = lane >> 4;
    const int K = g.K, nt = K / BK;
    unsigned voffA[2], voffB[2];
#pragma unroll
    for (int i = 0; i < 2; ++i) { int R, C; stage_rc(tid * 16 + i * 8192, R, C); const int Rb = Epi::PERM ? ((R & ~31) + perm32(R & 31)) : R;
        voffA[i] = (unsigned)(R * g.lda + C) * 2u; voffB[i] = (unsigned)(Rb * g.ldb + C) * 2u; }
    const size_t kstep = (size_t)(BK * 2);
    const size_t hstepA = (size_t)HALF * g.lda * 2, hstepB = (size_t)HALF * g.ldb * 2;
    const size_t tstepA = 2 * hstepA, tstepB = 2 * hstepB, ksA = (size_t)K * 2;
    const unsigned ldsw = (unsigned)wid * 1024u;
    const int aoff = lds_byte(wr * 64 + fr, fq * 8), boff = lds_byte(wc * 32 + fr, fq * 8);
#define PG8_SA(b, h) (((b) * 2 + (h)) * HTB)
#define PG8_SB(b, h) ((4 + (b) * 2 + (h)) * HTB)
#define PG8_STAGE(bufoff, gbase, voff) do { _Pragma("unroll") for (int _i = 0; _i < 2; ++_i) \
        __builtin_amdgcn_global_load_lds((const unsigned*)((const char*)(gbase) + (voff)[_i]), (PG8_LAS unsigned*)(lds + (bufoff) + ldsw + _i * 8192), 16, 0, 0); } while (0)
#define PG8_LDA(dst, b, h) do { _Pragma("unroll") for (int m = 0; m < 4; ++m) _Pragma("unroll") for (int k = 0; k < 2; ++k) dst[m][k] = *(const PG8_LAS bf16x8*)(lds + PG8_SA(b, h) + aoff + m * 2048 + k * 1024); } while (0)
#define PG8_LDB(dst, b, h) do { _Pragma("unroll") for (int n = 0; n < 2; ++n) _Pragma("unroll") for (int k = 0; k < 2; ++k) dst[n][k] = *(const PG8_LAS bf16x8*)(lds + PG8_SB(b, h) + boff + n * 2048 + k * 1024); } while (0)
#define PG8_MMA(ai, bj, At, Bt) do { __builtin_amdgcn_s_setprio(1); _Pragma("unroll") for (int m = 0; m < 4; ++m) _Pragma("unroll") for (int n = 0; n < 2; ++n) _Pragma("unroll") for (int k = 0; k < 2; ++k) \
        acc[ai][bj][m][n] = Epi::SWAP ? __builtin_amdgcn_mfma_f32_16x16x32_bf16(Bt[n][k], At[m][k], acc[ai][bj][m][n], 0, 0, 0) \
                                      : __builtin_amdgcn_mfma_f32_16x16x32_bf16(At[m][k], Bt[n][k], acc[ai][bj][m][n], 0, 0, 0); __builtin_amdgcn_s_setprio(0); } while (0)
#define PG8_WAIT_V(n) asm volatile("s_waitcnt vmcnt(" #n ")" ::: "memory")
#define PG8_WAIT_L(n) asm volatile("s_waitcnt lgkmcnt(" #n ")" ::: "memory")
#define PG8_BAR __builtin_amdgcn_s_barrier()
#define PG8_SCHED __builtin_amdgcn_sched_barrier(0)
    Unit cur, nxt; int ui = 0;
    if (!S.next(0, cur)) return;
    f32x4 acc[2][2][4][2];
#pragma unroll
    for (int a = 0; a < 2; ++a)
#pragma unroll
        for (int b = 0; b < 2; ++b)
#pragma unroll
            for (int m = 0; m < 4; ++m)
#pragma unroll
                for (int n = 0; n < 2; ++n) acc[a][b][m][n] = (f32x4){0.f, 0.f, 0.f, 0.f};
    bf16x8 At[4][2], B0[2][2], B1[2][2];
    const char* cA = (const char*)g.A + (size_t)cur.pm * tstepA + (size_t)cur.ks * ksA; const char* cB = (const char*)g.Bt + (size_t)cur.pn * tstepB + (size_t)cur.ks * ksA;
    PG8_STAGE(PG8_SB(0, 0), cB, voffB); PG8_STAGE(PG8_SB(0, 1), cB + hstepB, voffB); PG8_STAGE(PG8_SA(0, 0), cA, voffA); PG8_STAGE(PG8_SA(0, 1), cA + hstepA, voffA);
    if (wr == 1) PG8_BAR;
    PG8_WAIT_V(2); PG8_BAR;
    PG8_STAGE(PG8_SB(1, 0), cB + kstep, voffB); PG8_STAGE(PG8_SA(1, 0), cA + kstep, voffA); PG8_STAGE(PG8_SB(1, 1), cB + hstepB + kstep, voffB);
    PG8_WAIT_V(6); PG8_BAR;
    for (;;) {
        const bool has_next = S.next(ui + 1, nxt);
        const char* nA = has_next ? (const char*)g.A + (size_t)nxt.pm * tstepA + (size_t)nxt.ks * ksA : cA; const char* nB = has_next ? (const char*)g.Bt + (size_t)nxt.pn * tstepB + (size_t)nxt.ks * ksA : cB;
        for (int t = 0; t < nt; t += 2) {
            const bool last = (t == nt - 2);
            const char* a1 = cA + (size_t)(t + 1) * kstep;
            const char* a2 = last ? nA : cA + (size_t)(t + 2) * kstep; const char* b2 = last ? nB : cB + (size_t)(t + 2) * kstep;
            const char* a3 = a2 + kstep; const char* b3 = b2 + kstep;
            PG8_LDB(B0, 0, 0); PG8_LDB(B1, 0, 1); PG8_SCHED; PG8_LDA(At, 0, 0); PG8_STAGE(PG8_SA(1, 1), a1 + hstepA, voffA);
            PG8_WAIT_V(8); PG8_WAIT_L(0); PG8_BAR; PG8_MMA(0, 0, At, B0); PG8_MMA(0, 1, At, B1); PG8_BAR; PG8_SCHED;
            PG8_LDA(At, 0, 1); PG8_STAGE(PG8_SB(0, 0), b2, voffB); PG8_STAGE(PG8_SB(0, 1), b2 + hstepB, voffB); PG8_STAGE(PG8_SA(0, 0), a2, voffA);
            PG8_WAIT_V(8); PG8_WAIT_L(0); PG8_BAR; PG8_MMA(1, 0, At, B0); PG8_MMA(1, 1, At, B1); PG8_BAR; PG8_SCHED;
            PG8_LDB(B0, 1, 0); PG8_LDB(B1, 1, 1); PG8_SCHED; PG8_LDA(At, 1, 0); PG8_STAGE(PG8_SA(0, 1), a2 + hstepA, voffA);
            PG8_WAIT_V(8); PG8_WAIT_L(0); PG8_BAR; PG8_MMA(0, 0, At, B0); PG8_MMA(0, 1, At, B1); PG8_BAR; PG8_SCHED;
            PG8_LDA(At, 1, 1); PG8_STAGE(PG8_SB(1, 0), b3, voffB); PG8_STAGE(PG8_SB(1, 1), b3 + hstepB, voffB); PG8_STAGE(PG8_SA(1, 0), a3, voffA);
            PG8_WAIT_V(8); PG8_WAIT_L(0); PG8_BAR; PG8_MMA(1, 0, At, B0); PG8_MMA(1, 1, At, B1); PG8_BAR; PG8_SCHED;
        }
        if constexpr (ALIGN_EPI) { if (wr == 0) PG8_BAR; }
        E(acc, cur, wr, wc, fr, fq);
        if (!has_next) break;
#pragma unroll
        for (int a = 0; a < 2; ++a)
#pragma unroll
            for (int b = 0; b < 2; ++b)
#pragma unroll
                for (int m = 0; m < 4; ++m)
#pragma unroll
                    for (int n = 0; n < 2; ++n) acc[a][b][m][n] = (f32x4){0.f, 0.f, 0.f, 0.f};
        cur = nxt; cA = nA; cB = nB; ++ui;
        if constexpr (ALIGN_EPI) { if (wr == 1) PG8_BAR; }
    }
    PG8_WAIT_V(0);
    if constexpr (!ALIGN_EPI) { if (wr == 0) PG8_BAR; }
    PG8_BAR;
#undef PG8_SA
#undef PG8_SB
#undef PG8_STAGE
#undef PG8_LDA
#undef PG8_LDB
#undef PG8_MMA
#undef PG8_WAIT_V
#undef PG8_WAIT_L
#undef PG8_BAR
#undef PG8_SCHED
}
}

struct EpiHyIn {
    static constexpr bool PERM = false, SWAP = false;
    bf16_t* XT; const u64* rowss;
    __device__ __forceinline__ void operator()(const f32x4 (&acc)[2][2][4][2], const pg8::Unit& u, int wr, int wc, int fr, int fq) const {
        constexpr size_t REGION = (size_t)(WS_R2 - WS_R1) / 2;
#pragma unroll
        for (int ai = 0; ai < 2; ++ai)
#pragma unroll
            for (int m = 0; m < 4; ++m) {
                const int row0 = u.pm * 256 + ai * 128 + wr * 64 + m * 16;
                if (row0 >= MREAL) continue;
                const u64x2 s01 = *(const u64x2*)(rowss + row0 + 4 * fq), s23 = *(const u64x2*)(rowss + row0 + 4 * fq + 2);
                f32x4 ri; ri[0] = ss_rinv(s01[0]); ri[1] = ss_rinv(s01[1]); ri[2] = ss_rinv(s23[0]); ri[3] = ss_rinv(s23[1]);
                int s, p0, L; row_decode(row0, s, p0, L);
                const size_t so = seq_off_ch(s); const int LS = seq_LS(s);
#pragma unroll
                for (int bj = 0; bj < 2; ++bj)
#pragma unroll
                    for (int n = 0; n < 2; ++n) {
                        const int col = u.pn * 256 + bj * 128 + wc * 32 + n * 16 + fr;
                        const int part = col >> 10, ch = col & 1023;
                        const f32x4 v = acc[ai][bj][m][n] * ri;
                        u32x2 w; w.x = cvtpk(v[0], v[1]); w.y = cvtpk(v[2], v[3]);
                        *(u32x2*)(XT + (size_t)part * REGION + so + (size_t)ch * LS + XPAD + p0 + 4 * fq) = w;
                    }
            }
    }
};
template <int MODE> struct EpiRow {
    static constexpr bool PERM = true, SWAP = true;
    bf16_t* O; bf16_t* VT; const u64* rowss; int row_base;
    __device__ __forceinline__ void operator()(const f32x4 (&acc)[2][2][4][2], const pg8::Unit& u, int wr, int wc, int fr, int fq) const {
#pragma unroll
        for (int ai = 0; ai < 2; ++ai)
#pragma unroll
            for (int m = 0; m < 4; ++m) {
                const int lrow = u.pm * 256 + ai * 128 + wr * 64 + m * 16 + fr, grow = row_base + lrow;
                if (grow >= MREAL) continue;
                const float ri = ss_rinv(rowss[grow]);
#pragma unroll
                for (int bj = 0; bj < 2; ++bj) {
                    const int col0 = u.pn * 256 + bj * 128 + wc * 32 + 8 * fq;
                    f32x4 v0 = acc[ai][bj][m][0] * ri, v1 = acc[ai][bj][m][1] * ri;
                    if (MODE == 1) {
#pragma unroll
                        for (int i = 0; i < 4; ++i) { const float a = fmaxf(v0[i], 0.f), b = fmaxf(v1[i], 0.f); v0[i] = a * a; v1[i] = b * b; }
                        u32x4 w; w.x = cvtpk(v0[0], v0[1]); w.y = cvtpk(v0[2], v0[3]); w.z = cvtpk(v1[0], v1[1]); w.w = cvtpk(v1[2], v1[3]);
                        *(u32x4*)(O + (size_t)lrow * DFF + col0) = w;
                    } else {
                        if (col0 < 1280) {
                            u32x4 w; w.x = cvtpk(v0[0], v0[1]); w.y = cvtpk(v0[2], v0[3]); w.z = cvtpk(v1[0], v1[1]); w.w = cvtpk(v1[2], v1[3]);
                            *(u32x4*)(O + (size_t)grow * 1280 + col0) = w;
                        } else {
                            int s, p, L; row_decode(grow, s, p, L);
                            const int LS = seq_LS(s);
                            bf16_t* dst = VT + seq_off_ch(s) / 4 + (size_t)(col0 - 1280) * LS + XPAD + p;
#pragma unroll
                            for (int i = 0; i < 4; ++i) { dst[(size_t)i * LS] = (bf16_t)(cvtpk(v0[i], 0.f) & 0xffffu); dst[(size_t)(4 + i) * LS] = (bf16_t)(cvtpk(v1[i], 0.f) & 0xffffu); }
                        }
                    }
                }
            }
    }
};
struct EpiResid {
    static constexpr bool PERM = true, SWAP = true;
    const float* srcA; const float* srcB; const float* srcM; int meta_mask;
    float* dstMain; float* dstM; bf16_t* P; u64* rowss_next; int row_base;
    __device__ __forceinline__ void operator()(const f32x4 (&acc)[2][2][4][2], const pg8::Unit& u, int wr, int wc, int fr, int fq) const {
#pragma unroll
        for (int ai = 0; ai < 2; ++ai)
#pragma unroll
            for (int m = 0; m < 4; ++m) {
                const int grow = row_base + u.pm * 256 + ai * 128 + wr * 64 + m * 16 + fr;
                const bool ok = grow < MREAL;
                float ss = 0.f;
                if (ok) {
                    const float* src; float* dst;
                    if (grow < ROWS_P) { src = srcA + (size_t)grow * DM; dst = dstMain + (size_t)grow * DM; }
                    else if (grow < ROWS_MAIN) { src = srcB + (size_t)(grow - ROWS_P) * DM; dst = dstMain + (size_t)grow * DM; }
                    else { const int mr = grow - ROWS_MAIN; src = srcM + (size_t)(mr & meta_mask) * DM; dst = dstM + (size_t)mr * DM; }
#pragma unroll
                    for (int bj = 0; bj < 2; ++bj) {
                        const int col0 = u.pn * 256 + bj * 128 + wc * 32 + 8 * fq;
                        const f32x4 h0 = *(const f32x4*)(src + col0) + acc[ai][bj][m][0];
                        const f32x4 h1 = *(const f32x4*)(src + col0 + 4) + acc[ai][bj][m][1];
                        *(f32x4*)(dst + col0) = h0; *(f32x4*)(dst + col0 + 4) = h1;
                        if (P) { u32x4 w; w.x = cvtpk(h0[0], h0[1]); w.y = cvtpk(h0[2], h0[3]); w.z = cvtpk(h1[0], h1[1]); w.w = cvtpk(h1[2], h1[3]);
                            *(u32x4*)(P + (size_t)grow * DM + col0) = w; }
                        ss += (h0[0] * h0[0] + h0[1] * h0[1]) + (h0[2] * h0[2] + h0[3] * h0[3]) + (h1[0] * h1[0] + h1[1] * h1[1]) + (h1[2] * h1[2] + h1[3] * h1[3]);
                    }
                }
                ss += __shfl_xor(ss, 16); ss += __shfl_xor(ss, 32);
                if (ok && fq == 0 && rowss_next) atomicAdd(rowss_next + grow, (u64)(ss * SS_SCALE));
            }
    }
};

struct EpiPartial {
    static constexpr bool PERM = true, SWAP = true;
    float* PART;
    __device__ __forceinline__ void operator()(const f32x4 (&acc)[2][2][4][2], const pg8::Unit& u, int wr, int wc, int fr, int fq) const {
#pragma unroll
        for (int ai = 0; ai < 2; ++ai)
#pragma unroll
            for (int m = 0; m < 4; ++m) {
                const int lrow = u.pm * 256 + ai * 128 + wr * 64 + m * 16 + fr;
                float* dst = PART + ((size_t)u.ks * 512 + lrow) * DM + u.pn * 256 + wc * 32 + 8 * fq;
#pragma unroll
                for (int bj = 0; bj < 2; ++bj) { *(f32x4*)(dst + bj * 128) = acc[ai][bj][m][0]; *(f32x4*)(dst + bj * 128 + 4) = acc[ai][bj][m][1]; }
            }
    }
};
constexpr int DOWN_KS = 16;
__device__ __forceinline__ void meta_reduce(const float* PART, float* metah, bf16_t* P, u64* rowss_next, int gw, int NGW, int lane) {
    for (int lrow = gw; lrow < MREAL - ROWS_MAIN; lrow += NGW) {
        float ss = 0.f;
#pragma unroll
        for (int k = 0; k < 4; ++k) {
            const int col = k * 256 + lane * 4;
            f32x4 sum = *(const f32x4*)(metah + (size_t)lrow * DM + col);
#pragma unroll
            for (int ks = 0; ks < DOWN_KS; ++ks) sum += *(const f32x4*)(PART + ((size_t)ks * 512 + lrow) * DM + col);
            *(f32x4*)(metah + (size_t)lrow * DM + col) = sum;
            if (P) { u32x2 pk; pk.x = cvtpk(sum[0], sum[1]); pk.y = cvtpk(sum[2], sum[3]); *(u32x2*)(P + (size_t)(ROWS_MAIN + lrow) * DM + col) = pk; }
            ss += (sum[0] * sum[0] + sum[1] * sum[1]) + (sum[2] * sum[2] + sum[3] * sum[3]);
        }
        ss = wave_sum(ss);
        if (lane == 0 && rowss_next) rowss_next[ROWS_MAIN + lrow] = (u64)(ss * SS_SCALE);
    }
}

__device__ __forceinline__ void transpose_item(const float* W, const float* gain, int K, int N, bf16_t* WT, LAS float* scr, int item, int lane) {
    const int nblk = N / 32, kb = item / nblk, nb = item % nblk, k0 = 64 * kb, n0 = 32 * nb;
    {
        const int kr = lane >> 3, n4 = (lane & 7) * 4;
        f32x4 wv[8]; float gv[8];
#pragma unroll
        for (int i = 0; i < 8; ++i) { wv[i] = *(const f32x4*)(W + (size_t)(k0 + 8 * i + kr) * N + n0 + n4); gv[i] = gain ? gain[k0 + 8 * i + kr] : 1.0f; }
#pragma unroll
        for (int i = 0; i < 8; ++i) { LAS float* d = scr + (8 * i + kr) * 33 + n4; const f32x4 v = wv[i] * gv[i]; d[0] = v[0]; d[1] = v[1]; d[2] = v[2]; d[3] = v[3]; }
    }
    asm volatile("s_waitcnt lgkmcnt(0)" ::: "memory");
    const int c = lane & 7;
#pragma unroll
    for (int j = 0; j < 4; ++j) { const int n = (lane >> 3) + 8 * j; const LAS float* s = scr + (8 * c) * 33 + n;
        u32x4 o; o.x = cvtpk(s[0 * 33], s[1 * 33]); o.y = cvtpk(s[2 * 33], s[3 * 33]); o.z = cvtpk(s[4 * 33], s[5 * 33]); o.w = cvtpk(s[6 * 33], s[7 * 33]);
        *(u32x4*)(WT + (size_t)(n0 + n) * K + k0 + 8 * c) = o; }
    asm volatile("s_waitcnt lgkmcnt(0)" ::: "memory");
}
__device__ __forceinline__ void convert_matrix(const float* W, const float* gain, int K, int N, bf16_t* WT, LAS float* scr, int gw, int NGW, int lane) {
    const int nitems = (K / 64) * (N / 32);
    for (int it = gw; it < nitems; it += NGW) transpose_item(W, gain, K, N, WT, scr, it, lane);
}

__device__ __forceinline__ void h2_features(LAS unsigned char* lds, const Args& a, int j, int npr, int tid) {
    LAS float* hs = (LAS float*)lds;
    float* H2T = (float*)(a.ws + WS_H2T);
    const bool hvalid = npr < H2N;
    const int np = hvalid ? npr : H2N - 1;
    const int L = np < L_P ? L_P : L_S, n = np < L_P ? np : np - L_P;
    const float* w1 = a.in[9] + j * 33 * 64; const float* b1 = a.in[10] + j * 64; const float* fr1 = a.in[11] + j * 64;
    const float* w2 = a.in[12] + j * 64 * 64; const float* b2 = a.in[13] + j * 64; const float* fr2 = a.in[14] + j * 64;
    const float t = (float)n * (1.0f / (float)(L - 1));
    const float w = (6.283185307179586f / (float)L) * (float)n;
    float acc[64];
#pragma unroll
    for (int m = 0; m < 64; ++m) acc[m] = b1[m] + t * w1[m];
    for (int e = 0; e < 16; ++e) {
        const float f = 1e-4f + (float)e * ((15.0f - 1e-4f) / 15.0f);
        float s, c; my_sincos(f * w, s, c);
        const float* wc = w1 + (1 + e) * 64; const float* wsn = w1 + (17 + e) * 64;
#pragma unroll
        for (int m = 0; m < 64; ++m) acc[m] = fmaf(c, wc[m], fmaf(-s, wsn[m], acc[m]));
    }
#pragma unroll
    for (int m = 0; m < 64; ++m) hs[m * 64 + tid] = my_sin(fr1[m] * acc[m]);
#pragma unroll
    for (int m = 0; m < 64; ++m) acc[m] = b2[m];
    for (int e = 0; e < 64; ++e) {
        const float h = hs[e * 64 + tid]; const float* wr_ = w2 + e * 64;
#pragma unroll
        for (int m = 0; m < 64; ++m) acc[m] = fmaf(h, wr_[m], acc[m]);
    }
    if (hvalid) {
#pragma unroll
        for (int m = 0; m < 64; ++m) H2T[((size_t)j * H2N + np) * 64 + m] = my_sin(fr2[m] * acc[m]);
    }
}

__device__ __forceinline__ void split8(const f32x4 a, const f32x4 b, bf16x8& hi, bf16x8& lo) {
    u32x4 h, l;
    h.x = cvtpk(a[0], a[1]); h.y = cvtpk(a[2], a[3]); h.z = cvtpk(b[0], b[1]); h.w = cvtpk(b[2], b[3]);
    l.x = cvtpk(a[0] - bflo(h.x), a[1] - bfhi(h.x)); l.y = cvtpk(a[2] - bflo(h.y), a[3] - bfhi(h.y));
    l.z = cvtpk(b[0] - bflo(h.z), b[1] - bfhi(h.z)); l.w = cvtpk(b[2] - bflo(h.w), b[3] - bfhi(h.w));
    hi = __builtin_bit_cast(bf16x8, h); lo = __builtin_bit_cast(bf16x8, l);
}
__device__ __forceinline__ void fk_compute(const Args& a, int j, int gw, int NGW, int lane) {
    const float* H2 = (const float*)(a.ws + WS_H2T) + (size_t)j * H2N * 64;
    const float* w3 = a.in[15] + (size_t)j * 64 * 4096;
    const float* skip = a.in[16] + j * 2 * 1024;
    bf16_t* FK = (bf16_t*)(a.ws + WS_FK);
    const int n16 = lane & 15, g = lane >> 4;
#pragma unroll 1
    for (int it = gw; it < 2048; it += NGW) {
        const int pq = it & 3, cht = (it >> 2) & 63, dir = (it >> 8) & 1, o = (it >> 9) & 1, set = it >> 10;
        const int L = set ? L_S : L_P, offs = set ? FK_OFFS_S : FK_OFFS_P, len = set ? FK_LEN_S : FK_LEN_P, nbase = set ? L_P : 0;
        bf16_t* base = FK + (set ? FK_SAMPLE_OFF : 0);
        const int ch = cht * 16 + n16;
        bf16x8 Bh0, Bl0, Bh1, Bl1;
        {
            const float* wp = w3 + (o * 2 + dir) * 1024 + ch;
            f32x4 w0, w1, w2, w3v;
#pragma unroll
            for (int i = 0; i < 4; ++i) { w0[i] = wp[(size_t)(8 * g + i) * 4096]; w1[i] = wp[(size_t)(8 * g + 4 + i) * 4096];
                w2[i] = wp[(size_t)(32 + 8 * g + i) * 4096]; w3v[i] = wp[(size_t)(36 + 8 * g + i) * 4096]; }
            split8(w0, w1, Bh0, Bl0); split8(w2, w3v, Bh1, Bl1);
        }
        const float mind = -3.0701134573253944f, maxd = -15.350567286626972f;
        const float delta = fabsf(mind + (maxd - mind) * ((float)ch * (1.0f / 1023.0f)));
        const float skipv = skip[o * 1024 + ch];
        const float tinv = 1.0f / (float)(L - 1);
        bf16_t* rowp = base + ((size_t)o * 1024 + ch) * len;
        const int tq = offs / 64;
#pragma unroll 2
        for (int tile = pq * tq; tile < (pq + 1) * tq; ++tile) {
            const int n0 = tile * 16 + dir;
            const int nr = n0 + n16, nrc = nr < L ? nr : L - 1;
            const float* hp = H2 + (size_t)(nbase + nrc) * 64 + 8 * g;
            const f32x4 h0 = *(const f32x4*)hp, h1 = *(const f32x4*)(hp + 4), h2 = *(const f32x4*)(hp + 32), h3 = *(const f32x4*)(hp + 36);
            bf16x8 Ah0, Al0, Ah1, Al1; split8(h0, h1, Ah0, Al0); split8(h2, h3, Ah1, Al1);
            f32x4 acc = (f32x4){0.f, 0.f, 0.f, 0.f};
            acc = __builtin_amdgcn_mfma_f32_16x16x32_bf16(Al0, Bh0, acc, 0, 0, 0);
            acc = __builtin_amdgcn_mfma_f32_16x16x32_bf16(Al1, Bh1, acc, 0, 0, 0);
            acc = __builtin_amdgcn_mfma_f32_16x16x32_bf16(Ah0, Bl0, acc, 0, 0, 0);
            acc = __builtin_amdgcn_mfma_f32_16x16x32_bf16(Ah1, Bl1, acc, 0, 0, 0);
            acc = __builtin_amdgcn_mfma_f32_16x16x32_bf16(Ah0, Bh0, acc, 0, 0, 0);
            acc = __builtin_amdgcn_mfma_f32_16x16x32_bf16(Ah1, Bh1, acc, 0, 0, 0);
            float v[4];
#pragma unroll
            for (int ii = 0; ii < 4; ++ii) {
                const int n = n0 + 4 * g + ii;
                float x = acc[ii] * __expf(-((float)n * tinv) * delta);
                if (dir == 0 && n == 0) x += skipv;
                v[ii] = n < L ? x : 0.f;
            }
            u32x2 pk;
            if (dir == 0) { pk.x = cvtpk(v[0], v[1]); pk.y = cvtpk(v[2], v[3]); *(u32x2*)(rowp + offs + n0 + 4 * g) = pk; }
            else { pk.x = cvtpk(v[3], v[2]); pk.y = cvtpk(v[1], v[0]); *(u32x2*)(rowp + offs - (n0 + 4 * g + 3)) = pk; }
        }
    }
}

__device__ __forceinline__ u32x2 cld8(const void* p) { u32x2 v; asm volatile("global_load_dwordx2 %0, %1, off sc0 sc1\n\ts_waitcnt vmcnt(0)" : "=v"(v) : "v"(p) : "memory"); return v; }
__device__ __forceinline__ u32x4 cld16(const void* p) { u32x4 v; asm volatile("global_load_dwordx4 %0, %1, off sc0 sc1\n\ts_waitcnt vmcnt(0)" : "=v"(v) : "v"(p) : "memory"); return v; }
__device__ __forceinline__ unsigned short cld2(const void* p) { unsigned v; asm volatile("global_load_ushort %0, %1, off sc0 sc1\n\ts_waitcnt vmcnt(0)" : "=v"(v) : "v"(p) : "memory"); return (unsigned short)v; }
__device__ __forceinline__ f32x4 gate4(const bf16_t* xrow, int m, int L, float w0, float w1, float w2, float bb) {
    const u32x2 raw = *(const u32x2*)(xrow + m);
    const float x0 = bflo(raw.x), x1 = bfhi(raw.x), x2 = bflo(raw.y), x3 = bfhi(raw.y);
    const float xm = m > 0 ? bf2f(xrow[m - 1]) : 0.f, xp = (m + 4 < L) ? bf2f(xrow[m + 4]) : 0.f;
    f32x4 r;
    r[0] = w0 * xm + w1 * x0 + w2 * x1 + bb; r[1] = w0 * x0 + w1 * x1 + w2 * x2 + bb;
    r[2] = w0 * x1 + w1 * x2 + w2 * x3 + bb; r[3] = w0 * x2 + w1 * x3 + w2 * xp + bb;
    return r;
}
struct GateRaw { u32x2 raw; unsigned halo; };
__device__ __forceinline__ GateRaw gate_load(const bf16_t* xrow, int m, int L) {
    GateRaw r; r.raw = *(const u32x2*)(xrow + m);
    const unsigned xm = m > 0 ? (unsigned)xrow[m - 1] : 0u, xp = (m + 4 < L) ? (unsigned)xrow[m + 4] : 0u;
    r.halo = xm | (xp << 16); return r;
}
__device__ __forceinline__ f32x4 gate_eval(const GateRaw& gr, float w0, float w1, float w2, float bb) {
    const float x0 = bflo(gr.raw.x), x1 = bfhi(gr.raw.x), x2 = bflo(gr.raw.y), x3 = bfhi(gr.raw.y), xm = bflo(gr.halo), xp = bfhi(gr.halo);
    f32x4 r;
    r[0] = w0 * xm + w1 * x0 + w2 * x1 + bb; r[1] = w0 * x0 + w1 * x1 + w2 * x2 + bb;
    r[2] = w0 * x1 + w1 * x2 + w2 * x3 + bb; r[3] = w0 * x2 + w1 * x3 + w2 * xp + bb;
    return r;
}
template <int NQ, int NB, int L>
__device__ __forceinline__ void conv_unit(LAS unsigned char* lds, const Args& a, int j, int seq0, int c, int tid) {
    constexpr int QS = 64, GS = QS * NQ, WS = 4 * GS, PADL = 224;
    constexpr int LS = (NQ == 4) ? LS_P : LS_S;
    constexpr int LPD = (NQ == 4) ? 8720 : 4616;
    constexpr int OFFS = (NQ == 4) ? FK_OFFS_P : FK_OFFS_S, LEN = (NQ == 4) ? FK_LEN_P : FK_LEN_S;
    constexpr int S_LO = -QS * (NQ - 1), S_HI = ((L - 1) / 32) * 32;
    constexpr int U_OFF = 0, FKL_OFF = 77824, RED_OFF = 112640;
    static_assert(NB * LPD * 2 <= FKL_OFF && FKL_OFF + LEN * 2 <= RED_OFF, "conv LDS map");
    const int lane = tid & 63, w = __builtin_amdgcn_readfirstlane(tid >> 6);
    const bf16_t* X1 = (const bf16_t*)(a.ws + WS_R1); const bf16_t* X2 = (const bf16_t*)(a.ws + WS_R2); bf16_t* V = (bf16_t*)(a.ws + WS_R3);
    const bf16_t* FK = (const bf16_t*)(a.ws + WS_FK) + ((NQ == 4) ? 0 : FK_SAMPLE_OFF);
    const float* cw = a.in[7] + (size_t)j * 3 * 3072; const float* cb = a.in[8] + (size_t)j * 3072;
    constexpr int NF = (LEN / 8 + 511) / 512;
    u32x4 fkr[NF];
    {
        const u32x4* src = (const u32x4*)(FK + (size_t)c * LEN);
#pragma unroll
        for (int it = 0; it < NF; ++it) { const int i = it * 512 + tid; fkr[it] = src[i < LEN / 8 ? i : 0]; }
    }
    {
        const float w0 = cw[2048 + c], w1 = cw[3072 + 2048 + c], w2 = cw[2 * 3072 + 2048 + c], bb = cb[2048 + c];
        constexpr int NCH = LPD / 8, NIT = (NB * NCH + 511) / 512;
        u32x4 raws[NIT]; unsigned halos[NIT];
#pragma unroll
        for (int it = 0; it < NIT; ++it) {
            const int idx = it * 512 + tid; const int b = idx / NCH, ch = idx % NCH, p = ch * 8 - PADL;
            raws[it] = (u32x4){0u, 0u, 0u, 0u}; halos[it] = 0u;
            if (idx < NB * NCH && p >= 0 && p < L) {
                const bf16_t* row = V + seq_off_ch(seq0 + b) + (size_t)c * LS + XPAD + p;
                raws[it] = *(const u32x4*)row;
                const unsigned xm = p > 0 ? (unsigned)row[-1] : 0u, xp = (p + 8 < L) ? (unsigned)row[8] : 0u;
                halos[it] = xm | (xp << 16);
            }
        }
#pragma unroll
        for (int it = 0; it < NIT; ++it) {
            const int idx = it * 512 + tid; const int b = idx / NCH, ch = idx % NCH, p = ch * 8 - PADL;
            u32x4 o = {0u, 0u, 0u, 0u};
            if (p >= 0 && p < L) {
                const u32x4 raw = raws[it];
                float x[10];
                x[0] = bflo(halos[it]); x[9] = bfhi(halos[it]);
                x[1] = bflo(raw.x); x[2] = bfhi(raw.x); x[3] = bflo(raw.y); x[4] = bfhi(raw.y); x[5] = bflo(raw.z); x[6] = bfhi(raw.z); x[7] = bflo(raw.w); x[8] = bfhi(raw.w);
                float y[8];
#pragma unroll
                for (int i = 0; i < 8; ++i) y[i] = w0 * x[i] + w1 * x[i + 1] + w2 * x[i + 2] + bb;
                o.x = cvtpk(y[0], y[1]); o.y = cvtpk(y[2], y[3]); o.z = cvtpk(y[4], y[5]); o.w = cvtpk(y[6], y[7]);
            }
            if (idx < NB * NCH) *(LAS u32x4*)(lds + U_OFF + (b * LPD + ch * 8) * 2) = o;
        }
    }
    const int n = lane & 15, g = lane >> 4;
    const int q = (NQ == 4) ? (n >> 2) : (n >> 3), b = (NQ == 4) ? (n & 3) : (n & 7);
    const int ub = U_OFF + (b * LPD + PADL + QS * q + 8 * g) * 2;
    const int ubm = U_OFF + (b * LPD + PADL + 8 * g) * 2;
    const int pe = (1 + n) & 1;
    const int abr = FKL_OFF + (LEN - 1 - OFFS - n + 8 * g - pe) * 2;
    const unsigned sh = pe * 16;
    const int mw = 16 + WS * w;
    const int d_lo = mw - S_HI, d_hi = mw + 3 * GS - S_LO;
    const size_t xrow_off = seq_off_ch(seq0 + b) + (size_t)c * LS + XPAD;
#define ARAW(d, lagoff) do { const LAS unsigned* _p = (const LAS unsigned*)(lds + abr - (lagoff) * 2); d[0] = _p[0]; d[1] = _p[1]; d[2] = _p[2]; d[3] = _p[3]; d[4] = _p[4]; } while (0)
#define AFIN(dst, d) do { u32x4 _o; _o.x = __builtin_amdgcn_alignbit(d[1], d[0], sh); _o.y = __builtin_amdgcn_alignbit(d[2], d[1], sh); \
        _o.z = __builtin_amdgcn_alignbit(d[3], d[2], sh); _o.w = __builtin_amdgcn_alignbit(d[4], d[3], sh); dst = __builtin_bit_cast(bf16x8, _o); } while (0)
#define GATHER(dst, lagoff) do { unsigned _d[5]; ARAW(_d, lagoff); AFIN(dst, _d); } while (0)
#pragma unroll 1
    for (int o = 0; o < 2; ++o) {
#pragma unroll
        for (int it = 0; it < NF; ++it) { const int i = it * 512 + tid; const u32x4 v = fkr[it]; u32x4 r;
            r.x = __builtin_amdgcn_alignbit(v.w, v.w, 16); r.y = __builtin_amdgcn_alignbit(v.z, v.z, 16);
            r.z = __builtin_amdgcn_alignbit(v.y, v.y, 16); r.w = __builtin_amdgcn_alignbit(v.x, v.x, 16);
            if (i < LEN / 8) *(LAS u32x4*)(lds + FKL_OFF + (LEN / 8 - 1 - i) * 16) = r; }
        __syncthreads();
        if (o == 0) {
            const u32x4* src = (const u32x4*)(FK + ((size_t)1024 + c) * LEN);
#pragma unroll
            for (int it = 0; it < NF; ++it) { const int i = it * 512 + tid; fkr[it] = src[i < LEN / 8 ? i : 0]; }
        }
        f32x4 acc[4][4];
#pragma unroll
        for (int gi = 0; gi < 4; ++gi)
#pragma unroll
            for (int t = 0; t < 4; ++t) acc[gi][t] = (f32x4){0.f, 0.f, 0.f, 0.f};
        bf16x8 A0, A1, A2, A3, Bc[4], Bn[4];
        GATHER(A0, d_lo); GATHER(A1, d_lo + 16); GATHER(A2, d_lo + 32); GATHER(A3, d_lo + 48);
        int baddr = ub + 2 * (mw - d_lo);
#pragma unroll
        for (int gi = 0; gi < 4; ++gi) Bc[gi] = *(const LAS bf16x8*)(lds + baddr + 2 * GS * gi);
#define CONV_STEP(BCUR, BNXT, DL, CHECK) do { \
            unsigned r2[5], r3[5]; ARAW(r2, (DL) + 64); ARAW(r3, (DL) + 80); \
            baddr -= 64; \
            _Pragma("unroll") for (int gi = 0; gi < 4; ++gi) BNXT[gi] = *(const LAS bf16x8*)(lds + baddr + 2 * GS * gi); \
            __builtin_amdgcn_s_setprio(1); \
            _Pragma("unroll") for (int gi = 0; gi < 4; ++gi) { \
                const int s0 = mw + GS * gi - (DL); \
                if (!(CHECK) || ((s0 >= S_LO) && (s0 <= S_HI))) { \
                    acc[gi][0] = __builtin_amdgcn_mfma_f32_16x16x32_bf16(A0, BCUR[gi], acc[gi][0], 0, 0, 0); \
                    acc[gi][1] = __builtin_amdgcn_mfma_f32_16x16x32_bf16(A1, BCUR[gi], acc[gi][1], 0, 0, 0); \
                    acc[gi][2] = __builtin_amdgcn_mfma_f32_16x16x32_bf16(A2, BCUR[gi], acc[gi][2], 0, 0, 0); \
                    acc[gi][3] = __builtin_amdgcn_mfma_f32_16x16x32_bf16(A3, BCUR[gi], acc[gi][3], 0, 0, 0); \
                } \
            } \
            __builtin_amdgcn_s_setprio(0); \
            A0 = A2; A1 = A3; AFIN(A2, r2); AFIN(A3, r3); } while (0)
        const int dl_a = mw + 3 * GS - S_HI, dl_b = mw - S_LO;
        static_assert(((3 * GS / 32) % 2 == 0) && (((S_HI - S_LO - 3 * GS) / 32 + 1) % 2 == 1), "conv step-count parity");
#pragma unroll 1
        for (int dl = d_lo; dl < dl_a; dl += 64) { CONV_STEP(Bc, Bn, dl, true); CONV_STEP(Bn, Bc, dl + 32, true); }
#pragma unroll 1
        for (int dl = dl_a; dl < dl_b; dl += 64) { CONV_STEP(Bc, Bn, dl, false); CONV_STEP(Bn, Bc, dl + 32, false); }
        CONV_STEP(Bc, Bn, dl_b, false);
#pragma unroll 1
        for (int dl = dl_b + 32; dl <= d_hi; dl += 64) { CONV_STEP(Bn, Bc, dl, true); CONV_STEP(Bc, Bn, dl + 32, true); }
#undef CONV_STEP
        const bf16_t* X = (o == 0 ? X1 : X2) + xrow_off;
        const float w0 = cw[o * 1024 + c], w1 = cw[3072 + o * 1024 + c], w2 = cw[2 * 3072 + o * 1024 + c], bb = cb[o * 1024 + c];
        GateRaw gt[4][4];
        {
            const int mb = mw + QS * q + 4 * g; const bf16_t* Xb = X + mb;
#pragma unroll
            for (int gi = 0; gi < 4; ++gi)
#pragma unroll
                for (int t = 0; t < 4; ++t) { constexpr int dummy = 0; (void)dummy; const int off = GS * gi + 16 * t;
                    GateRaw r; r.raw = *(const u32x2*)(Xb + off);
                    const unsigned xm = (unsigned)Xb[off - 1]; unsigned xp = (unsigned)Xb[off + 4];
                    if (mb + off + 4 >= L) xp = 0u;
                    r.halo = xm | (xp << 16); gt[gi][t] = r; }
        }
        const GateRaw gtm = gate_load(X, 4 * g, L);
        f32x4 macc = (f32x4){0.f, 0.f, 0.f, 0.f};
#pragma unroll 1
        for (int t = w; t <= S_HI / 32; t += 8) {
            bf16x8 Am; GATHER(Am, -32 * t);
            const bf16x8 B = *(const LAS bf16x8*)(lds + ubm + t * 64);
            macc = __builtin_amdgcn_mfma_f32_16x16x32_bf16(Am, B, macc, 0, 0, 0);
        }
        *(LAS f32x4*)(lds + RED_OFF + (w * 64 + lane) * 16) = macc;
        __syncthreads();
        if (w == 0 && q == 0) {
            f32x4 s = (f32x4){0.f, 0.f, 0.f, 0.f};
#pragma unroll
            for (int ww = 0; ww < 8; ++ww) s += *(const LAS f32x4*)(lds + RED_OFF + (ww * 64 + lane) * 16);
            const int m = 4 * g;
            const f32x4 z = gate_eval(gtm, w0, w1, w2, bb) * s;
            u32x2 pk; pk.x = cvtpk(z[0], z[1]); pk.y = cvtpk(z[2], z[3]);
            if (o == 0) *(LAS u32x2*)(lds + U_OFF + (b * LPD + PADL + m) * 2) = pk;
            else *(u32x2*)(V + xrow_off + m) = pk;
        }
#pragma unroll
        for (int gi = 0; gi < 4; ++gi)
#pragma unroll
            for (int t = 0; t < 4; ++t) {
                const int m = mw + GS * gi + 16 * t + QS * q + 4 * g;
                const f32x4 z = gate_eval(gt[gi][t], w0, w1, w2, bb) * acc[gi][t];
                u32x2 pk; pk.x = cvtpk(z[0], z[1]); pk.y = cvtpk(z[2], z[3]);
                if (o == 0) *(LAS u32x2*)(lds + U_OFF + (b * LPD + PADL + m) * 2) = pk;
                else *(u32x2*)(V + xrow_off + m) = pk;
            }
        __syncthreads();
    }
#undef GATHER
#undef ARAW
#undef AFIN
}
__device__ __forceinline__ void conv_phase(LAS unsigned char* lds, const Args& a, int j, int bid, int G, int tid) {
#pragma unroll 1
    for (int u0 = bid; u0 < 3072; u0 += G) {
        const int u = u0;
        int tl = tid; asm volatile("" : "+v"(tl));
        if (u < 1024) conv_unit<4, 4, L_P>(lds, a, j, 0, u, tl);
        else { const int v = u - 1024; conv_unit<2, 8, L_S>(lds, a, j, 4 + 8 * (v & 1), v >> 1, tl); }
    }
}

__device__ __forceinline__ void transpose_phase(LAS unsigned char* lds, const Args& a, int bid, int G, int tid) {
    const bf16_t* ZT = (const bf16_t*)(a.ws + WS_R3); bf16_t* OUT = (bf16_t*)(a.ws + WS_R1);
    constexpr int TP = 129, TS = 65, UP = 4 * TP * 4, US = 16 * TS * 4, TILEB = 256 * 72 * 2;
#define TR_DECODE(u, s, p0, np, c0) do { int _cq, _tt; if ((u) < UP) { _cq = (u) & 3; const int _v = (u) >> 2; s = _v / TP; _tt = _v % TP; } \
        else { const int _r = (u) - UP; _cq = _r & 3; const int _v = _r >> 2; s = 4 + _v / TS; _tt = _v % TS; } \
        p0 = _tt == 0 ? 0 : 16 + 64 * (_tt - 1); np = _tt == 0 ? 16 : 64; c0 = _cq * 256; } while (0)
#define TR_LOAD(u) do { int _s, _p0, _np, _c0; TR_DECODE(u, _s, _p0, _np, _c0); const int _LS = seq_LS(_s), _nq = _np / 4; \
        const bf16_t* _src = ZT + seq_off_ch(_s) + (size_t)_c0 * _LS + XPAD + _p0; \
        _Pragma("unroll") for (int _k = 0; _k < 8; ++_k) { const int _task = _k * 512 + tid; const int _ch = _task / _nq, _pc = _task % _nq; \
            rg[_k] = (_task < 256 * _nq) ? *(const u32x2*)(_src + (size_t)_ch * _LS + 4 * _pc) : (u32x2){0u, 0u}; } } while (0)
    u32x2 rg[8];
    int u = bid, par = 0;
    if (u < UP + US) TR_LOAD(u);
#pragma unroll 1
    for (; u < UP + US; u += G, par ^= 1) {
        int s, p0, np, c0; TR_DECODE(u, s, p0, np, c0);
        const int nq = np / 4; LAS unsigned char* tile = lds + par * TILEB;
#pragma unroll
        for (int k = 0; k < 8; ++k) { const int task = k * 512 + tid; const int ch = task / nq, pc = task % nq;
            if (task < 256 * nq) *(LAS u32x2*)(tile + (ch * 72 + 4 * pc) * 2) = rg[k]; }
        __syncthreads();
        if (u + G < UP + US) TR_LOAD(u + G);
        for (int task = tid; task < np * 32; task += 512) { const int pos = task % np, cc = task / np;
            const LAS unsigned short* t = (const LAS unsigned short*)(tile + ((8 * cc) * 72 + pos) * 2);
            u32x4 o; o.x = (unsigned)t[0] | ((unsigned)t[72] << 16); o.y = (unsigned)t[144] | ((unsigned)t[216] << 16);
            o.z = (unsigned)t[288] | ((unsigned)t[360] << 16); o.w = (unsigned)t[432] | ((unsigned)t[504] << 16);
            *(u32x4*)(OUT + (size_t)seq_row(s, p0 + pos) * DM + c0 + 8 * cc) = o; }
    }
    __syncthreads();
#undef TR_DECODE
#undef TR_LOAD
}

__device__ __forceinline__ void attn_phase(LAS unsigned char* lds, const Args& a, int j, int bid, int G, int tid) {
    constexpr int KN_OFF = 0, KSTR = 144, VT_OFF = 59904, VSTR = 848, BT_OFF = 114176;
    const bf16_t* QK = (const bf16_t*)(a.ws + WS_R1); const bf16_t* VTg = (const bf16_t*)(a.ws + WS_VT); bf16_t* O = (bf16_t*)(a.ws + WS_R3);
    const float* rel_bias = a.in[3]; const float* qg = a.in[19] + j * 64; const float* kg = a.in[20] + j * 64; const float* sink = a.in[21] + j * 16;
    const int lane = tid & 63, w = __builtin_amdgcn_readfirstlane(tid >> 6), r = lane & 15, g = lane >> 4;
    LAS float* BT = (LAS float*)(lds + BT_OFF);
    if (tid < 64) { float mq = fabsf(qg[tid]), mk = fabsf(kg[tid]);
#pragma unroll
        for (int o = 1; o < 64; o <<= 1) { mq = fmaxf(mq, __shfl_xor(mq, o)); mk = fmaxf(mk, __shfl_xor(mk, o)); }
        if (tid == 0) BT[16 * 257] = 8.0f * mq * mk; }
    __syncthreads();
    {
        const float shift0 = BT[16 * 257];
        for (int i = tid; i < 16 * 257; i += 512) { const int h = i / 257, rel = i % 257 - 128; BT[i] = (rel_bias[t5_bucket(rel) * 16 + h] - shift0) * 1.4426950408889634f; }
    }
    __syncthreads();
    constexpr int NU = (4 * 65 + 16 * 33) * 4;
    for (int u = bid; u < NU; u += G) {
        const int hk = u & 3; int v = u >> 2, seq, qb, L;
        if (v < 260) { seq = v / 65; qb = v % 65; L = L_P; } else { v -= 260; seq = 4 + v / 33; qb = v % 33; L = L_S; }
        const int start = qb * 128 - 128;
        {
            const bf16_t* vb = VTg + seq_off_ch(seq) / 4 + (size_t)(hk * 64) * seq_LS(seq) + XPAD;
            const int LS = seq_LS(seq);
            u32x4 kraw[7], vraw[7];
#pragma unroll
            for (int it = 0; it < 7; ++it) {
                const int idx = it * 512 + tid;
                { const int slot = idx >> 3, dc = idx & 7; const int pos = slot < 16 ? slot : start + slot - 16;
                  const bool valid = (idx < 416 * 8) && (slot < 16 || (slot < 400 && pos >= 16 && pos < L));
                  kraw[it] = (u32x4){0u, 0u, 0u, 0u};
                  if (valid) kraw[it] = *(const u32x4*)(QK + (size_t)seq_row(seq, pos) * 1280 + 1024 + hk * 64 + dc * 8); }
                { const int d = idx / 52, c8 = idx % 52; const int pos0 = c8 < 2 ? 8 * c8 : start + 8 * c8 - 16;
                  const bool valid = (idx < 64 * 52) && (c8 < 2 || (c8 < 50 && pos0 >= 16 && pos0 < L));
                  vraw[it] = (u32x4){0u, 0u, 0u, 0u};
                  if (valid) vraw[it] = *(const u32x4*)(vb + (size_t)d * LS + pos0); }
            }
#pragma unroll
            for (int it = 0; it < 7; ++it) {
                const int idx = it * 512 + tid;
                const int slot = idx >> 3, dc = idx & 7;
                const u32x4 raw = kraw[it];
                float x[8] = {bflo(raw.x), bfhi(raw.x), bflo(raw.y), bfhi(raw.y), bflo(raw.z), bfhi(raw.z), bflo(raw.w), bfhi(raw.w)};
                float ss = 0.f;
#pragma unroll
                for (int i = 0; i < 8; ++i) ss += x[i] * x[i];
                ss += __shfl_xor(ss, 1); ss += __shfl_xor(ss, 2); ss += __shfl_xor(ss, 4);
                const float ri = __builtin_amdgcn_rsqf(ss * (1.0f / 64.0f) + EPS);
                const f32x4 g0 = *(const f32x4*)(kg + dc * 8), g1 = *(const f32x4*)(kg + dc * 8 + 4);
                u32x4 o; o.x = cvtpk(x[0] * ri * g0[0], x[1] * ri * g0[1]); o.y = cvtpk(x[2] * ri * g0[2], x[3] * ri * g0[3]);
                o.z = cvtpk(x[4] * ri * g1[0], x[5] * ri * g1[1]); o.w = cvtpk(x[6] * ri * g1[2], x[7] * ri * g1[3]);
                if (idx < 416 * 8) *(LAS u32x4*)(lds + KN_OFF + slot * KSTR + dc * 16) = o;
                const int d = idx / 52, c8 = idx % 52;
                if (idx < 64 * 52) *(LAS u32x4*)(lds + VT_OFF + d * VSTR + c8 * 16) = vraw[it];
            }
        }
        __syncthreads();
        const int q0 = qb * 128 + 16 * w;
        if (q0 < L) {
            const int qpos = q0 + r;
            const int fb = (16 + 16 * w) >> 5, cb = fb < 1 ? 1 : fb;
            const bf16_t* qrow = QK + (size_t)seq_row(seq, qpos) * 1280 + hk * 256;
            u32x4 qn0 = *(const u32x4*)(qrow + 8 * g), qn1 = *(const u32x4*)(qrow + 32 + 8 * g);
#pragma unroll 1
            for (int hh = 0; hh < 4; ++hh) {
                const int head = hk * 4 + hh;
                bf16x8 qf0, qf1;
                {
                    const u32x4 r0 = qn0, r1 = qn1;
                    { const int hn = hh < 3 ? hh + 1 : 3;
                      qn0 = *(const u32x4*)(qrow + hn * 64 + 8 * g); qn1 = *(const u32x4*)(qrow + hn * 64 + 32 + 8 * g); }
                    float x[16] = {bflo(r0.x), bfhi(r0.x), bflo(r0.y), bfhi(r0.y), bflo(r0.z), bfhi(r0.z), bflo(r0.w), bfhi(r0.w),
                                   bflo(r1.x), bfhi(r1.x), bflo(r1.y), bfhi(r1.y), bflo(r1.z), bfhi(r1.z), bflo(r1.w), bfhi(r1.w)};
                    float ss = 0.f;
#pragma unroll
                    for (int i = 0; i < 16; ++i) ss += x[i] * x[i];
                    ss += __shfl_xor(ss, 16); ss += __shfl_xor(ss, 32);
                    const float ri = __builtin_amdgcn_rsqf(ss * (1.0f / 64.0f) + EPS) * (0.125f * 1.4426950408889634f);
                    const f32x4 ga = *(const f32x4*)(qg + 8 * g), gb = *(const f32x4*)(qg + 8 * g + 4), gc = *(const f32x4*)(qg + 32 + 8 * g), gd = *(const f32x4*)(qg + 36 + 8 * g);
                    u32x4 p0, p1;
                    p0.x = cvtpk(x[0] * ri * ga[0], x[1] * ri * ga[1]); p0.y = cvtpk(x[2] * ri * ga[2], x[3] * ri * ga[3]);
                    p0.z = cvtpk(x[4] * ri * gb[0], x[5] * ri * gb[1]); p0.w = cvtpk(x[6] * ri * gb[2], x[7] * ri * gb[3]);
                    p1.x = cvtpk(x[8] * ri * gc[0], x[9] * ri * gc[1]); p1.y = cvtpk(x[10] * ri * gc[2], x[11] * ri * gc[3]);
                    p1.z = cvtpk(x[12] * ri * gd[0], x[13] * ri * gd[1]); p1.w = cvtpk(x[14] * ri * gd[2], x[15] * ri * gd[3]);
                    qf0 = __builtin_bit_cast(bf16x8, p0); qf1 = __builtin_bit_cast(bf16x8, p1);
                }
                const LAS float* bt = BT + head * 257 + 128;
                const float shift = BT[16 * 257];
                const float sk = sink[head];
                float den = 0.f;
                f32x4 oacc[4];
#pragma unroll
                for (int dt = 0; dt < 4; ++dt) oacc[dt] = (f32x4){0.f, 0.f, 0.f, 0.f};
                const int lkoff = KN_OFF + (8 * (r >> 2) + (r & 3)) * KSTR + 16 * g;
                const int lvoff = VT_OFF + r * VSTR + 16 * g;
                const int lb = 8 * g - r;
#pragma unroll 2
                for (int i = 0; i < 10; ++i) {
                    const int chunk = i == 0 ? 0 : cb + i - 1;
                    const int kb = lkoff + 32 * chunk * KSTR;
                    const bf16x8 k00 = *(const LAS bf16x8*)(lds + kb), k01 = *(const LAS bf16x8*)(lds + kb + 64);
                    const bf16x8 k10 = *(const LAS bf16x8*)(lds + kb + 4 * KSTR), k11 = *(const LAS bf16x8*)(lds + kb + 4 * KSTR + 64);
                    f32x4 s0 = (f32x4){0.f, 0.f, 0.f, 0.f}, s1 = (f32x4){0.f, 0.f, 0.f, 0.f};
                    s0 = __builtin_amdgcn_mfma_f32_16x16x32_bf16(k00, qf0, s0, 0, 0, 0);
                    s1 = __builtin_amdgcn_mfma_f32_16x16x32_bf16(k10, qf0, s1, 0, 0, 0);
                    s0 = __builtin_amdgcn_mfma_f32_16x16x32_bf16(k01, qf1, s0, 0, 0, 0);
                    s1 = __builtin_amdgcn_mfma_f32_16x16x32_bf16(k11, qf1, s1, 0, 0, 0);
                    const int cs = start - 16 - q0 + 32 * chunk + lb;
                    float p[8];
                    const int pmin = start + 32 * chunk - 16;
                    const bool interior = (chunk > 0) && (pmin >= q0 + 15 - 128) && (pmin + 31 <= q0 + 128) && (pmin >= 16) && (pmin + 31 < L);
                    if (interior) {
#pragma unroll
                        for (int e = 0; e < 8; ++e) {
                            const float sv = e < 4 ? s0[e & 3] : s1[e & 3];
                            p[e] = __builtin_amdgcn_exp2f(sv + bt[cs + e]);
                            den += p[e];
                        }
                    } else {
                        const bool metal = (chunk == 0) && (g < 2);
#pragma unroll
                        for (int e = 0; e < 8; ++e) {
                            const float sv = e < 4 ? s0[e & 3] : s1[e & 3];
                            const int relb = cs + e, pos = relb + qpos;
                            const int relm = 8 * g + e - qpos;
                            const bool bvalid = ((unsigned)(relb + 128) <= 256u) && ((unsigned)(pos - 16) < (unsigned)(L - 16));
                            const int rel = metal ? relm : relb;
                            const bool valid = metal || bvalid;
                            const int relc = rel < -128 ? -128 : (rel > 128 ? 128 : rel);
                            const float val = __builtin_amdgcn_exp2f(sv + bt[relc]);
                            p[e] = valid ? val : 0.f;
                            den += p[e];
                        }
                    }
                    u32x4 pp; pp.x = cvtpk(p[0], p[1]); pp.y = cvtpk(p[2], p[3]); pp.z = cvtpk(p[4], p[5]); pp.w = cvtpk(p[6], p[7]);
                    const bf16x8 pa = __builtin_bit_cast(bf16x8, pp);
                    const int vbo = lvoff + 64 * chunk;
#pragma unroll
                    for (int dt = 0; dt < 4; ++dt) {
                        const bf16x8 vb = *(const LAS bf16x8*)(lds + vbo + dt * 16 * VSTR);
                        oacc[dt] = __builtin_amdgcn_mfma_f32_16x16x32_bf16(pa, vb, oacc[dt], 0, 0, 0);
                    }
                }
                den += __shfl_xor(den, 16); den += __shfl_xor(den, 32);
                den += __builtin_amdgcn_exp2f((sk - shift) * 1.4426950408889634f);
                const float inv = 1.0f / den;
#pragma unroll
                for (int ii = 0; ii < 4; ++ii) {
                    const float iv = __shfl(inv, 4 * g + ii);
                    bf16_t* op = O + (size_t)seq_row(seq, q0 + 4 * g + ii) * DM + head * 64 + r;
#pragma unroll
                    for (int dt = 0; dt < 4; ++dt) op[dt * 16] = (bf16_t)(cvtpk(oacc[dt][ii] * iv, 0.f) & 0xffffu);
                }
            }
        }
        __syncthreads();
    }
}

#define XB_TMO      128
#define XB_XCNT(j)  (256  + 64 * (j))
#define XB_XSUB(j)  (1280 + 64 * (j))
#define XB_XGEN(j)  (2304 + 64 * (j))
#define XB_TOP      3328
#define XB_TOPGEN   3392
#define XCD_BAR_WORDS 3456
#define XB_SPIN_CAP (1u << 18)

__device__ __forceinline__ unsigned xb_ld(unsigned* p)              { return __hip_atomic_load(p, __ATOMIC_RELAXED, __HIP_MEMORY_SCOPE_AGENT); }
__device__ __forceinline__ unsigned xb_add(unsigned* p, unsigned v) { return __hip_atomic_fetch_add(p, v, __ATOMIC_RELAXED, __HIP_MEMORY_SCOPE_AGENT); }
__device__ __forceinline__ unsigned xb_xcc_id() { return (unsigned)__builtin_amdgcn_s_getreg((3 << 11) | 20) & 0xFu; }
#define XB_SPIN(cond, bar) do { unsigned _sp = 0; while (cond) { __builtin_amdgcn_s_sleep(1); \
    if ((++_sp & 255u) == 0u) { if (xb_ld(&(bar)[XB_TMO])) break; if (_sp > XB_SPIN_CAP) { atomicAdd(&(bar)[XB_TMO], 1u); break; } } } } while (0)

struct XcdBarrier {
    unsigned* bar; unsigned x;
    volatile LAS unsigned* st;
};

__device__ __forceinline__ XcdBarrier xcd_barrier_post(unsigned* bar, volatile LAS unsigned* st) {
    XcdBarrier b; b.bar = bar; b.x = xb_xcc_id(); b.st = st;
    if (threadIdx.x == 0) (void)xb_add(&bar[XB_XCNT(b.x)], 1u);
    return b;
}
__device__ __forceinline__ void xcd_barrier_complete(unsigned* bar, unsigned x, unsigned& nloc, unsigned& nx) {
    const unsigned G = gridDim.x * gridDim.y * gridDim.z;
    unsigned sum, cnt, mine, sp = 0u;
    for (;;) {
        sum = 0u; cnt = 0u; mine = 0u;
#pragma unroll
        for (unsigned j = 0; j < 16; ++j) { const unsigned c = xb_ld(&bar[XB_XCNT(j)]); sum += c; cnt += (c > 0u) ? 1u : 0u; mine = (j == x) ? c : mine; }
        if (sum == G) break;
        __builtin_amdgcn_s_sleep(1);
        if ((++sp & 255u) == 0u) { if (xb_ld(&bar[XB_TMO])) break; if (sp > XB_SPIN_CAP) { atomicAdd(&bar[XB_TMO], 1u); break; } }
    }
    nloc = mine > 0u ? mine : 1u; nx = cnt > 0u ? cnt : 1u;
}

__device__ __forceinline__ void xcd_barrier(const XcdBarrier& b) {
    asm volatile("s_waitcnt vmcnt(0)" ::: "memory");
    __syncthreads();
    if (threadIdx.x == 0) {
        unsigned* bar = b.bar;
        __builtin_amdgcn_s_waitcnt(0);
        unsigned nloc = b.st[0], nx = b.st[1];
        if (nloc == 0u) { xcd_barrier_complete(bar, b.x, nloc, nx); b.st[0] = nloc; b.st[1] = nx; }
        const unsigned old = xb_add(&bar[XB_XSUB(b.x)], 1u);
        const unsigned gen = old / nloc;
        if (old + 1u == (gen + 1u) * nloc) {
            __builtin_amdgcn_fence(__ATOMIC_RELEASE, "agent");
            asm volatile("s_waitcnt vmcnt(0)" ::: "memory");
            const unsigned og = xb_add(&bar[XB_TOP], 1u);
            const unsigned tg = og / nx;
            if (og + 1u == (tg + 1u) * nx) xb_add(&bar[XB_TOPGEN], 1u);
            else XB_SPIN(xb_ld(&bar[XB_TOPGEN]) == tg, bar);
            __builtin_amdgcn_fence(__ATOMIC_ACQUIRE, "agent");
            xb_add(&bar[XB_XGEN(b.x)], 1u);
            asm volatile("s_waitcnt vmcnt(0)" ::: "memory");
        } else {
            XB_SPIN(xb_ld(&bar[XB_XGEN(b.x)]) == gen, bar);
            __builtin_amdgcn_fence(__ATOMIC_ACQUIRE, "agent");
            asm volatile("s_waitcnt vmcnt(0)" ::: "memory");
        }
    }
    __syncthreads();
}

constexpr int LDS_XB_OFF = 147456 - 64;
#ifndef PHMASK
#define PHMASK 0xFFFF
#endif
#define PH(b) if constexpr ((PHMASK >> (b)) & 1)
#define GRID_SYNC() do { XcdBarrier _b; { kargs_t _p = (kargs_t)__builtin_amdgcn_kernarg_segment_ptr(); asm volatile("" : "+s"(_p)); _b.bar = (unsigned*)_p->ws; } _b.x = xb_xcc_id(); _b.st = (volatile LAS unsigned*)(lds + LDS_XB_OFF); xcd_barrier(_b); } while (0)
#define GRID_SYNC_CG() do { asm volatile("s_waitcnt vmcnt(0) lgkmcnt(0)" ::: "memory"); grid.sync(); if ((threadIdx.x >> 6) == 0) { __builtin_amdgcn_fence(__ATOMIC_ACQUIRE, "agent"); asm volatile("s_waitcnt vmcnt(0)" ::: "memory"); } __syncthreads(); } while (0)
typedef const __attribute__((address_space(4))) Args* kargs_t;
__device__ __forceinline__ Args get_args() {
    kargs_t p = (kargs_t)__builtin_amdgcn_kernarg_segment_ptr();
    asm volatile("" : "+s"(p));
    Args a;
#pragma unroll
    for (int i = 0; i < 25; ++i) a.in[i] = p->in[i];
    a.out = p->out; a.ws = p->ws; a.layer_lo = p->layer_lo; a.layer_hi = p->layer_hi;
    return a;
}
__device__ __forceinline__ EpiResid make_resid(const Args& a, int layer, int which  , int rb) {
    u64* rowss = (u64*)(a.ws + WS_ROWSS); float* metah = (float*)(a.ws + WS_METAH);
    EpiResid e;
    const bool first = (layer == 0 && which == 0);
    e.srcA = first ? a.in[0] : a.out; e.srcB = first ? a.in[1] : a.out + (size_t)ROWS_P * DM; e.srcM = first ? a.in[2] : metah; e.meta_mask = first ? 15 : 0xffff;
    e.dstMain = a.out; e.dstM = metah;
    const int nxt = 2 * layer + 1 + which;
    e.P = nxt < 8 ? (bf16_t*)(a.ws + WS_P) : nullptr; e.rowss_next = nxt < 8 ? rowss + (size_t)nxt * MPAD : nullptr; e.row_base = rb;
    return e;
}
__global__ void __launch_bounds__(512, 2) fwd_megakernel(Args a_unused) {
    extern __shared__ __attribute__((aligned(16))) unsigned char lds_raw[];
    LAS unsigned char* lds = (LAS unsigned char*)lds_raw;
    cg::grid_group grid = cg::this_grid();
    const int G0 = gridDim.x, bid0 = blockIdx.x;
    volatile LAS unsigned* xst = (volatile LAS unsigned*)(lds + LDS_XB_OFF);
    if (threadIdx.x < 2) xst[threadIdx.x] = 0u;
    __syncthreads();
    (void)xcd_barrier_post((unsigned*)a_unused.ws, xst);

    const int layer_lo = a_unused.layer_lo, layer_hi = a_unused.layer_hi;
    if (layer_lo == 0) {
        const Args a = get_args(); const int tid = ltid(), G = lsg(G0), bid = lsg(bid0);
        const int lane = tid & 63, wave = __builtin_amdgcn_readfirstlane(tid >> 6);
        const int gw = bid * 7 + wave, NGW = G * 7;
        u64* rowss = (u64*)(a.ws + WS_ROWSS);
        bf16_t* Wb = (bf16_t*)(a.ws + WS_W);
        bf16_t* P = (bf16_t*)(a.ws + WS_P);
        for (size_t i = (size_t)bid * 512 + tid; i < (size_t)7 * MPAD; i += (size_t)G * 512) rowss[MPAD + i] = 0ull;
        if (wave == 7) {
            PH(1) for (int task = bid; task < 2 * 193; task += G) h2_features(lds + 7 * 16384, a, task / 193, (task % 193) * 64 + lane, lane);
        } else
        PH(0) {
        LAS float* scr = (LAS float*)(lds + wave * 16384);
#pragma unroll 1
        for (int j = 0; j < 2; ++j) {
            convert_matrix(a.in[6] + (size_t)j * 1024 * 3072, a.in[4] + (2 * j) * 1024, 1024, 3072, (bf16_t*)((char*)Wb + W_IN + (size_t)j * 6 * MiB), scr, gw, NGW, lane);
            convert_matrix(a.in[17] + (size_t)j * 1024 * 1024, nullptr, 1024, 1024, (bf16_t*)((char*)Wb + W_HOUT + (size_t)j * 2 * MiB), scr, gw, NGW, lane);
            convert_matrix(a.in[18] + (size_t)j * 1024 * 1536, a.in[4] + (2 * j + 1) * 1024, 1024, 1536, (bf16_t*)((char*)Wb + W_QKV + (size_t)j * 3 * MiB), scr, gw, NGW, lane);
            convert_matrix(a.in[22] + (size_t)j * 1024 * 1024, nullptr, 1024, 1024, (bf16_t*)((char*)Wb + W_AOUT + (size_t)j * 2 * MiB), scr, gw, NGW, lane);
        }
#pragma unroll 1
        for (int i = 0; i < 4; ++i) {
            convert_matrix(a.in[23] + (size_t)i * 1024 * 4096, a.in[5] + i * 1024, 1024, 4096, (bf16_t*)((char*)Wb + W_UP + (size_t)i * 8 * MiB), scr, gw, NGW, lane);
            convert_matrix(a.in[24] + (size_t)i * 4096 * 1024, nullptr, 4096, 1024, (bf16_t*)((char*)Wb + W_DN + (size_t)i * 8 * MiB), scr, gw, NGW, lane);
        }
        for (int row0 = gw; row0 < MREAL; row0 += 4 * NGW) {
            f32x4 v[4][4];
#pragma unroll
            for (int rr = 0; rr < 4; ++rr) {
                const int row = row0 + rr * NGW, rowc = row < MREAL ? row : MREAL - 1;
                const float* src = rowc < ROWS_P ? a.in[0] + (size_t)rowc * DM : (rowc < ROWS_MAIN ? a.in[1] + (size_t)(rowc - ROWS_P) * DM : a.in[2] + (size_t)((rowc - ROWS_MAIN) & 15) * DM);
#pragma unroll
                for (int k = 0; k < 4; ++k) v[rr][k] = *(const f32x4*)(src + k * 256 + lane * 4);
            }
#pragma unroll
            for (int rr = 0; rr < 4; ++rr) {
                const int row = row0 + rr * NGW;
                float ss = 0.f;
#pragma unroll
                for (int k = 0; k < 4; ++k) { const f32x4 x = v[rr][k];
                    ss += (x[0] * x[0] + x[1] * x[1]) + (x[2] * x[2] + x[3] * x[3]);
                    u32x2 pk; pk.x = cvtpk(x[0], x[1]); pk.y = cvtpk(x[2], x[3]);
                    if (row < MREAL) *(u32x2*)(P + (size_t)row * DM + k * 256 + lane * 4) = pk; }
                ss = wave_sum(ss);
                if (lane == 0 && row < MREAL) rowss[row] = (u64)(ss * SS_SCALE);
            }
        }
        }
        GRID_SYNC_CG();
    }

#pragma unroll 1
    for (int layer = layer_lo; layer < layer_hi; ++layer) {
        if ((layer & 1) == 0) {
            {
                const Args a = get_args(); const int tid = ltid(), G = lsg(G0), bid = lsg(bid0); const int j = layer >> 1;
                PH(2) fk_compute(a, j, bid * 8 + __builtin_amdgcn_readfirstlane(tid >> 6), G * 8, tid & 63);
                PH(3) {
                pg8::Gemm g{(const bf16_t*)(a.ws + WS_P), (const bf16_t*)(a.ws + WS_W + W_IN + (size_t)j * 6 * MiB), MPAD, 3072, 1024, 1024, 1024}; pg8::StaticOrder S; S.init(MPAD, 3072, G, bid);
                EpiHyIn E{(bf16_t*)(a.ws + WS_R1), (const u64*)(a.ws + WS_ROWSS) + (size_t)(2 * layer) * MPAD};
                pg8::gemm_phase<EpiHyIn>(lds, g, S, E);
                }
            }
            GRID_SYNC();
            { const Args a = get_args(); const int tid = ltid(), G = lsg(G0), bid = lsg(bid0); PH(4) conv_phase(lds, a, layer >> 1, bid, G, tid); }
            GRID_SYNC();
            { const Args a = get_args(); const int tid = ltid(), G = lsg(G0), bid = lsg(bid0); PH(5) transpose_phase(lds, a, bid, G, tid); }
            GRID_SYNC();
            {
                const Args a = get_args(); const int tid = ltid(), G = lsg(G0), bid = lsg(bid0); const int j = layer >> 1;
                PH(6) {
                pg8::Gemm g{(const bf16_t*)(a.ws + WS_R1), (const bf16_t*)(a.ws + WS_W + W_HOUT + (size_t)j * 2 * MiB), MPAD, 1024, 1024, 1024, 1024}; pg8::StaticOrder S; S.init(MPAD, 1024, G, bid);
                const EpiResid er = make_resid(a, layer, 0, 0);
                pg8::gemm_phase<EpiResid>(lds, g, S, er);
                }
            }
            GRID_SYNC();
        } else {
            {
                const Args a = get_args(); const int tid = ltid(), G = lsg(G0), bid = lsg(bid0); const int j = layer >> 1;
                PH(7) {
                pg8::Gemm g{(const bf16_t*)(a.ws + WS_P), (const bf16_t*)(a.ws + WS_W + W_QKV + (size_t)j * 3 * MiB), MPAD, 1536, 1024, 1024, 1024}; pg8::StaticOrder S; S.init(MPAD, 1536, G, bid);
                EpiRow<0> E{(bf16_t*)(a.ws + WS_R1), (bf16_t*)(a.ws + WS_VT), (const u64*)(a.ws + WS_ROWSS) + (size_t)(2 * layer) * MPAD, 0};
                pg8::gemm_phase<EpiRow<0>>(lds, g, S, E);
                }
            }
            GRID_SYNC();
            { const Args a = get_args(); const int tid = ltid(), G = lsg(G0), bid = lsg(bid0); PH(8) attn_phase(lds, a, layer >> 1, bid, G, tid); }
            GRID_SYNC();
            {
                const Args a = get_args(); const int tid = ltid(), G = lsg(G0), bid = lsg(bid0); const int j = layer >> 1;
                PH(9) {
                pg8::Gemm g{(const bf16_t*)(a.ws + WS_R3), (const bf16_t*)(a.ws + WS_W + W_AOUT + (size_t)j * 2 * MiB), MPAD, 1024, 1024, 1024, 1024}; pg8::StaticOrder S; S.init(MPAD, 1024, G, bid);
                const EpiResid er = make_resid(a, layer, 0, 0);
                pg8::gemm_phase<EpiResid>(lds, g, S, er);
                }
            }
            GRID_SYNC();
        }
#pragma unroll 1
        for (int half = 0; half < 2; ++half) {
            const int rb = half * MT_H0 * 256; const int mrows = (half == 0 ? MT_H0 : MT_H1) * 256;
            {
                const Args a = get_args(); const int tid = ltid(), G = lsg(G0), bid = lsg(bid0);
                PH(10) {
                pg8::Gemm g{(const bf16_t*)(a.ws + WS_P) + (size_t)rb * DM, (const bf16_t*)(a.ws + WS_W + W_UP + (size_t)layer * 8 * MiB), mrows, 4096, 1024, 1024, 1024}; pg8::StaticOrder S; S.init(mrows, 4096, G, bid);
                EpiRow<1> E{(bf16_t*)(a.ws + WS_R1), nullptr, (const u64*)(a.ws + WS_ROWSS) + (size_t)(2 * layer + 1) * MPAD, rb};
                pg8::gemm_phase<EpiRow<1>>(lds, g, S, E);
                }
            }
            GRID_SYNC();
            {
                const Args a = get_args(); const int tid = ltid(), G = lsg(G0), bid = lsg(bid0);
                PH(11) {
                const int drows = MT_H0 * 256;
                pg8::Gemm g{(const bf16_t*)(a.ws + WS_R1), (const bf16_t*)(a.ws + WS_W + W_DN + (size_t)layer * 8 * MiB), drows, 1024, 4096, 4096, 4096}; pg8::StaticOrder S; S.init(drows, 1024, G, bid);
                const EpiResid e2 = make_resid(a, layer, 1, rb);
                pg8::gemm_phase<EpiResid>(lds, g, S, e2);
                }
            }
            if (half == 1) {
                {
                    const Args a = get_args(); const int G = lsg(G0), bid = lsg(bid0);
                    PH(11) {
                    pg8::Gemm g2{(const bf16_t*)(a.ws + WS_R1) + (size_t)(MT_H0 * 256) * DFF, (const bf16_t*)(a.ws + WS_W + W_DN + (size_t)layer * 8 * MiB), 512, 1024, 4096 / DOWN_KS, 4096, 4096};
                    pg8::StaticOrder S2; S2.init_ks(512, 1024, DOWN_KS, G, bid);
                    EpiPartial ep{(float*)(a.ws + WS_R3)};
                    pg8::gemm_phase<EpiPartial>(lds, g2, S2, ep);
                    }
                }
                GRID_SYNC();
                const Args a = get_args(); const int tid = ltid(), G = lsg(G0), bid = lsg(bid0);
                const int nxt = 2 * layer + 2;
                meta_reduce((const float*)(a.ws + WS_R3), (float*)(a.ws + WS_METAH), nxt < 8 ? (bf16_t*)(a.ws + WS_P) : nullptr,
                            nxt < 8 ? (u64*)(a.ws + WS_ROWSS) + (size_t)nxt * MPAD : nullptr, bid * 8 + (tid >> 6), G * 8, tid & 63);
            }
            if (!(layer == layer_hi - 1 && half == 1)) GRID_SYNC();
        }
    }
}

constexpr int LDS_BYTES = 147456;
extern "C" void kernel_launch(void* const* d_in, const int* in_sizes, int n_in, void* d_out, int out_size, void* d_ws, size_t ws_size, hipStream_t stream) {
    static int grid = 0;
    if (grid == 0) {
        if (n_in != 25 || ws_size < WS_END) { fprintf(stderr, "kernel_launch: unexpected n_in %d or ws_size %zu (need %zu)\n", n_in, ws_size, (size_t)WS_END); grid = -1; return; }
        int dev = 0, cus = 0, per_cu = 0;
        (void)hipGetDevice(&dev);
        (void)hipDeviceGetAttribute(&cus, hipDeviceAttributeMultiprocessorCount, dev);
        if (hipFuncSetAttribute((const void*)fwd_megakernel, hipFuncAttributeMaxDynamicSharedMemorySize, LDS_BYTES) != hipSuccess) { fprintf(stderr, "kernel_launch: hipFuncSetAttribute failed\n"); grid = -1; return; }
        if (hipOccupancyMaxActiveBlocksPerMultiprocessor(&per_cu, (const void*)fwd_megakernel, 512, LDS_BYTES) != hipSuccess || per_cu < 1) { fprintf(stderr, "kernel_launch: occupancy query gives %d\n", per_cu); per_cu = 1; }
        (void)hipGetLastError();
        grid = cus * 1;
        fprintf(stderr, "kernel_launch: cus %d per_cu %d grid %d\n", cus, per_cu, grid);
    }
    if (grid < 0) return;
    Args a{};
    for (int i = 0; i < 25; ++i) a.in[i] = (const float*)d_in[i];
    a.out = (float*)d_out; a.ws = (unsigned char*)d_ws;
#ifndef NSPLIT
#define NSPLIT 1
#endif
    (void)hipMemsetAsync(d_ws, 0, 16384, stream);
    for (int part = 0; part < NSPLIT; ++part) {
        a.layer_lo = part * (4 / NSPLIT); a.layer_hi = (part + 1) * (4 / NSPLIT);
        void* args[] = {&a};
        hipError_t e = hipLaunchCooperativeKernel((const void*)fwd_megakernel, dim3(grid), dim3(512), args, LDS_BYTES, stream);
        if (e != hipSuccess) fprintf(stderr, "cooperative launch failed: %s (grid %d)\n", hipGetErrorString(e), grid);
    }
}
```

```cpp
#include <hip/hip_runtime.h>
#include <hip/hip_cooperative_groups.h>
#include <cstdio>
#include <cstdint>
namespace cg = cooperative_groups;

#define LAS __attribute__((address_space(3)))
typedef unsigned short bf16_t;
typedef short bf16x8 __attribute__((ext_vector_type(8)));
typedef float f32x4 __attribute__((ext_vector_type(4)));
typedef float f32x2 __attribute__((ext_vector_type(2)));
typedef unsigned u32x4 __attribute__((ext_vector_type(4)));
typedef unsigned u32x2 __attribute__((ext_vector_type(2)));
typedef __bf16 bf16x2_t __attribute__((ext_vector_type(2)));
typedef unsigned long long u64;
typedef unsigned long long u64x2 __attribute__((ext_vector_type(2)));
constexpr float SS_SCALE = 1048576.0f, SS_INV = 1.0f / (1048576.0f * 1024.0f);
__device__ __forceinline__ float ss_rinv(u64 v) { return __builtin_amdgcn_rsqf((float)v * SS_INV + 1e-6f); }

constexpr int DM = 1024, DFF = 4096;
constexpr int L_P = 8208, L_S = 4112;
constexpr int LS_P = 8256, LS_S = 4160, XPAD = 48;
constexpr int ROWS_P = 32768, ROWS_MAIN = 98304, MREAL = 98624, MPAD = 98816;
constexpr int MT_ALL = MPAD / 256;
constexpr int MT_H0 = 192, MT_H1 = MT_ALL - MT_H0;
constexpr float EPS = 1e-6f;

constexpr size_t MiB = 1u << 20;
constexpr size_t WS_ROWSS = 1 * MiB;
constexpr size_t WS_METAH = 8 * MiB;
constexpr size_t WS_H2T = 10 * MiB;
constexpr size_t WS_W = 17 * MiB;
constexpr size_t WS_FK = 107 * MiB;
constexpr size_t WS_P = 211 * MiB;
constexpr size_t WS_R1 = 404 * MiB, WS_R2 = 599 * MiB, WS_R3 = 794 * MiB, WS_END = 989 * MiB;
constexpr size_t WS_VT = 703 * MiB;
constexpr size_t W_IN = 0, W_HOUT = 12 * MiB, W_QKV = 16 * MiB, W_AOUT = 22 * MiB, W_UP = 26 * MiB, W_DN = 58 * MiB;
constexpr int H2N = 12320;
constexpr int FK_OFFS_P = 8704, FK_LEN_P = 17408, FK_OFFS_S = 4608, FK_LEN_S = 9216;
constexpr size_t FK_SAMPLE_OFF = (size_t)2 * 1024 * FK_LEN_P;

struct Args { const float* in[25]; float* out; unsigned char* ws; int layer_lo, layer_hi; };

__device__ __forceinline__ unsigned cvtpk(float lo, float hi) { f32x2 v = {lo, hi}; bf16x2_t b = __builtin_convertvector(v, bf16x2_t); return __builtin_bit_cast(unsigned, b); }
__device__ __forceinline__ float bf2f(unsigned short x) { return __builtin_bit_cast(float, (unsigned)x << 16); }
__device__ __forceinline__ float bflo(unsigned x) { return __builtin_bit_cast(float, x << 16); }
__device__ __forceinline__ float bfhi(unsigned x) { return __builtin_bit_cast(float, x & 0xffff0000u); }
__device__ __forceinline__ int ltid() { int t = threadIdx.x; asm volatile("" : "+v"(t)); return t; }
__device__ __forceinline__ int lsg(int x) { asm volatile("" : "+s"(x)); return x; }
__device__ __forceinline__ int seq_L(int s) { return s < 4 ? L_P : L_S; }
__device__ __forceinline__ int seq_LS(int s) { return s < 4 ? LS_P : LS_S; }
__device__ __forceinline__ size_t seq_off_ch(int s) { return s < 4 ? (size_t)s * 1024 * LS_P : (size_t)4 * 1024 * LS_P + (size_t)(s - 4) * 1024 * LS_S; }
__device__ __forceinline__ int seq_row(int s, int p) { return p < 16 ? ROWS_MAIN + 16 * s + p : (s < 4 ? s * 8192 : 32768 + (s - 4) * 4096) + p - 16; }
__device__ __forceinline__ void row_decode(int row0, int& s, int& p0, int& L) {
    if (row0 < ROWS_P) { s = row0 >> 13; p0 = 16 + (row0 & 8191); L = L_P; }
    else if (row0 < ROWS_MAIN) { const int r = row0 - ROWS_P; s = 4 + (r >> 12); p0 = 16 + (r & 4095); L = L_S; }
    else { const int r = row0 - ROWS_MAIN; s = r >> 4; p0 = r & 15; L = s < 4 ? L_P : L_S; }
}
__device__ __forceinline__ float wave_sum(float v) {
#pragma unroll
    for (int o = 1; o < 64; o <<= 1) v += __shfl_xor(v, o);
    return v;
}
__device__ __forceinline__ void my_sincos(float x, float& s, float& c) {
    const float k = rintf(x * 0.636619772367581f);
    float r = fmaf(-k, 1.57079625129699707031f, x);
    r = fmaf(-k, 7.54978941586159635335e-08f, r);
    r = fmaf(-k, 5.39030285815811905290e-15f, r);
    const float r2 = r * r;
    const float sp = r + r * r2 * (-1.6666654611e-1f + r2 * (8.3321608736e-3f + r2 * -1.9515295891e-4f));
    const float cp = 1.0f - 0.5f * r2 + r2 * r2 * (4.166664568298827e-2f + r2 * (-1.388731625493765e-3f + r2 * 2.443315711809948e-5f));
    const int n = ((int)k) & 3;
    s = (n == 0) ? sp : (n == 1) ? cp : (n == 2) ? -sp : -cp;
    c = (n == 0) ? cp : (n == 1) ? -sp : (n == 2) ? -cp : sp;
}
__device__ __forceinline__ float my_sin(float x) { float s, c; my_sincos(x, s, c); return s; }
__device__ __forceinline__ int t5_bucket(int rel) {
    const int n = rel < 0 ? -rel : rel; int b;
    if (n < 8) b = n; else if (n < 12) b = 8; else if (n < 16) b = 9; else if (n < 23) b = 10; else if (n < 32) b = 11;
    else if (n < 46) b = 12; else if (n < 64) b = 13; else if (n < 91) b = 14; else b = 15;
    return (rel > 0 ? 16 : 0) + b;
}

namespace pg8 {
#define PG8_LAS __attribute__((address_space(3)))
constexpr int BM = 256, BK = 64, HALF = 128, HTB = HALF * BK * 2, STAGE_BYTES = 8 * HTB, NXCD = 8, WGM = 8;
__host__ __device__ __forceinline__ int lds_byte(int r, int c) { const int st = (r >> 4) * 2 + (c >> 5), rr = r & 15, cc = c & 31, ob = rr * 64 + cc * 2; return st * 1024 + (ob ^ (((ob >> 9) & 1) << 5)); }
__host__ __device__ __forceinline__ void stage_rc(int b, int& R, int& C) { const int st = b / 1024, sb = b % 1024, swz = sb ^ (((sb >> 9) & 1) << 5); R = (st >> 1) * 16 + swz / 64; C = (st & 1) * 32 + (swz % 64) / 2; }
__host__ __device__ __forceinline__ int perm32(int rho) { const int n = rho >> 4, i = rho & 15; return 8 * (i >> 2) + 4 * n + (i & 3); }
struct Unit { int pm, pn, ks; };
struct Gemm { const bf16_t* A; const bf16_t* Bt; int M, N, K; int lda, ldb; };
struct StaticOrder {
    int nM, nN, nwg, G, c, KS;
    __host__ __device__ void init(int M, int N, int G_, int c_) { nM = M / BM; nN = N / BM; nwg = nM * nN; G = G_; c = c_; KS = 1; }
    __host__ __device__ void init_ks(int M, int N, int KS_, int G_, int c_) { nM = M / BM; nN = N / BM; KS = KS_; nwg = nM * nN * KS; G = G_; c = c_; }
    __host__ __device__ bool next(int i, Unit& u) const {
        const long L = (long)i * G + c; if (L >= nwg) return false;
        u.ks = 0;
        if (KS > 1) { const int l = (int)L; u.ks = l % KS; const int t = l / KS; u.pm = t % nM; u.pn = t / nM; return true; }
        int wgid = (int)L; { const int q = nwg / NXCD, r = nwg % NXCD, xcd = wgid % NXCD, off = wgid / NXCD; wgid = (xcd < r ? xcd * (q + 1) : r * (q + 1) + (xcd - r) * q) + off; }
        const int nig = WGM * nN, gid = wgid / nig, fm = gid * WGM, gsz = (nM - fm) < WGM ? (nM - fm) : WGM;
        u.pm = fm + ((wgid % nig) % gsz); u.pn = (wgid % nig) / gsz; return true;
    }
};

template <class Epi, bool ALIGN_EPI = true>
__device__ __forceinline__ void gemm_phase(PG8_LAS unsigned char* lds, const Gemm g, const StaticOrder& S, const Epi& E) {
    const int tid = ltid(), wid = __builtin_amdgcn_readfirstlane(tid >> 6), lane = tid & 63, wr = wid >> 2, wc = wid & 3, fr = lane & 15, fq = lane >> 4;
    const int K = g.K, nt = K / BK;
    unsigned voffA[2], voffB[2];
#pragma unroll
    for (int i = 0; i < 2; ++i) { int R, C; stage_rc(tid * 16 + i * 8192, R, C); const int Rb = Epi::PERM ? ((R & ~31) + perm32(R & 31)) : R;
        voffA[i] = (unsigned)(R * g.lda + C) * 2u; voffB[i] = (unsigned)(Rb * g.ldb + C) * 2u; }
    const size_t kstep = (size_t)(BK * 2);
    const size_t hstepA = (size_t)HALF * g.lda * 2, hstepB = (size_t)HALF * g.ldb * 2;
    const size_t tstepA = 2 * hstepA, tstepB = 2 * hstepB, ksA = (size_t)K * 2;
    const unsigned ldsw = (unsigned)wid * 1024u;
    const int aoff = lds_byte(wr * 64 + fr, fq * 8), boff = lds_byte(wc * 32 + fr, fq * 8);
#define PG8_SA(b, h) (((b) * 2 + (h)) * HTB)
#define PG8_SB(b, h) ((4 + (b) * 2 + (h)) * HTB)
#define PG8_STAGE(bufoff, gbase, voff) do { _Pragma("unroll") for (int _i = 0; _i < 2; ++_i) \
        __builtin_amdgcn_global_load_lds((const unsigned*)((const char*)(gbase) + (voff)[_i]), (PG8_LAS unsigned*)(lds + (bufoff) + ldsw + _i * 8192), 16, 0, 0); } while (0)
#define PG8_LDA(dst, b, h) do { _Pragma("unroll") for (int m = 0; m < 4; ++m) _Pragma("unroll") for (int k = 0; k < 2; ++k) dst[m][k] = *(const PG8_LAS bf16x8*)(lds + PG8_SA(b, h) + aoff + m * 2048 + k * 1024); } while (0)
#define PG8_LDB(dst, b, h) do { _Pragma("unroll") for (int n = 0; n < 2; ++n) _Pragma("unroll") for (int k = 0; k < 2; ++k) dst[n][k] = *(const PG8_LAS bf16x8*)(lds + PG8_SB(b, h) + boff + n * 2048 + k * 1024); } while (0)
#define PG8_MMA(ai, bj, At, Bt) do { __builtin_amdgcn_s_setprio(1); _Pragma("unroll") for (int m = 0; m < 4; ++m) _Pragma("unroll") for (int n = 0; n < 2; ++n) _Pragma("unroll") for (int k = 0; k < 2; ++k) \
        acc[ai][bj][m][n] = Epi::SWAP ? __builtin_amdgcn_mfma_f32_16x16x32_bf16(Bt[n][k], At[m][k], acc[ai][bj][m][n], 0, 0, 0) \
                                      : __builtin_amdgcn_mfma_f32_16x16x32_bf16(At[m][k], Bt[n][k], acc[ai][bj][m][n], 0, 0, 0); __builtin_amdgcn_s_setprio(0); } while (0)
#define PG8_WAIT_V(n) asm volatile("s_waitcnt vmcnt(" #n ")" ::: "memory")
#define PG8_WAIT_L(n) asm volatile("s_waitcnt lgkmcnt(" #n ")" ::: "memory")
#define PG8_BAR __builtin_amdgcn_s_barrier()
#define PG8_SCHED __builtin_amdgcn_sched_barrier(0)
    Unit cur, nxt; int ui = 0;
    if (!S.next(0, cur)) return;
    f32x4 acc[2][2][4][2];
#pragma unroll
    for (int a = 0; a < 2; ++a)
#pragma unroll
        for (int b = 0; b < 2; ++b)
#pragma unroll
            for (int m = 0; m < 4; ++m)
#pragma unroll
                for (int n = 0; n < 2; ++n) acc[a][b][m][n] = (f32x4){0.f, 0.f, 0.f, 0.f};
    bf16x8 At[4][2], B0[2][2], B1[2][2];
    const char* cA = (const char*)g.A + (size_t)cur.pm * tstepA + (size_t)cur.ks * ksA; const char* cB = (const char*)g.Bt + (size_t)cur.pn * tstepB + (size_t)cur.ks * ksA;
    PG8_STAGE(PG8_SB(0, 0), cB, voffB); PG8_STAGE(PG8_SB(0, 1), cB + hstepB, voffB); PG8_STAGE(PG8_SA(0, 0), cA, voffA); PG8_STAGE(PG8_SA(0, 1), cA + hstepA, voffA);
    if (wr == 1) PG8_BAR;
    PG8_WAIT_V(2); PG8_BAR;
    PG8_STAGE(PG8_SB(1, 0), cB + kstep, voffB); PG8_STAGE(PG8_SA(1, 0), cA + kstep, voffA); PG8_STAGE(PG8_SB(1, 1), cB + hstepB + kstep, voffB);
    PG8_WAIT_V(6); PG8_BAR;
    for (;;) {
        const bool has_next = S.next(ui + 1, nxt);
        const char* nA = has_next ? (const char*)g.A + (size_t)nxt.pm * tstepA + (size_t)nxt.ks * ksA : cA; const char* nB = has_next ? (const char*)g.Bt + (size_t)nxt.pn * tstepB + (size_t)nxt.ks * ksA : cB;
        for (int t = 0; t < nt; t += 2) {
            const bool last = (t == nt - 2);
            const char* a1 = cA + (size_t)(t + 1) * kstep;
            const char* a2 = last ? nA : cA + (size_t)(t + 2) * kstep; const char* b2 = last ? nB : cB + (size_t)(t + 2) * kstep;
            const char* a3 = a2 + kstep; const char* b3 = b2 + kstep;
            PG8_LDB(B0, 0, 0); PG8_LDB(B1, 0, 1); PG8_SCHED; PG8_LDA(At, 0, 0); PG8_STAGE(PG8_SA(1, 1), a1 + hstepA, voffA);
            PG8_WAIT_V(8); PG8_WAIT_L(0); PG8_BAR; PG8_MMA(0, 0, At, B0); PG8_MMA(0, 1, At, B1); PG8_BAR; PG8_SCHED;
            PG8_LDA(At, 0, 1); PG8_STAGE(PG8_SB(0, 0), b2, voffB); PG8_STAGE(PG8_SB(0, 1), b2 + hstepB, voffB); PG8_STAGE(PG8_SA(0, 0), a2, voffA);
            PG8_WAIT_V(8); PG8_WAIT_L(0); PG8_BAR; PG8_MMA(1, 0, At, B0); PG8_MMA(1, 1, At, B1); PG8_BAR; PG8_SCHED;
            PG8_LDB(B0, 1, 0); PG8_LDB(B1, 1, 1); PG8_SCHED; PG8_LDA(At, 1, 0); PG8_STAGE(PG8_SA(0, 1), a2 + hstepA, voffA);
            PG8_WAIT_V(8); PG8_WAIT_L(0); PG8_BAR; PG8_MMA(0, 0, At, B0); PG8_MMA(0, 1, At, B1); PG8_BAR; PG8_SCHED;
            PG8_LDA(At, 1, 1); PG8_STAGE(PG8_SB(1, 0), b3, voffB); PG8_STAGE(PG8_SB(1, 1), b3 + hstepB, voffB); PG8_STAGE(PG8_SA(1, 0), a3, voffA);
            PG8_WAIT_V(8); PG8_WAIT_L(0); PG8_BAR; PG8_MMA(1, 0, At, B0); PG8_MMA(1, 1, At, B1); PG8_BAR; PG8_SCHED;
        }
        if constexpr (ALIGN_EPI) { if (wr == 0) PG8_BAR; }
        E(acc, cur, wr, wc, fr, fq);
        if (!has_next) break;
#pragma unroll
        for (int a = 0; a < 2; ++a)
#pragma unroll
            for (int b = 0; b < 2; ++b)
#pragma unroll
                for (int m = 0; m < 4; ++m)
#pragma unroll
                    for (int n = 0; n < 2; ++n) acc[a][b][m][n] = (f32x4){0.f, 0.f, 0.f, 0.f};
        cur = nxt; cA = nA; cB = nB; ++ui;
        if constexpr (ALIGN_EPI) { if (wr == 1) PG8_BAR; }
    }
    PG8_WAIT_V(0);
    if constexpr (!ALIGN_EPI) { if (wr == 0) PG8_BAR; }
    PG8_BAR;
#undef PG8_SA
#undef PG8_SB
#undef PG8_STAGE
#undef PG8_LDA
#undef PG8_LDB
#undef PG8_MMA
#undef PG8_WAIT_V
#undef PG8_WAIT_L
#undef PG8_BAR
#undef PG8_SCHED
}
}

struct EpiHyIn {
    static constexpr bool PERM = false, SWAP = false;
    bf16_t* XT; const u64* rowss;
    __device__ __forceinline__ void operator()(const f32x4 (&acc)[2][2][4][2], const pg8::Unit& u, int wr, int wc, int fr, int fq) const {
        constexpr size_t REGION = (size_t)(WS_R2 - WS_R1) / 2;
#pragma unroll
        for (int ai = 0; ai < 2; ++ai)
#pragma unroll
            for (int m = 0; m < 4; ++m) {
                const int row0 = u.pm * 256 + ai * 128 + wr * 64 + m * 16;
                if (row0 >= MREAL) continue;
                const u64x2 s01 = *(const u64x2*)(rowss + row0 + 4 * fq), s23 = *(const u64x2*)(rowss + row0 + 4 * fq + 2);
                f32x4 ri; ri[0] = ss_rinv(s01[0]); ri[1] = ss_rinv(s01[1]); ri[2] = ss_rinv(s23[0]); ri[3] = ss_rinv(s23[1]);
                int s, p0, L; row_decode(row0, s, p0, L);
                const size_t so = seq_off_ch(s); const int LS = seq_LS(s);
#pragma unroll
                for (int bj = 0; bj < 2; ++bj)
#pragma unroll
                    for (int n = 0; n < 2; ++n) {
                        const int col = u.pn * 256 + bj * 128 + wc * 32 + n * 16 + fr;
                        const int part = col >> 10, ch = col & 1023;
                        const f32x4 v = acc[ai][bj][m][n] * ri;
                        u32x2 w; w.x = cvtpk(v[0], v[1]); w.y = cvtpk(v[2], v[3]);
                        *(u32x2*)(XT + (size_t)part * REGION + so + (size_t)ch * LS + XPAD + p0 + 4 * fq) = w;
                    }
            }
    }
};
template <int MODE> struct EpiRow {
    static constexpr bool PERM = true, SWAP = true;
    bf16_t* O; bf16_t* VT; const u64* rowss; int row_base;
    __device__ __forceinline__ void operator()(const f32x4 (&acc)[2][2][4][2], const pg8::Unit& u, int wr, int wc, int fr, int fq) const {
#pragma unroll
        for (int ai = 0; ai < 2; ++ai)
#pragma unroll
            for (int m = 0; m < 4; ++m) {
                const int lrow = u.pm * 256 + ai * 128 + wr * 64 + m * 16 + fr, grow = row_base + lrow;
                if (grow >= MREAL) continue;
                const float ri = ss_rinv(rowss[grow]);
#pragma unroll
                for (int bj = 0; bj < 2; ++bj) {
                    const int col0 = u.pn * 256 + bj * 128 + wc * 32 + 8 * fq;
                    f32x4 v0 = acc[ai][bj][m][0] * ri, v1 = acc[ai][bj][m][1] * ri;
                    if (MODE == 1) {
#pragma unroll
                        for (int i = 0; i < 4; ++i) { const float a = fmaxf(v0[i], 0.f), b = fmaxf(v1[i], 0.f); v0[i] = a * a; v1[i] = b * b; }
                        u32x4 w; w.x = cvtpk(v0[0], v0[1]); w.y = cvtpk(v0[2], v0[3]); w.z = cvtpk(v1[0], v1[1]); w.w = cvtpk(v1[2], v1[3]);
                        *(u32x4*)(O + (size_t)lrow * DFF + col0) = w;
                    } else {
                        if (col0 < 1280) {
                            u32x4 w; w.x = cvtpk(v0[0], v0[1]); w.y = cvtpk(v0[2], v0[3]); w.z = cvtpk(v1[0], v1[1]); w.w = cvtpk(v1[2], v1[3]);
                            *(u32x4*)(O + (size_t)grow * 1280 + col0) = w;
                        } else {
                            int s, p, L; row_decode(grow, s, p, L);
                            const int LS = seq_LS(s);
                            bf16_t* dst = VT + seq_off_ch(s) / 4 + (size_t)(col0 - 1280) * LS + XPAD + p;
#pragma unroll
                            for (int i = 0; i < 4; ++i) { dst[(size_t)i * LS] = (bf16_t)(cvtpk(v0[i], 0.f) & 0xffffu); dst[(size_t)(4 + i) * LS] = (bf16_t)(cvtpk(v1[i], 0.f) & 0xffffu); }
                        }
                    }
                }
            }
    }
};
struct EpiResid {
    static constexpr bool PERM = true, SWAP = true;
    const float* srcA; const float* srcB; const float* srcM; int meta_mask;
    float* dstMain; float* dstM; bf16_t* P; u64* rowss_next; int row_base;
    __device__ __forceinline__ void operator()(const f32x4 (&acc)[2][2][4][2], const pg8::Unit& u, int wr, int wc, int fr, int fq) const {
#pragma unroll
        for (int ai = 0; ai < 2; ++ai)
#pragma unroll
            for (int m = 0; m < 4; ++m) {
                const int grow = row_base + u.pm * 256 + ai * 128 + wr * 64 + m * 16 + fr;
                const bool ok = grow < MREAL;
                float ss = 0.f;
                if (ok) {
                    const float* src; float* dst;
                    if (grow < ROWS_P) { src = srcA + (size_t)grow * DM; dst = dstMain + (size_t)grow * DM; }
                    else if (grow < ROWS_MAIN) { src = srcB + (size_t)(grow - ROWS_P) * DM; dst = dstMain + (size_t)grow * DM; }
                    else { const int mr = grow - ROWS_MAIN; src = srcM + (size_t)(mr & meta_mask) * DM; dst = dstM + (size_t)mr * DM; }
#pragma unroll
                    for (int bj = 0; bj < 2; ++bj) {
                        const int col0 = u.pn * 256 + bj * 128 + wc * 32 + 8 * fq;
                        const f32x4 h0 = *(const f32x4*)(src + col0) + acc[ai][bj][m][0];
                        const f32x4 h1 = *(const f32x4*)(src + col0 + 4) + acc[ai][bj][m][1];
                        *(f32x4*)(dst + col0) = h0; *(f32x4*)(dst + col0 + 4) = h1;
                        if (P) { u32x4 w; w.x = cvtpk(h0[0], h0[1]); w.y = cvtpk(h0[2], h0[3]); w.z = cvtpk(h1[0], h1[1]); w.w = cvtpk(h1[2], h1[3]);
                            *(u32x4*)(P + (size_t)grow * DM + col0) = w; }
                        ss += (h0[0] * h0[0] + h0[1] * h0[1]) + (h0[2] * h0[2] + h0[3] * h0[3]) + (h1[0] * h1[0] + h1[1] * h1[1]) + (h1[2] * h1[2] + h1[3] * h1[3]);
                    }
                }
                ss += __shfl_xor(ss, 16); ss += __shfl_xor(ss, 32);
                if (ok && fq == 0 && rowss_next) atomicAdd(rowss_next + grow, (u64)(ss * SS_SCALE));
            }
    }
};

struct EpiPartial {
    static constexpr bool PERM = true, SWAP = true;
    float* PART;
    __device__ __forceinline__ void operator()(const f32x4 (&acc)[2][2][4][2], const pg8::Unit& u, int wr, int wc, int fr, int fq) const {
#pragma unroll
        for (int ai = 0; ai < 2; ++ai)
#pragma unroll
            for (int m = 0; m < 4; ++m) {
                const int lrow = u.pm * 256 + ai * 128 + wr * 64 + m * 16 + fr;
                float* dst = PART + ((size_t)u.ks * 512 + lrow) * DM + u.pn * 256 + wc * 32 + 8 * fq;
#pragma unroll
                for (int bj = 0; bj < 2; ++bj) { *(f32x4*)(dst + bj * 128) = acc[ai][bj][m][0]; *(f32x4*)(dst + bj * 128 + 4) = acc[ai][bj][m][1]; }
            }
    }
};
constexpr int DOWN_KS = 16;
__device__ __forceinline__ void meta_reduce(const float* PART, float* metah, bf16_t* P, u64* rowss_next, int gw, int NGW, int lane) {
    for (int lrow = gw; lrow < MREAL - ROWS_MAIN; lrow += NGW) {
        float ss = 0.f;
#pragma unroll
        for (int k = 0; k < 4; ++k) {
            const int col = k * 256 + lane * 4;
            f32x4 sum = *(const f32x4*)(metah + (size_t)lrow * DM + col);
#pragma unroll
            for (int ks = 0; ks < DOWN_KS; ++ks) sum += *(const f32x4*)(PART + ((size_t)ks * 512 + lrow) * DM + col);
            *(f32x4*)(metah + (size_t)lrow * DM + col) = sum;
            if (P) { u32x2 pk; pk.x = cvtpk(sum[0], sum[1]); pk.y = cvtpk(sum[2], sum[3]); *(u32x2*)(P + (size_t)(ROWS_MAIN + lrow) * DM + col) = pk; }
            ss += (sum[0] * sum[0] + sum[1] * sum[1]) + (sum[2] * sum[2] + sum[3] * sum[3]);
        }
        ss = wave_sum(ss);
        if (lane == 0 && rowss_next) rowss_next[ROWS_MAIN + lrow] = (u64)(ss * SS_SCALE);
    }
}

__device__ __forceinline__ void transpose_item(const float* W, const float* gain, int K, int N, bf16_t* WT, LAS float* scr, int item, int lane) {
    const int nblk = N / 32, kb = item / nblk, nb = item % nblk, k0 = 64 * kb, n0 = 32 * nb;
    {
        const int kr = lane >> 3, n4 = (lane & 7) * 4;
        f32x4 wv[8]; float gv[8];
#pragma unroll
        for (int i = 0; i < 8; ++i) { wv[i] = *(const f32x4*)(W + (size_t)(k0 + 8 * i + kr) * N + n0 + n4); gv[i] = gain ? gain[k0 + 8 * i + kr] : 1.0f; }
#pragma unroll
        for (int i = 0; i < 8; ++i) { LAS float* d = scr + (8 * i + kr) * 33 + n4; const f32x4 v = wv[i] * gv[i]; d[0] = v[0]; d[1] = v[1]; d[2] = v[2]; d[3] = v[3]; }
    }
    asm volatile("s_waitcnt lgkmcnt(0)" ::: "memory");
    const int c = lane & 7;
#pragma unroll
    for (int j = 0; j < 4; ++j) { const int n = (lane >> 3) + 8 * j; const LAS float* s = scr + (8 * c) * 33 + n;
        u32x4 o; o.x = cvtpk(s[0 * 33], s[1 * 33]); o.y = cvtpk(s[2 * 33], s[3 * 33]); o.z = cvtpk(s[4 * 33], s[5 * 33]); o.w = cvtpk(s[6 * 33], s[7 * 33]);
        *(u32x4*)(WT + (size_t)(n0 + n) * K + k0 + 8 * c) = o; }
    asm volatile("s_waitcnt lgkmcnt(0)" ::: "memory");
}
__device__ __forceinline__ void convert_matrix(const float* W, const float* gain, int K, int N, bf16_t* WT, LAS float* scr, int gw, int NGW, int lane) {
    const int nitems = (K / 64) * (N / 32);
    for (int it = gw; it < nitems; it += NGW) transpose_item(W, gain, K, N, WT, scr, it, lane);
}

__device__ __forceinline__ void h2_features(LAS unsigned char* lds, const Args& a, int j, int npr, int tid) {
    LAS float* hs = (LAS float*)lds;
    float* H2T = (float*)(a.ws + WS_H2T);
    const bool hvalid = npr < H2N;
    const int np = hvalid ? npr : H2N - 1;
    const int L = np < L_P ? L_P : L_S, n = np < L_P ? np : np - L_P;
    const float* w1 = a.in[9] + j * 33 * 64; const float* b1 = a.in[10] + j * 64; const float* fr1 = a.in[11] + j * 64;
    const float* w2 = a.in[12] + j * 64 * 64; const float* b2 = a.in[13] + j * 64; const float* fr2 = a.in[14] + j * 64;
    const float t = (float)n * (1.0f / (float)(L - 1));
    const float w = (6.283185307179586f / (float)L) * (float)n;
    float acc[64];
#pragma unroll
    for (int m = 0; m < 64; ++m) acc[m] = b1[m] + t * w1[m];
    for (int e = 0; e < 16; ++e) {
        const float f = 1e-4f + (float)e * ((15.0f - 1e-4f) / 15.0f);
        float s, c; my_sincos(f * w, s, c);
        const float* wc = w1 + (1 + e) * 64; const float* wsn = w1 + (17 + e) * 64;
#pragma unroll
        for (int m = 0; m < 64; ++m) acc[m] = fmaf(c, wc[m], fmaf(-s, wsn[m], acc[m]));
    }
#pragma unroll
    for (int m = 0; m < 64; ++m) hs[m * 64 + tid] = my_sin(fr1[m] * acc[m]);
#pragma unroll
    for (int m = 0; m < 64; ++m) acc[m] = b2[m];
    for (int e = 0; e < 64; ++e) {
        const float h = hs[e * 64 + tid]; const float* wr_ = w2 + e * 64;
#pragma unroll
        for (int m = 0; m < 64; ++m) acc[m] = fmaf(h, wr_[m], acc[m]);
    }
    if (hvalid) {
#pragma unroll
        for (int m = 0; m < 64; ++m) H2T[((size_t)j * H2N + np) * 64 + m] = my_sin(fr2[m] * acc[m]);
    }
}

__device__ __forceinline__ void split8(const f32x4 a, const f32x4 b, bf16x8& hi, bf16x8& lo) {
    u32x4 h, l;
    h.x = cvtpk(a[0], a[1]); h.y = cvtpk(a[2], a[3]); h.z = cvtpk(b[0], b[1]); h.w = cvtpk(b[2], b[3]);
    l.x = cvtpk(a[0] - bflo(h.x), a[1] - bfhi(h.x)); l.y = cvtpk(a[2] - bflo(h.y), a[3] - bfhi(h.y));
    l.z = cvtpk(b[0] - bflo(h.z), b[1] - bfhi(h.z)); l.w = cvtpk(b[2] - bflo(h.w), b[3] - bfhi(h.w));
    hi = __builtin_bit_cast(bf16x8, h); lo = __builtin_bit_cast(bf16x8, l);
}
__device__ __forceinline__ void fk_compute(const Args& a, int j, int gw, int NGW, int lane) {
    const float* H2 = (const float*)(a.ws + WS_H2T) + (size_t)j * H2N * 64;
    const float* w3 = a.in[15] + (size_t)j * 64 * 4096;
    const float* skip = a.in[16] + j * 2 * 1024;
    bf16_t* FK = (bf16_t*)(a.ws + WS_FK);
    const int n16 = lane & 15, g = lane >> 4;
#pragma unroll 1
    for (int it = gw; it < 2048; it += NGW) {
        const int pq = it & 3, cht = (it >> 2) & 63, dir = (it >> 8) & 1, o = (it >> 9) & 1, set = it >> 10;
        const int L = set ? L_S : L_P, offs = set ? FK_OFFS_S : FK_OFFS_P, len = set ? FK_LEN_S : FK_LEN_P, nbase = set ? L_P : 0;
        bf16_t* base = FK + (set ? FK_SAMPLE_OFF : 0);
        const int ch = cht * 16 + n16;
        bf16x8 Bh0, Bl0, Bh1, Bl1;
        {
            const float* wp = w3 + (o * 2 + dir) * 1024 + ch;
            f32x4 w0, w1, w2, w3v;
#pragma unroll
            for (int i = 0; i < 4; ++i) { w0[i] = wp[(size_t)(8 * g + i) * 4096]; w1[i] = wp[(size_t)(8 * g + 4 + i) * 4096];
                w2[i] = wp[(size_t)(32 + 8 * g + i) * 4096]; w3v[i] = wp[(size_t)(36 + 8 * g + i) * 4096]; }
            split8(w0, w1, Bh0, Bl0); split8(w2, w3v, Bh1, Bl1);
        }
        const float mind = -3.0701134573253944f, maxd = -15.350567286626972f;
        const float delta = fabsf(mind + (maxd - mind) * ((float)ch * (1.0f / 1023.0f)));
        const float skipv = skip[o * 1024 + ch];
        const float tinv = 1.0f / (float)(L - 1);
        bf16_t* rowp = base + ((size_t)o * 1024 + ch) * len;
        const int tq = offs / 64;
#pragma unroll 2
        for (int tile = pq * tq; tile < (pq + 1) * tq; ++tile) {
            const int n0 = tile * 16 + dir;
            const int nr = n0 + n16, nrc = nr < L ? nr : L - 1;
            const float* hp = H2 + (size_t)(nbase + nrc) * 64 + 8 * g;
            const f32x4 h0 = *(const f32x4*)hp, h1 = *(const f32x4*)(hp + 4), h2 = *(const f32x4*)(hp + 32), h3 = *(const f32x4*)(hp + 36);
            bf16x8 Ah0, Al0, Ah1, Al1; split8(h0, h1, Ah0, Al0); split8(h2, h3, Ah1, Al1);
            f32x4 acc = (f32x4){0.f, 0.f, 0.f, 0.f};
            acc = __builtin_amdgcn_mfma_f32_16x16x32_bf16(Al0, Bh0, acc, 0, 0, 0);
            acc = __builtin_amdgcn_mfma_f32_16x16x32_bf16(Al1, Bh1, acc, 0, 0, 0);
            acc = __builtin_amdgcn_mfma_f32_16x16x32_bf16(Ah0, Bl0, acc, 0, 0, 0);
            acc = __builtin_amdgcn_mfma_f32_16x16x32_bf16(Ah1, Bl1, acc, 0, 0, 0);
            acc = __builtin_amdgcn_mfma_f32_16x16x32_bf16(Ah0, Bh0, acc, 0, 0, 0);
            acc = __builtin_amdgcn_mfma_f32_16x16x32_bf16(Ah1, Bh1, acc, 0, 0, 0);
            float v[4];
#pragma unroll
            for (int ii = 0; ii < 4; ++ii) {
                const int n = n0 + 4 * g + ii;
                float x = acc[ii] * __expf(-((float)n * tinv) * delta);
                if (dir == 0 && n == 0) x += skipv;
                v[ii] = n < L ? x : 0.f;
            }
            u32x2 pk;
            if (dir == 0) { pk.x = cvtpk(v[0], v[1]); pk.y = cvtpk(v[2], v[3]); *(u32x2*)(rowp + offs + n0 + 4 * g) = pk; }
            else { pk.x = cvtpk(v[3], v[2]); pk.y = cvtpk(v[1], v[0]); *(u32x2*)(rowp + offs - (n0 + 4 * g + 3)) = pk; }
        }
    }
}

__device__ __forceinline__ u32x2 cld8(const void* p) { u32x2 v; asm volatile("global_load_dwordx2 %0, %1, off sc0 sc1\n\ts_waitcnt vmcnt(0)" : "=v"(v) : "v"(p) : "memory"); return v; }
__device__ __forceinline__ u32x4 cld16(const void* p) { u32x4 v; asm volatile("global_load_dwordx4 %0, %1, off sc0 sc1\n\ts_waitcnt vmcnt(0)" : "=v"(v) : "v"(p) : "memory"); return v; }
__device__ __forceinline__ unsigned short cld2(const void* p) { unsigned v; asm volatile("global_load_ushort %0, %1, off sc0 sc1\n\ts_waitcnt vmcnt(0)" : "=v"(v) : "v"(p) : "memory"); return (unsigned short)v; }
__device__ __forceinline__ f32x4 gate4(const bf16_t* xrow, int m, int L, float w0, float w1, float w2, float bb) {
    const u32x2 raw = *(const u32x2*)(xrow + m);
    const float x0 = bflo(raw.x), x1 = bfhi(raw.x), x2 = bflo(raw.y), x3 = bfhi(raw.y);
    const float xm = m > 0 ? bf2f(xrow[m - 1]) : 0.f, xp = (m + 4 < L) ? bf2f(xrow[m + 4]) : 0.f;
    f32x4 r;
    r[0] = w0 * xm + w1 * x0 + w2 * x1 + bb; r[1] = w0 * x0 + w1 * x1 + w2 * x2 + bb;
    r[2] = w0 * x1 + w1 * x2 + w2 * x3 + bb; r[3] = w0 * x2 + w1 * x3 + w2 * xp + bb;
    return r;
}
struct GateRaw { u32x2 raw; unsigned halo; };
__device__ __forceinline__ GateRaw gate_load(const bf16_t* xrow, int m, int L) {
    GateRaw r; r.raw = *(const u32x2*)(xrow + m);
    const unsigned xm = m > 0 ? (unsigned)xrow[m - 1] : 0u, xp = (m + 4 < L) ? (unsigned)xrow[m + 4] : 0u;
    r.halo = xm | (xp << 16); return r;
}
__device__ __forceinline__ f32x4 gate_eval(const GateRaw& gr, float w0, float w1, float w2, float bb) {
    const float x0 = bflo(gr.raw.x), x1 = bfhi(gr.raw.x), x2 = bflo(gr.raw.y), x3 = bfhi(gr.raw.y), xm = bflo(gr.halo), xp = bfhi(gr.halo);
    f32x4 r;
    r[0] = w0 * xm + w1 * x0 + w2 * x1 + bb; r[1] = w0 * x0 + w1 * x1 + w2 * x2 + bb;
    r[2] = w0 * x1 + w1 * x2 + w2 * x3 + bb; r[3] = w0 * x2 + w1 * x3 + w2 * xp + bb;
    return r;
}
template <int NQ, int NB, int L>
__device__ __forceinline__ void conv_unit(LAS unsigned char* lds, const Args& a, int j, int seq0, int c, int tid) {
    constexpr int QS = 64, GS = QS * NQ, WS = 4 * GS, PADL = 224;
    constexpr int LS = (NQ == 4) ? LS_P : LS_S;
    constexpr int LPD = (NQ == 4) ? 8720 : 4616;
    constexpr int OFFS = (NQ == 4) ? FK_OFFS_P : FK_OFFS_S, LEN = (NQ == 4) ? FK_LEN_P : FK_LEN_S;
    constexpr int S_LO = -QS * (NQ - 1), S_HI = ((L - 1) / 32) * 32;
    constexpr int U_OFF = 0, FKL_OFF = 77824, RED_OFF = 112640;
    static_assert(NB * LPD * 2 <= FKL_OFF && FKL_OFF + LEN * 2 <= RED_OFF, "conv LDS map");
    const int lane = tid & 63, w = __builtin_amdgcn_readfirstlane(tid >> 6);
    const bf16_t* X1 = (const bf16_t*)(a.ws + WS_R1); const bf16_t* X2 = (const bf16_t*)(a.ws + WS_R2); bf16_t* V = (bf16_t*)(a.ws + WS_R3);
    const bf16_t* FK = (const bf16_t*)(a.ws + WS_FK) + ((NQ == 4) ? 0 : FK_SAMPLE_OFF);
    const float* cw = a.in[7] + (size_t)j * 3 * 3072; const float* cb = a.in[8] + (size_t)j * 3072;
    constexpr int NF = (LEN / 8 + 511) / 512;
    u32x4 fkr[NF];
    {
        const u32x4* src = (const u32x4*)(FK + (size_t)c * LEN);
#pragma unroll
        for (int it = 0; it < NF; ++it) { const int i = it * 512 + tid; fkr[it] = src[i < LEN / 8 ? i : 0]; }
    }
    {
        const float w0 = cw[2048 + c], w1 = cw[3072 + 2048 + c], w2 = cw[2 * 3072 + 2048 + c], bb = cb[2048 + c];
        constexpr int NCH = LPD / 8, NIT = (NB * NCH + 511) / 512;
        u32x4 raws[NIT]; unsigned halos[NIT];
#pragma unroll
        for (int it = 0; it < NIT; ++it) {
            const int idx = it * 512 + tid; const int b = idx / NCH, ch = idx % NCH, p = ch * 8 - PADL;
            raws[it] = (u32x4){0u, 0u, 0u, 0u}; halos[it] = 0u;
            if (idx < NB * NCH && p >= 0 && p < L) {
                const bf16_t* row = V + seq_off_ch(seq0 + b) + (size_t)c * LS + XPAD + p;
                raws[it] = *(const u32x4*)row;
                const unsigned xm = p > 0 ? (unsigned)row[-1] : 0u, xp = (p + 8 < L) ? (unsigned)row[8] : 0u;
                halos[it] = xm | (xp << 16);
            }
        }
#pragma unroll
        for (int it = 0; it < NIT; ++it) {
            const int idx = it * 512 + tid; const int b = idx / NCH, ch = idx % NCH, p = ch * 8 - PADL;
            u32x4 o = {0u, 0u, 0u, 0u};
            if (p >= 0 && p < L) {
                const u32x4 raw = raws[it];
                float x[10];
                x[0] = bflo(halos[it]); x[9] = bfhi(halos[it]);
                x[1] = bflo(raw.x); x[2] = bfhi(raw.x); x[3] = bflo(raw.y); x[4] = bfhi(raw.y); x[5] = bflo(raw.z); x[6] = bfhi(raw.z); x[7] = bflo(raw.w); x[8] = bfhi(raw.w);
                float y[8];
#pragma unroll
                for (int i = 0; i < 8; ++i) y[i] = w0 * x[i] + w1 * x[i + 1] + w2 * x[i + 2] + bb;
                o.x = cvtpk(y[0], y[1]); o.y = cvtpk(y[2], y[3]); o.z = cvtpk(y[4], y[5]); o.w = cvtpk(y[6], y[7]);
            }
            if (idx < NB * NCH) *(LAS u32x4*)(lds + U_OFF + (b * LPD + ch * 8) * 2) = o;
        }
    }
    const int n = lane & 15, g = lane >> 4;
    const int q = (NQ == 4) ? (n >> 2) : (n >> 3), b = (NQ == 4) ? (n & 3) : (n & 7);
    const int ub = U_OFF + (b * LPD + PADL + QS * q + 8 * g) * 2;
    const int ubm = U_OFF + (b * LPD + PADL + 8 * g) * 2;
    const int pe = (1 + n) & 1;
    const int abr = FKL_OFF + (LEN - 1 - OFFS - n + 8 * g - pe) * 2;
    const unsigned sh = pe * 16;
    const int mw = 16 + WS * w;
    const int d_lo = mw - S_HI, d_hi = mw + 3 * GS - S_LO;
    const size_t xrow_off = seq_off_ch(seq0 + b) + (size_t)c * LS + XPAD;
#define ARAW(d, lagoff) do { const LAS unsigned* _p = (const LAS unsigned*)(lds + abr - (lagoff) * 2); d[0] = _p[0]; d[1] = _p[1]; d[2] = _p[2]; d[3] = _p[3]; d[4] = _p[4]; } while (0)
#define AFIN(dst, d) do { u32x4 _o; _o.x = __builtin_amdgcn_alignbit(d[1], d[0], sh); _o.y = __builtin_amdgcn_alignbit(d[2], d[1], sh); \
        _o.z = __builtin_amdgcn_alignbit(d[3], d[2], sh); _o.w = __builtin_amdgcn_alignbit(d[4], d[3], sh); dst = __builtin_bit_cast(bf16x8, _o); } while (0)
#define GATHER(dst, lagoff) do { unsigned _d[5]; ARAW(_d, lagoff); AFIN(dst, _d); } while (0)
#pragma unroll 1
    for (int o = 0; o < 2; ++o) {
#pragma unroll
        for (int it = 0; it < NF; ++it) { const int i = it * 512 + tid; const u32x4 v = fkr[it]; u32x4 r;
            r.x = __builtin_amdgcn_alignbit(v.w, v.w, 16); r.y = __builtin_amdgcn_alignbit(v.z, v.z, 16);
            r.z = __builtin_amdgcn_alignbit(v.y, v.y, 16); r.w = __builtin_amdgcn_alignbit(v.x, v.x, 16);
            if (i < LEN / 8) *(LAS u32x4*)(lds + FKL_OFF + (LEN / 8 - 1 - i) * 16) = r; }
        __syncthreads();
        if (o == 0) {
            const u32x4* src = (const u32x4*)(FK + ((size_t)1024 + c) * LEN);
#pragma unroll
            for (int it = 0; it < NF; ++it) { const int i = it * 512 + tid; fkr[it] = src[i < LEN / 8 ? i : 0]; }
        }
        f32x4 acc[4][4];
#pragma unroll
        for (int gi = 0; gi < 4; ++gi)
#pragma unroll
            for (int t = 0; t < 4; ++t) acc[gi][t] = (f32x4){0.f, 0.f, 0.f, 0.f};
        bf16x8 A0, A1, A2, A3, Bc[4], Bn[4];
        GATHER(A0, d_lo); GATHER(A1, d_lo + 16); GATHER(A2, d_lo + 32); GATHER(A3, d_lo + 48);
        int baddr = ub + 2 * (mw - d_lo);
#pragma unroll
        for (int gi = 0; gi < 4; ++gi) Bc[gi] = *(const LAS bf16x8*)(lds + baddr + 2 * GS * gi);
#define CONV_STEP(BCUR, BNXT, DL, CHECK) do { \
            unsigned r2[5], r3[5]; ARAW(r2, (DL) + 64); ARAW(r3, (DL) + 80); \
            baddr -= 64; \
            _Pragma("unroll") for (int gi = 0; gi < 4; ++gi) BNXT[gi] = *(const LAS bf16x8*)(lds + baddr + 2 * GS * gi); \
            __builtin_amdgcn_s_setprio(1); \
            _Pragma("unroll") for (int gi = 0; gi < 4; ++gi) { \
                const int s0 = mw + GS * gi - (DL); \
                if (!(CHECK) || ((s0 >= S_LO) && (s0 <= S_HI))) { \
                    acc[gi][0] = __builtin_amdgcn_mfma_f32_16x16x32_bf16(A0, BCUR[gi], acc[gi][0], 0, 0, 0); \
                    acc[gi][1] = __builtin_amdgcn_mfma_f32_16x16x32_bf16(A1, BCUR[gi], acc[gi][1], 0, 0, 0); \
                    acc[gi][2] = __builtin_amdgcn_mfma_f32_16x16x32_bf16(A2, BCUR[gi], acc[gi][2], 0, 0, 0); \
                    acc[gi][3] = __builtin_amdgcn_mfma_f32_16x16x32_bf16(A3, BCUR[gi], acc[gi][3], 0, 0, 0); \
                } \
            } \
            __builtin_amdgcn_s_setprio(0); \
            A0 = A2; A1 = A3; AFIN(A2, r2); AFIN(A3, r3); } while (0)
        const int dl_a = mw + 3 * GS - S_HI, dl_b = mw - S_LO;
        static_assert(((3 * GS / 32) % 2 == 0) && (((S_HI - S_LO - 3 * GS) / 32 + 1) % 2 == 1), "conv step-count parity");
#pragma unroll 1
        for (int dl = d_lo; dl < dl_a; dl += 64) { CONV_STEP(Bc, Bn, dl, true); CONV_STEP(Bn, Bc, dl + 32, true); }
#pragma unroll 1
        for (int dl = dl_a; dl < dl_b; dl += 64) { CONV_STEP(Bc, Bn, dl, false); CONV_STEP(Bn, Bc, dl + 32, false); }
        CONV_STEP(Bc, Bn, dl_b, false);
#pragma unroll 1
        for (int dl = dl_b + 32; dl <= d_hi; dl += 64) { CONV_STEP(Bn, Bc, dl, true); CONV_STEP(Bc, Bn, dl + 32, true); }
#undef CONV_STEP
        const bf16_t* X = (o == 0 ? X1 : X2) + xrow_off;
        const float w0 = cw[o * 1024 + c], w1 = cw[3072 + o * 1024 + c], w2 = cw[2 * 3072 + o * 1024 + c], bb = cb[o * 1024 + c];
        GateRaw gt[4][4];
        {
            const int mb = mw + QS * q + 4 * g; const bf16_t* Xb = X + mb;
#pragma unroll
            for (int gi = 0; gi < 4; ++gi)
#pragma unroll
                for (int t = 0; t < 4; ++t) { constexpr int dummy = 0; (void)dummy; const int off = GS * gi + 16 * t;
                    GateRaw r; r.raw = *(const u32x2*)(Xb + off);
                    const unsigned xm = (unsigned)Xb[off - 1]; unsigned xp = (unsigned)Xb[off + 4];
                    if (mb + off + 4 >= L) xp = 0u;
                    r.halo = xm | (xp << 16); gt[gi][t] = r; }
        }
        const GateRaw gtm = gate_load(X, 4 * g, L);
        f32x4 macc = (f32x4){0.f, 0.f, 0.f, 0.f};
#pragma unroll 1
        for (int t = w; t <= S_HI / 32; t += 8) {
            bf16x8 Am; GATHER(Am, -32 * t);
            const bf16x8 B = *(const LAS bf16x8*)(lds + ubm + t * 64);
            macc = __builtin_amdgcn_mfma_f32_16x16x32_bf16(Am, B, macc, 0, 0, 0);
        }
        *(LAS f32x4*)(lds + RED_OFF + (w * 64 + lane) * 16) = macc;
        __syncthreads();
        if (w == 0 && q == 0) {
            f32x4 s = (f32x4){0.f, 0.f, 0.f, 0.f};
#pragma unroll
            for (int ww = 0; ww < 8; ++ww) s += *(const LAS f32x4*)(lds + RED_OFF + (ww * 64 + lane) * 16);
            const int m = 4 * g;
            const f32x4 z = gate_eval(gtm, w0, w1, w2, bb) * s;
            u32x2 pk; pk.x = cvtpk(z[0], z[1]); pk.y = cvtpk(z[2], z[3]);
            if (o == 0) *(LAS u32x2*)(lds + U_OFF + (b * LPD + PADL + m) * 2) = pk;
            else *(u32x2*)(V + xrow_off + m) = pk;
        }
#pragma unroll
        for (int gi = 0; gi < 4; ++gi)
#pragma unroll
            for (int t = 0; t < 4; ++t) {
                const int m = mw + GS * gi + 16 * t + QS * q + 4 * g;
                const f32x4 z = gate_eval(gt[gi][t], w0, w1, w2, bb) * acc[gi][t];
                u32x2 pk; pk.x = cvtpk(z[0], z[1]); pk.y = cvtpk(z[2], z[3]);
                if (o == 0) *(LAS u32x2*)(lds + U_OFF + (b * LPD + PADL + m) * 2) = pk;
                else *(u32x2*)(V + xrow_off + m) = pk;
            }
        __syncthreads();
    }
#undef GATHER
#undef ARAW
#undef AFIN
}
__device__ __forceinline__ void conv_phase(LAS unsigned char* lds, const Args& a, int j, int bid, int G, int tid) {
#pragma unroll 1
    for (int u0 = bid; u0 < 3072; u0 += G) {
        const int u = u0;
        int tl = tid; asm volatile("" : "+v"(tl));
        if (u < 1024) conv_unit<4, 4, L_P>(lds, a, j, 0, u, tl);
        else { const int v = u - 1024; conv_unit<2, 8, L_S>(lds, a, j, 4 + 8 * (v & 1), v >> 1, tl); }
    }
}

__device__ __forceinline__ void transpose_phase(LAS unsigned char* lds, const Args& a, int bid, int G, int tid) {
    const bf16_t* ZT = (const bf16_t*)(a.ws + WS_R3); bf16_t* OUT = (bf16_t*)(a.ws + WS_R1);
    constexpr int TP = 129, TS = 65, UP = 4 * TP * 4, US = 16 * TS * 4, TILEB = 256 * 72 * 2;
#define TR_DECODE(u, s, p0, np, c0) do { int _cq, _tt; if ((u) < UP) { _cq = (u) & 3; const int _v = (u) >> 2; s = _v / TP; _tt = _v % TP; } \
        else { const int _r = (u) - UP; _cq = _r & 3; const int _v = _r >> 2; s = 4 + _v / TS; _tt = _v % TS; } \
        p0 = _tt == 0 ? 0 : 16 + 64 * (_tt - 1); np = _tt == 0 ? 16 : 64; c0 = _cq * 256; } while (0)
#define TR_LOAD(u) do { int _s, _p0, _np, _c0; TR_DECODE(u, _s, _p0, _np, _c0); const int _LS = seq_LS(_s), _nq = _np / 4; \
        const bf16_t* _src = ZT + seq_off_ch(_s) + (size_t)_c0 * _LS + XPAD + _p0; \
        _Pragma("unroll") for (int _k = 0; _k < 8; ++_k) { const int _task = _k * 512 + tid; const int _ch = _task / _nq, _pc = _task % _nq; \
            rg[_k] = (_task < 256 * _nq) ? *(const u32x2*)(_src + (size_t)_ch * _LS + 4 * _pc) : (u32x2){0u, 0u}; } } while (0)
    u32x2 rg[8];
    int u = bid, par = 0;
    if (u < UP + US) TR_LOAD(u);
#pragma unroll 1
    for (; u < UP + US; u += G, par ^= 1) {
        int s, p0, np, c0; TR_DECODE(u, s, p0, np, c0);
        const int nq = np / 4; LAS unsigned char* tile = lds + par * TILEB;
#pragma unroll
        for (int k = 0; k < 8; ++k) { const int task = k * 512 + tid; const int ch = task / nq, pc = task % nq;
            if (task < 256 * nq) *(LAS u32x2*)(tile + (ch * 72 + 4 * pc) * 2) = rg[k]; }
        __syncthreads();
        if (u + G < UP + US) TR_LOAD(u + G);
        for (int task = tid; task < np * 32; task += 512) { const int pos = task % np, cc = task / np;
            const LAS unsigned short* t = (const LAS unsigned short*)(tile + ((8 * cc) * 72 + pos) * 2);
            u32x4 o; o.x = (unsigned)t[0] | ((unsigned)t[72] << 16); o.y = (unsigned)t[144] | ((unsigned)t[216] << 16);
            o.z = (unsigned)t[288] | ((unsigned)t[360] << 16); o.w = (unsigned)t[432] | ((unsigned)t[504] << 16);
            *(u32x4*)(OUT + (size_t)seq_row(s, p0 + pos) * DM + c0 + 8 * cc) = o; }
    }
    __syncthreads();
#undef TR_DECODE
#undef TR_LOAD
}

__device__ __forceinline__ void attn_qfrag(const u32x4 r0, const u32x4 r1, const float* qg, int g, bf16x8& qf0, bf16x8& qf1) {
    float x[16] = {bflo(r0.x), bfhi(r0.x), bflo(r0.y), bfhi(r0.y), bflo(r0.z), bfhi(r0.z), bflo(r0.w), bfhi(r0.w),
                   bflo(r1.x), bfhi(r1.x), bflo(r1.y), bfhi(r1.y), bflo(r1.z), bfhi(r1.z), bflo(r1.w), bfhi(r1.w)};
    float ss = 0.f;
#pragma unroll
    for (int i = 0; i < 16; ++i) ss += x[i] * x[i];
    ss += __shfl_xor(ss, 16); ss += __shfl_xor(ss, 32);
    const float ri = __builtin_amdgcn_rsqf(ss * (1.0f / 64.0f) + EPS) * (0.125f * 1.4426950408889634f);
    const f32x4 ga = *(const f32x4*)(qg + 8 * g), gb = *(const f32x4*)(qg + 8 * g + 4), gc = *(const f32x4*)(qg + 32 + 8 * g), gd = *(const f32x4*)(qg + 36 + 8 * g);
    u32x4 p0, p1;
    p0.x = cvtpk(x[0] * ri * ga[0], x[1] * ri * ga[1]); p0.y = cvtpk(x[2] * ri * ga[2], x[3] * ri * ga[3]);
    p0.z = cvtpk(x[4] * ri * gb[0], x[5] * ri * gb[1]); p0.w = cvtpk(x[6] * ri * gb[2], x[7] * ri * gb[3]);
    p1.x = cvtpk(x[8] * ri * gc[0], x[9] * ri * gc[1]); p1.y = cvtpk(x[10] * ri * gc[2], x[11] * ri * gc[3]);
    p1.z = cvtpk(x[12] * ri * gd[0], x[13] * ri * gd[1]); p1.w = cvtpk(x[14] * ri * gd[2], x[15] * ri * gd[3]);
    qf0 = __builtin_bit_cast(bf16x8, p0); qf1 = __builtin_bit_cast(bf16x8, p1);
}
__device__ __forceinline__ bf16x8 attn_scores(const f32x4 s0, const f32x4 s1, const LAS float* bt, int cs, bool interior, bool metal, int g, int qpos, int L, float& den) {
    float p[8];
    if (interior) {
#pragma unroll
        for (int e = 0; e < 8; ++e) { const float sv = e < 4 ? s0[e & 3] : s1[e & 3]; p[e] = __builtin_amdgcn_exp2f(sv + bt[cs + e]); den += p[e]; }
    } else {
#pragma unroll
        for (int e = 0; e < 8; ++e) {
            const float sv = e < 4 ? s0[e & 3] : s1[e & 3];
            const int relb = cs + e, pos = relb + qpos;
            const int relm = 8 * g + e - qpos;
            const bool bvalid = ((unsigned)(relb + 128) <= 256u) && ((unsigned)(pos - 16) < (unsigned)(L - 16));
            const int rel = metal ? relm : relb;
            const bool valid = metal || bvalid;
            const int relc = rel < -128 ? -128 : (rel > 128 ? 128 : rel);
            const float val = __builtin_amdgcn_exp2f(sv + bt[relc]);
            p[e] = valid ? val : 0.f;
            den += p[e];
        }
    }
    u32x4 pp; pp.x = cvtpk(p[0], p[1]); pp.y = cvtpk(p[2], p[3]); pp.z = cvtpk(p[4], p[5]); pp.w = cvtpk(p[6], p[7]);
    return __builtin_bit_cast(bf16x8, pp);
}
__device__ __forceinline__ void attn_store(const f32x4 (&oacc)[4], float den, float sk, float shift, bf16_t* O, int seq, int q0, int g, int r, int head) {
    den += __shfl_xor(den, 16); den += __shfl_xor(den, 32);
    den += __builtin_amdgcn_exp2f((sk - shift) * 1.4426950408889634f);
    const float inv = 1.0f / den;
#pragma unroll
    for (int ii = 0; ii < 4; ++ii) {
        const float iv = __shfl(inv, 4 * g + ii);
        bf16_t* op = O + (size_t)seq_row(seq, q0 + 4 * g + ii) * DM + head * 64 + r;
#pragma unroll
        for (int dt = 0; dt < 4; ++dt) op[dt * 16] = (bf16_t)(cvtpk(oacc[dt][ii] * iv, 0.f) & 0xffffu);
    }
}
__device__ __forceinline__ void attn_phase(LAS unsigned char* lds, const Args& a, int j, int bid, int G, int tid) {
    constexpr int KN_OFF = 0, KSTR = 144, VT_OFF = 59904, VSTR = 848, BT_OFF = 114176;
    const bf16_t* QK = (const bf16_t*)(a.ws + WS_R1); const bf16_t* VTg = (const bf16_t*)(a.ws + WS_VT); bf16_t* O = (bf16_t*)(a.ws + WS_R3);
    const float* rel_bias = a.in[3]; const float* qg = a.in[19] + j * 64; const float* kg = a.in[20] + j * 64; const float* sink = a.in[21] + j * 16;
    const int lane = tid & 63, w = __builtin_amdgcn_readfirstlane(tid >> 6), r = lane & 15, g = lane >> 4;
    LAS float* BT = (LAS float*)(lds + BT_OFF);
    if (tid < 64) { float mq = fabsf(qg[tid]), mk = fabsf(kg[tid]);
#pragma unroll
        for (int o = 1; o < 64; o <<= 1) { mq = fmaxf(mq, __shfl_xor(mq, o)); mk = fmaxf(mk, __shfl_xor(mk, o)); }
        if (tid == 0) BT[16 * 257] = 8.0f * mq * mk; }
    __syncthreads();
    {
        const float shift0 = BT[16 * 257];
        for (int i = tid; i < 16 * 257; i += 512) { const int h = i / 257, rel = i % 257 - 128; BT[i] = (rel_bias[t5_bucket(rel) * 16 + h] - shift0) * 1.4426950408889634f; }
    }
    __syncthreads();
    constexpr int NU = (4 * 65 + 16 * 33) * 4;
    for (int u = bid; u < NU; u += G) {
        const int hk = u & 3; int v = u >> 2, seq, qb, L;
        if (v < 260) { seq = v / 65; qb = v % 65; L = L_P; } else { v -= 260; seq = 4 + v / 33; qb = v % 33; L = L_S; }
        const int start = qb * 128 - 128;
        {
            const bf16_t* vb = VTg + seq_off_ch(seq) / 4 + (size_t)(hk * 64) * seq_LS(seq) + XPAD;
            const int LS = seq_LS(seq);
            u32x4 kraw[7], vraw[7];
#pragma unroll
            for (int it = 0; it < 7; ++it) {
                const int idx = it * 512 + tid;
                { const int slot = idx >> 3, dc = idx & 7; const int pos = slot < 16 ? slot : start + slot - 16;
                  const bool valid = (idx < 416 * 8) && (slot < 16 || (slot < 400 && pos >= 16 && pos < L));
                  kraw[it] = (u32x4){0u, 0u, 0u, 0u};
                  if (valid) kraw[it] = *(const u32x4*)(QK + (size_t)seq_row(seq, pos) * 1280 + 1024 + hk * 64 + dc * 8); }
                { const int d = idx / 52, c8 = idx % 52; const int pos0 = c8 < 2 ? 8 * c8 : start + 8 * c8 - 16;
                  const bool valid = (idx < 64 * 52) && (c8 < 2 || (c8 < 50 && pos0 >= 16 && pos0 < L));
                  vraw[it] = (u32x4){0u, 0u, 0u, 0u};
                  if (valid) vraw[it] = *(const u32x4*)(vb + (size_t)d * LS + pos0); }
            }
#pragma unroll
            for (int it = 0; it < 7; ++it) {
                const int idx = it * 512 + tid;
                const int slot = idx >> 3, dc = idx & 7;
                const u32x4 raw = kraw[it];
                float x[8] = {bflo(raw.x), bfhi(raw.x), bflo(raw.y), bfhi(raw.y), bflo(raw.z), bfhi(raw.z), bflo(raw.w), bfhi(raw.w)};
                float ss = 0.f;
#pragma unroll
                for (int i = 0; i < 8; ++i) ss += x[i] * x[i];
                ss += __shfl_xor(ss, 1); ss += __shfl_xor(ss, 2); ss += __shfl_xor(ss, 4);
                const float ri = __builtin_amdgcn_rsqf(ss * (1.0f / 64.0f) + EPS);
                const f32x4 g0 = *(const f32x4*)(kg + dc * 8), g1 = *(const f32x4*)(kg + dc * 8 + 4);
                u32x4 o; o.x = cvtpk(x[0] * ri * g0[0], x[1] * ri * g0[1]); o.y = cvtpk(x[2] * ri * g0[2], x[3] * ri * g0[3]);
                o.z = cvtpk(x[4] * ri * g1[0], x[5] * ri * g1[1]); o.w = cvtpk(x[6] * ri * g1[2], x[7] * ri * g1[3]);
                if (idx < 416 * 8) *(LAS u32x4*)(lds + KN_OFF + slot * KSTR + dc * 16) = o;
                const int d = idx / 52, c8 = idx % 52;
                if (idx < 64 * 52) *(LAS u32x4*)(lds + VT_OFF + d * VSTR + c8 * 16) = vraw[it];
            }
        }
        __syncthreads();
        const int q0 = qb * 128 + 16 * w;
        if (q0 < L) {
            const int qpos = q0 + r;
            const int fb = (16 + 16 * w) >> 5, cb = fb < 1 ? 1 : fb;
            const bf16_t* qrow = QK + (size_t)seq_row(seq, qpos) * 1280 + hk * 256;
            const float shift = BT[16 * 257];
            const int lkoff = KN_OFF + (8 * (r >> 2) + (r & 3)) * KSTR + 16 * g;
            const int lvoff = VT_OFF + r * VSTR + 16 * g;
            const int lb = 8 * g - r;
#pragma unroll 1
            for (int hp = 0; hp < 2; ++hp) {
                const int hA = hk * 4 + 2 * hp, hB = hA + 1;
                bf16x8 qA0, qA1, qB0, qB1;
                {
                    const bf16_t* qa = qrow + (2 * hp) * 64; const bf16_t* qb_ = qa + 64;
                    const u32x4 a0 = *(const u32x4*)(qa + 8 * g), a1 = *(const u32x4*)(qa + 32 + 8 * g), b0 = *(const u32x4*)(qb_ + 8 * g), b1 = *(const u32x4*)(qb_ + 32 + 8 * g);
                    attn_qfrag(a0, a1, qg, g, qA0, qA1); attn_qfrag(b0, b1, qg, g, qB0, qB1);
                }
                const LAS float* btA = BT + hA * 257 + 128; const LAS float* btB = BT + hB * 257 + 128;
                float denA = 0.f, denB = 0.f;
                f32x4 oA[4], oB[4];
#pragma unroll
                for (int dt = 0; dt < 4; ++dt) { oA[dt] = (f32x4){0.f, 0.f, 0.f, 0.f}; oB[dt] = (f32x4){0.f, 0.f, 0.f, 0.f}; }
#pragma unroll 2
                for (int i = 0; i < 10; ++i) {
                    const int chunk = i == 0 ? 0 : cb + i - 1;
                    const int kb = lkoff + 32 * chunk * KSTR;
                    const bf16x8 k00 = *(const LAS bf16x8*)(lds + kb), k01 = *(const LAS bf16x8*)(lds + kb + 64);
                    const bf16x8 k10 = *(const LAS bf16x8*)(lds + kb + 4 * KSTR), k11 = *(const LAS bf16x8*)(lds + kb + 4 * KSTR + 64);
                    const f32x4 z4 = (f32x4){0.f, 0.f, 0.f, 0.f};
                    f32x4 sA0 = __builtin_amdgcn_mfma_f32_16x16x32_bf16(k00, qA0, z4, 0, 0, 0);
                    f32x4 sA1 = __builtin_amdgcn_mfma_f32_16x16x32_bf16(k10, qA0, z4, 0, 0, 0);
                    f32x4 sB0 = __builtin_amdgcn_mfma_f32_16x16x32_bf16(k00, qB0, z4, 0, 0, 0);
                    f32x4 sB1 = __builtin_amdgcn_mfma_f32_16x16x32_bf16(k10, qB0, z4, 0, 0, 0);
                    sA0 = __builtin_amdgcn_mfma_f32_16x16x32_bf16(k01, qA1, sA0, 0, 0, 0);
                    sA1 = __builtin_amdgcn_mfma_f32_16x16x32_bf16(k11, qA1, sA1, 0, 0, 0);
                    sB0 = __builtin_amdgcn_mfma_f32_16x16x32_bf16(k01, qB1, sB0, 0, 0, 0);
                    sB1 = __builtin_amdgcn_mfma_f32_16x16x32_bf16(k11, qB1, sB1, 0, 0, 0);
                    const int cs = start - 16 - q0 + 32 * chunk + lb;
                    const int pmin = start + 32 * chunk - 16;
                    const bool interior = (chunk > 0) && (pmin >= q0 + 15 - 128) && (pmin + 31 <= q0 + 128) && (pmin >= 16) && (pmin + 31 < L);
                    const bool metal = (chunk == 0) && (g < 2);
                    const bf16x8 paA = attn_scores(sA0, sA1, btA, cs, interior, metal, g, qpos, L, denA);
                    const bf16x8 paB = attn_scores(sB0, sB1, btB, cs, interior, metal, g, qpos, L, denB);
                    const int vbo = lvoff + 64 * chunk;
#pragma unroll
                    for (int dt = 0; dt < 4; ++dt) {
                        const bf16x8 vb = *(const LAS bf16x8*)(lds + vbo + dt * 16 * VSTR);
                        oA[dt] = __builtin_amdgcn_mfma_f32_16x16x32_bf16(paA, vb, oA[dt], 0, 0, 0);
                        oB[dt] = __builtin_amdgcn_mfma_f32_16x16x32_bf16(paB, vb, oB[dt], 0, 0, 0);
                    }
                }
                attn_store(oA, denA, sink[hA], shift, O, seq, q0, g, r, hA);
                attn_store(oB, denB, sink[hB], shift, O, seq, q0, g, r, hB);
            }
        }
        __syncthreads();
    }
}

#define XB_TMO      128
#define XB_XCNT(j)  (256  + 64 * (j))
#define XB_XSUB(j)  (1280 + 64 * (j))
#define XB_XGEN(j)  (2304 + 64 * (j))
#define XB_TOP      3328
#define XB_TOPGEN   3392
#define XCD_BAR_WORDS 3456
#define XB_SPIN_CAP (1u << 18)

__device__ __forceinline__ unsigned xb_ld(unsigned* p)              { return __hip_atomic_load(p, __ATOMIC_RELAXED, __HIP_MEMORY_SCOPE_AGENT); }
__device__ __forceinline__ unsigned xb_add(unsigned* p, unsigned v) { return __hip_atomic_fetch_add(p, v, __ATOMIC_RELAXED, __HIP_MEMORY_SCOPE_AGENT); }
__device__ __forceinline__ unsigned xb_xcc_id() { return (unsigned)__builtin_amdgcn_s_getreg((3 << 11) | 20) & 0xFu; }
#define XB_SPIN(cond, bar) do { unsigned _sp = 0; while (cond) { __builtin_amdgcn_s_sleep(1); \
    if ((++_sp & 255u) == 0u) { if (xb_ld(&(bar)[XB_TMO])) break; if (_sp > XB_SPIN_CAP) { atomicAdd(&(bar)[XB_TMO], 1u); break; } } } } while (0)

struct XcdBarrier {
    unsigned* bar; unsigned x;
    volatile LAS unsigned* st;
};

__device__ __forceinline__ XcdBarrier xcd_barrier_post(unsigned* bar, volatile LAS unsigned* st) {
    XcdBarrier b; b.bar = bar; b.x = xb_xcc_id(); b.st = st;
    if (threadIdx.x == 0) (void)xb_add(&bar[XB_XCNT(b.x)], 1u);
    return b;
}
__device__ __forceinline__ void xcd_barrier_complete(unsigned* bar, unsigned x, unsigned& nloc, unsigned& nx) {
    const unsigned G = gridDim.x * gridDim.y * gridDim.z;
    unsigned sum, cnt, mine, sp = 0u;
    for (;;) {
        sum = 0u; cnt = 0u; mine = 0u;
#pragma unroll
        for (unsigned j = 0; j < 16; ++j) { const unsigned c = xb_ld(&bar[XB_XCNT(j)]); sum += c; cnt += (c > 0u) ? 1u : 0u; mine = (j == x) ? c : mine; }
        if (sum == G) break;
        __builtin_amdgcn_s_sleep(1);
        if ((++sp & 255u) == 0u) { if (xb_ld(&bar[XB_TMO])) break; if (sp > XB_SPIN_CAP) { atomicAdd(&bar[XB_TMO], 1u); break; } }
    }
    nloc = mine > 0u ? mine : 1u; nx = cnt > 0u ? cnt : 1u;
}

__device__ __forceinline__ void xcd_barrier(const XcdBarrier& b) {
    asm volatile("s_waitcnt vmcnt(0)" ::: "memory");
    __syncthreads();
    if (threadIdx.x == 0) {
        unsigned* bar = b.bar;
        __builtin_amdgcn_s_waitcnt(0);
        unsigned nloc = b.st[0], nx = b.st[1];
        if (nloc == 0u) { xcd_barrier_complete(bar, b.x, nloc, nx); b.st[0] = nloc; b.st[1] = nx; }
        const unsigned old = xb_add(&bar[XB_XSUB(b.x)], 1u);
        const unsigned gen = old / nloc;
        if (old + 1u == (gen + 1u) * nloc) {
            __builtin_amdgcn_fence(__ATOMIC_RELEASE, "agent");
            asm volatile("s_waitcnt vmcnt(0)" ::: "memory");
            const unsigned og = xb_add(&bar[XB_TOP], 1u);
            const unsigned tg = og / nx;
            if (og + 1u == (tg + 1u) * nx) xb_add(&bar[XB_TOPGEN], 1u);
            else XB_SPIN(xb_ld(&bar[XB_TOPGEN]) == tg, bar);
            __builtin_amdgcn_fence(__ATOMIC_ACQUIRE, "agent");
            xb_add(&bar[XB_XGEN(b.x)], 1u);
            asm volatile("s_waitcnt vmcnt(0)" ::: "memory");
        } else {
            XB_SPIN(xb_ld(&bar[XB_XGEN(b.x)]) == gen, bar);
            __builtin_amdgcn_fence(__ATOMIC_ACQUIRE, "agent");
            asm volatile("s_waitcnt vmcnt(0)" ::: "memory");
        }
    }
    __syncthreads();
}

constexpr int LDS_XB_OFF = 147456 - 64;
#ifndef PHMASK
#define PHMASK 0xFFFF
#endif
#define PH(b) if constexpr ((PHMASK >> (b)) & 1)
#define GRID_SYNC() do { XcdBarrier _b; { kargs_t _p = (kargs_t)__builtin_amdgcn_kernarg_segment_ptr(); asm volatile("" : "+s"(_p)); _b.bar = (unsigned*)_p->ws; } _b.x = xb_xcc_id(); _b.st = (volatile LAS unsigned*)(lds + LDS_XB_OFF); xcd_barrier(_b); } while (0)
#define GRID_SYNC_CG() do { asm volatile("s_waitcnt vmcnt(0) lgkmcnt(0)" ::: "memory"); grid.sync(); if ((threadIdx.x >> 6) == 0) { __builtin_amdgcn_fence(__ATOMIC_ACQUIRE, "agent"); asm volatile("s_waitcnt vmcnt(0)" ::: "memory"); } __syncthreads(); } while (0)
typedef const __attribute__((address_space(4))) Args* kargs_t;
__device__ __forceinline__ Args get_args() {
    kargs_t p = (kargs_t)__builtin_amdgcn_kernarg_segment_ptr();
    asm volatile("" : "+s"(p));
    Args a;
#pragma unroll
    for (int i = 0; i < 25; ++i) a.in[i] = p->in[i];
    a.out = p->out; a.ws = p->ws; a.layer_lo = p->layer_lo; a.layer_hi = p->layer_hi;
    return a;
}
__device__ __forceinline__ EpiResid make_resid(const Args& a, int layer, int which  , int rb) {
    u64* rowss = (u64*)(a.ws + WS_ROWSS); float* metah = (float*)(a.ws + WS_METAH);
    EpiResid e;
    const bool first = (layer == 0 && which == 0);
    e.srcA = first ? a.in[0] : a.out; e.srcB = first ? a.in[1] : a.out + (size_t)ROWS_P * DM; e.srcM = first ? a.in[2] : metah; e.meta_mask = first ? 15 : 0xffff;
    e.dstMain = a.out; e.dstM = metah;
    const int nxt = 2 * layer + 1 + which;
    e.P = nxt < 8 ? (bf16_t*)(a.ws + WS_P) : nullptr; e.rowss_next = nxt < 8 ? rowss + (size_t)nxt * MPAD : nullptr; e.row_base = rb;
    return e;
}
__global__ void __launch_bounds__(512, 2) fwd_megakernel(Args a_unused) {
    extern __shared__ __attribute__((aligned(16))) unsigned char lds_raw[];
    LAS unsigned char* lds = (LAS unsigned char*)lds_raw;
    cg::grid_group grid = cg::this_grid();
    const int G0 = gridDim.x, bid0 = blockIdx.x;
    volatile LAS unsigned* xst = (volatile LAS unsigned*)(lds + LDS_XB_OFF);
    if (threadIdx.x < 2) xst[threadIdx.x] = 0u;
    __syncthreads();
    (void)xcd_barrier_post((unsigned*)a_unused.ws, xst);

    const int layer_lo = a_unused.layer_lo, layer_hi = a_unused.layer_hi;
    if (layer_lo == 0) {
        const Args a = get_args(); const int tid = ltid(), G = lsg(G0), bid = lsg(bid0);
        const int lane = tid & 63, wave = __builtin_amdgcn_readfirstlane(tid >> 6);
        const int gw = bid * 7 + wave, NGW = G * 7;
        u64* rowss = (u64*)(a.ws + WS_ROWSS);
        bf16_t* Wb = (bf16_t*)(a.ws + WS_W);
        bf16_t* P = (bf16_t*)(a.ws + WS_P);
        for (size_t i = (size_t)bid * 512 + tid; i < (size_t)7 * MPAD; i += (size_t)G * 512) rowss[MPAD + i] = 0ull;
        if (wave == 7) {
            PH(1) for (int task = bid; task < 2 * 193; task += G) h2_features(lds + 7 * 16384, a, task / 193, (task % 193) * 64 + lane, lane);
        } else
        PH(0) {
        LAS float* scr = (LAS float*)(lds + wave * 16384);
#pragma unroll 1
        for (int j = 0; j < 2; ++j) {
            convert_matrix(a.in[6] + (size_t)j * 1024 * 3072, a.in[4] + (2 * j) * 1024, 1024, 3072, (bf16_t*)((char*)Wb + W_IN + (size_t)j * 6 * MiB), scr, gw, NGW, lane);
            convert_matrix(a.in[17] + (size_t)j * 1024 * 1024, nullptr, 1024, 1024, (bf16_t*)((char*)Wb + W_HOUT + (size_t)j * 2 * MiB), scr, gw, NGW, lane);
            convert_matrix(a.in[18] + (size_t)j * 1024 * 1536, a.in[4] + (2 * j + 1) * 1024, 1024, 1536, (bf16_t*)((char*)Wb + W_QKV + (size_t)j * 3 * MiB), scr, gw, NGW, lane);
            convert_matrix(a.in[22] + (size_t)j * 1024 * 1024, nullptr, 1024, 1024, (bf16_t*)((char*)Wb + W_AOUT + (size_t)j * 2 * MiB), scr, gw, NGW, lane);
        }
#pragma unroll 1
        for (int i = 0; i < 4; ++i) {
            convert_matrix(a.in[23] + (size_t)i * 1024 * 4096, a.in[5] + i * 1024, 1024, 4096, (bf16_t*)((char*)Wb + W_UP + (size_t)i * 8 * MiB), scr, gw, NGW, lane);
            convert_matrix(a.in[24] + (size_t)i * 4096 * 1024, nullptr, 4096, 1024, (bf16_t*)((char*)Wb + W_DN + (size_t)i * 8 * MiB), scr, gw, NGW, lane);
        }
        for (int row0 = gw; row0 < MREAL; row0 += 4 * NGW) {
            f32x4 v[4][4];
#pragma unroll
            for (int rr = 0; rr < 4; ++rr) {
                const int row = row0 + rr * NGW, rowc = row < MREAL ? row : MREAL - 1;
                const float* src = rowc < ROWS_P ? a.in[0] + (size_t)rowc * DM : (rowc < ROWS_MAIN ? a.in[1] + (size_t)(rowc - ROWS_P) * DM : a.in[2] + (size_t)((rowc - ROWS_MAIN) & 15) * DM);
#pragma unroll
                for (int k = 0; k < 4; ++k) v[rr][k] = *(const f32x4*)(src + k * 256 + lane * 4);
            }
#pragma unroll
            for (int rr = 0; rr < 4; ++rr) {
                const int row = row0 + rr * NGW;
                float ss = 0.f;
#pragma unroll
                for (int k = 0; k < 4; ++k) { const f32x4 x = v[rr][k];
                    ss += (x[0] * x[0] + x[1] * x[1]) + (x[2] * x[2] + x[3] * x[3]);
                    u32x2 pk; pk.x = cvtpk(x[0], x[1]); pk.y = cvtpk(x[2], x[3]);
                    if (row < MREAL) *(u32x2*)(P + (size_t)row * DM + k * 256 + lane * 4) = pk; }
                ss = wave_sum(ss);
                if (lane == 0 && row < MREAL) rowss[row] = (u64)(ss * SS_SCALE);
            }
        }
        }
        GRID_SYNC_CG();
    }

#pragma unroll 1
    for (int layer = layer_lo; layer < layer_hi; ++layer) {
        if ((layer & 1) == 0) {
            {
                const Args a = get_args(); const int tid = ltid(), G = lsg(G0), bid = lsg(bid0); const int j = layer >> 1;
                PH(2) fk_compute(a, j, bid * 8 + __builtin_amdgcn_readfirstlane(tid >> 6), G * 8, tid & 63);
                PH(3) {
                pg8::Gemm g{(const bf16_t*)(a.ws + WS_P), (const bf16_t*)(a.ws + WS_W + W_IN + (size_t)j * 6 * MiB), MPAD, 3072, 1024, 1024, 1024}; pg8::StaticOrder S; S.init(MPAD, 3072, G, bid);
                EpiHyIn E{(bf16_t*)(a.ws + WS_R1), (const u64*)(a.ws + WS_ROWSS) + (size_t)(2 * layer) * MPAD};
                pg8::gemm_phase<EpiHyIn>(lds, g, S, E);
                }
            }
            GRID_SYNC();
            { const Args a = get_args(); const int tid = ltid(), G = lsg(G0), bid = lsg(bid0); PH(4) conv_phase(lds, a, layer >> 1, bid, G, tid); }
            GRID_SYNC();
            { const Args a = get_args(); const int tid = ltid(), G = lsg(G0), bid = lsg(bid0); PH(5) transpose_phase(lds, a, bid, G, tid); }
            GRID_SYNC();
            {
                const Args a = get_args(); const int tid = ltid(), G = lsg(G0), bid = lsg(bid0); const int j = layer >> 1;
                PH(6) {
                pg8::Gemm g{(const bf16_t*)(a.ws + WS_R1), (const bf16_t*)(a.ws + WS_W + W_HOUT + (size_t)j * 2 * MiB), MPAD, 1024, 1024, 1024, 1024}; pg8::StaticOrder S; S.init(MPAD, 1024, G, bid);
                const EpiResid er = make_resid(a, layer, 0, 0);
                pg8::gemm_phase<EpiResid>(lds, g, S, er);
                }
            }
            GRID_SYNC();
        } else {
            {
                const Args a = get_args(); const int tid = ltid(), G = lsg(G0), bid = lsg(bid0); const int j = layer >> 1;
                PH(7) {
                pg8::Gemm g{(const bf16_t*)(a.ws + WS_P), (const bf16_t*)(a.ws + WS_W + W_QKV + (size_t)j * 3 * MiB), MPAD, 1536, 1024, 1024, 1024}; pg8::StaticOrder S; S.init(MPAD, 1536, G, bid);
                EpiRow<0> E{(bf16_t*)(a.ws + WS_R1), (bf16_t*)(a.ws + WS_VT), (const u64*)(a.ws + WS_ROWSS) + (size_t)(2 * layer) * MPAD, 0};
                pg8::gemm_phase<EpiRow<0>>(lds, g, S, E);
                }
            }
            GRID_SYNC();
            { const Args a = get_args(); const int tid = ltid(), G = lsg(G0), bid = lsg(bid0); PH(8) attn_phase(lds, a, layer >> 1, bid, G, tid); }
            GRID_SYNC();
            {
                const Args a = get_args(); const int tid = ltid(), G = lsg(G0), bid = lsg(bid0); const int j = layer >> 1;
                PH(9) {
                pg8::Gemm g{(const bf16_t*)(a.ws + WS_R3), (const bf16_t*)(a.ws + WS_W + W_AOUT + (size_t)j * 2 * MiB), MPAD, 1024, 1024, 1024, 1024}; pg8::StaticOrder S; S.init(MPAD, 1024, G, bid);
                const EpiResid er = make_resid(a, layer, 0, 0);
                pg8::gemm_phase<EpiResid>(lds, g, S, er);
                }
            }
            GRID_SYNC();
        }
#pragma unroll 1
        for (int half = 0; half < 2; ++half) {
            const int rb = half * MT_H0 * 256; const int mrows = (half == 0 ? MT_H0 : MT_H1) * 256;
            {
                const Args a = get_args(); const int tid = ltid(), G = lsg(G0), bid = lsg(bid0);
                PH(10) {
                pg8::Gemm g{(const bf16_t*)(a.ws + WS_P) + (size_t)rb * DM, (const bf16_t*)(a.ws + WS_W + W_UP + (size_t)layer * 8 * MiB), mrows, 4096, 1024, 1024, 1024}; pg8::StaticOrder S; S.init(mrows, 4096, G, bid);
                EpiRow<1> E{(bf16_t*)(a.ws + WS_R1), nullptr, (const u64*)(a.ws + WS_ROWSS) + (size_t)(2 * layer + 1) * MPAD, rb};
                pg8::gemm_phase<EpiRow<1>>(lds, g, S, E);
                }
            }
            GRID_SYNC();
            {
                const Args a = get_args(); const int tid = ltid(), G = lsg(G0), bid = lsg(bid0);
                PH(11) {
                const int drows = MT_H0 * 256;
                pg8::Gemm g{(const bf16_t*)(a.ws + WS_R1), (const bf16_t*)(a.ws + WS_W + W_DN + (size_t)layer * 8 * MiB), drows, 1024, 4096, 4096, 4096}; pg8::StaticOrder S; S.init(drows, 1024, G, bid);
                const EpiResid e2 = make_resid(a, layer, 1, rb);
                pg8::gemm_phase<EpiResid>(lds, g, S, e2);
                }
            }
            if (half == 1) {
                {
                    const Args a = get_args(); const int G = lsg(G0), bid = lsg(bid0);
                    PH(11) {
                    pg8::Gemm g2{(const bf16_t*)(a.ws + WS_R1) + (size_t)(MT_H0 * 256) * DFF, (const bf16_t*)(a.ws + WS_W + W_DN + (size_t)layer * 8 * MiB), 512, 1024, 4096 / DOWN_KS, 4096, 4096};
                    pg8::StaticOrder S2; S2.init_ks(512, 1024, DOWN_KS, G, bid);
                    EpiPartial ep{(float*)(a.ws + WS_R3)};
                    pg8::gemm_phase<EpiPartial>(lds, g2, S2, ep);
                    }
                }
                GRID_SYNC();
                const Args a = get_args(); const int tid = ltid(), G = lsg(G0), bid = lsg(bid0);
                const int nxt = 2 * layer + 2;
                meta_reduce((const float*)(a.ws + WS_R3), (float*)(a.ws + WS_METAH), nxt < 8 ? (bf16_t*)(a.ws + WS_P) : nullptr,
                            nxt < 8 ? (u64*)(a.ws + WS_ROWSS) + (size_t)nxt * MPAD : nullptr, bid * 8 + (tid >> 6), G * 8, tid & 63);
            }
            if (!(layer == layer_hi - 1 && half == 1)) GRID_SYNC();
        }
    }
}

constexpr int LDS_BYTES = 147456;
extern "C" void kernel_launch(void* const* d_in, const int* in_sizes, int n_in, void* d_out, int out_size, void* d_ws, size_t ws_size, hipStream_t stream) {
    static int grid = 0;
    if (grid == 0) {
        if (n_in != 25 || ws_size < WS_END) { fprintf(stderr, "kernel_launch: unexpected n_in %d or ws_size %zu (need %zu)\n", n_in, ws_size, (size_t)WS_END); grid = -1; return; }
        int dev = 0, cus = 0, per_cu = 0;
        (void)hipGetDevice(&dev);
        (void)hipDeviceGetAttribute(&cus, hipDeviceAttributeMultiprocessorCount, dev);
        if (hipFuncSetAttribute((const void*)fwd_megakernel, hipFuncAttributeMaxDynamicSharedMemorySize, LDS_BYTES) != hipSuccess) { fprintf(stderr, "kernel_launch: hipFuncSetAttribute failed\n"); grid = -1; return; }
        if (hipOccupancyMaxActiveBlocksPerMultiprocessor(&per_cu, (const void*)fwd_megakernel, 512, LDS_BYTES) != hipSuccess || per_cu < 1) { fprintf(stderr, "kernel_launch: occupancy query gives %d\n", per_cu); per_cu = 1; }
        (void)hipGetLastError();
        grid = cus * 1;
        fprintf(stderr, "kernel_launch: cus %d per_cu %d grid %d\n", cus, per_cu, grid);
    }
    if (grid < 0) return;
    Args a{};
    for (int i = 0; i < 25; ++i) a.in[i] = (const float*)d_in[i];
    a.out = (float*)d_out; a.ws = (unsigned char*)d_ws;
#ifndef NSPLIT
#define NSPLIT 1
#endif
    (void)hipMemsetAsync(d_ws, 0, 16384, stream);
    for (int part = 0; part < NSPLIT; ++part) {
        a.layer_lo = part * (4 / NSPLIT); a.layer_hi = (part + 1) * (4 / NSPLIT);
        void* args[] = {&a};
        hipError_t e = hipLaunchCooperativeKernel((const void*)fwd_megakernel, dim3(grid), dim3(512), args, LDS_BYTES, stream);
        if (e != hipSuccess) fprintf(stderr, "cooperative launch failed: %s (grid %d)\n", hipGetErrorString(e), grid);
    }
}
```

```cpp
#include <hip/hip_runtime.h>
#include <hip/hip_cooperative_groups.h>
#include <cstdio>
#include <cstdint>
namespace cg = cooperative_groups;

#define LAS __attribute__((address_space(3)))
typedef unsigned short bf16_t;
typedef short bf16x8 __attribute__((ext_vector_type(8)));
typedef float f32x4 __attribute__((ext_vector_type(4)));
typedef float f32x2 __attribute__((ext_vector_type(2)));
typedef unsigned u32x4 __attribute__((ext_vector_type(4)));
typedef unsigned u32x2 __attribute__((ext_vector_type(2)));
typedef __bf16 bf16x2_t __attribute__((ext_vector_type(2)));
typedef unsigned long long u64;
typedef unsigned long long u64x2 __attribute__((ext_vector_type(2)));
constexpr float SS_SCALE = 1048576.0f, SS_INV = 1.0f / (1048576.0f * 1024.0f);
__device__ __forceinline__ float ss_rinv(u64 v) { return __builtin_amdgcn_rsqf((float)v * SS_INV + 1e-6f); }

constexpr int DM = 1024, DFF = 4096;
constexpr int L_P = 8208, L_S = 4112;
constexpr int LS_P = 8256, LS_S = 4160, XPAD = 48;
constexpr int ROWS_P = 32768, ROWS_MAIN = 98304, MREAL = 98624, MPAD = 98816;
constexpr int MT_ALL = MPAD / 256;
constexpr int MT_H0 = 192, MT_H1 = MT_ALL - MT_H0;
constexpr float EPS = 1e-6f;

constexpr size_t MiB = 1u << 20;
constexpr size_t WS_ROWSS = 1 * MiB;
constexpr size_t WS_METAH = 8 * MiB;
constexpr size_t WS_H2T = 10 * MiB;
constexpr size_t WS_W = 17 * MiB;
constexpr size_t WS_FK = 107 * MiB;
constexpr size_t WS_P = 211 * MiB;
constexpr size_t WS_R1 = 404 * MiB, WS_R2 = 599 * MiB, WS_R3 = 794 * MiB, WS_END = 989 * MiB;
constexpr size_t WS_VT = 703 * MiB;
constexpr size_t W_IN = 0, W_HOUT = 12 * MiB, W_QKV = 16 * MiB, W_AOUT = 22 * MiB, W_UP = 26 * MiB, W_DN = 58 * MiB;
constexpr int H2N = 12320;
constexpr int FK_OFFS_P = 8704, FK_LEN_P = 17408, FK_OFFS_S = 4608, FK_LEN_S = 9216;
constexpr size_t FK_SAMPLE_OFF = (size_t)2 * 1024 * FK_LEN_P;

struct Args { const float* in[25]; float* out; unsigned char* ws; int layer_lo, layer_hi; };

__device__ __forceinline__ unsigned cvtpk(float lo, float hi) { f32x2 v = {lo, hi}; bf16x2_t b = __builtin_convertvector(v, bf16x2_t); return __builtin_bit_cast(unsigned, b); }
__device__ __forceinline__ float bf2f(unsigned short x) { return __builtin_bit_cast(float, (unsigned)x << 16); }
__device__ __forceinline__ float bflo(unsigned x) { return __builtin_bit_cast(float, x << 16); }
__device__ __forceinline__ float bfhi(unsigned x) { return __builtin_bit_cast(float, x & 0xffff0000u); }
__device__ __forceinline__ int ltid() { int t = threadIdx.x; asm volatile("" : "+v"(t)); return t; }
__device__ __forceinline__ int lsg(int x) { asm volatile("" : "+s"(x)); return x; }
__device__ __forceinline__ int seq_L(int s) { return s < 4 ? L_P : L_S; }
__device__ __forceinline__ int seq_LS(int s) { return s < 4 ? LS_P : LS_S; }
__device__ __forceinline__ size_t seq_off_ch(int s) { return s < 4 ? (size_t)s * 1024 * LS_P : (size_t)4 * 1024 * LS_P + (size_t)(s - 4) * 1024 * LS_S; }
__device__ __forceinline__ int seq_row(int s, int p) { return p < 16 ? ROWS_MAIN + 16 * s + p : (s < 4 ? s * 8192 : 32768 + (s - 4) * 4096) + p - 16; }
__device__ __forceinline__ void row_decode(int row0, int& s, int& p0, int& L) {
    if (row0 < ROWS_P) { s = row0 >> 13; p0 = 16 + (row0 & 8191); L = L_P; }
    else if (row0 < ROWS_MAIN) { const int r = row0 - ROWS_P; s = 4 + (r >> 12); p0 = 16 + (r & 4095); L = L_S; }
    else { const int r = row0 - ROWS_MAIN; s = r >> 4; p0 = r & 15; L = s < 4 ? L_P : L_S; }
}
__device__ __forceinline__ float wave_sum(float v) {
#pragma unroll
    for (int o = 1; o < 64; o <<= 1) v += __shfl_xor(v, o);
    return v;
}
__device__ __forceinline__ void my_sincos(float x, float& s, float& c) {
    const float k = rintf(x * 0.636619772367581f);
    float r = fmaf(-k, 1.57079625129699707031f, x);
    r = fmaf(-k, 7.54978941586159635335e-08f, r);
    r = fmaf(-k, 5.39030285815811905290e-15f, r);
    const float r2 = r * r;
    const float sp = r + r * r2 * (-1.6666654611e-1f + r2 * (8.3321608736e-3f + r2 * -1.9515295891e-4f));
    const float cp = 1.0f - 0.5f * r2 + r2 * r2 * (4.166664568298827e-2f + r2 * (-1.388731625493765e-3f + r2 * 2.443315711809948e-5f));
    const int n = ((int)k) & 3;
    s = (n == 0) ? sp : (n == 1) ? cp : (n == 2) ? -sp : -cp;
    c = (n == 0) ? cp : (n == 1) ? -sp : (n == 2) ? -cp : sp;
}
__device__ __forceinline__ float my_sin(float x) { float s, c; my_sincos(x, s, c); return s; }
__device__ __forceinline__ int t5_bucket(int rel) {
    const int n = rel < 0 ? -rel : rel; int b;
    if (n < 8) b = n; else if (n < 12) b = 8; else if (n < 16) b = 9; else if (n < 23) b = 10; else if (n < 32) b = 11;
    else if (n < 46) b = 12; else if (n < 64) b = 13; else if (n < 91) b = 14; else b = 15;
    return (rel > 0 ? 16 : 0) + b;
}

namespace pg8 {
#define PG8_LAS __attribute__((address_space(3)))
constexpr int BM = 256, BK = 64, HALF = 128, HTB = HALF * BK * 2, STAGE_BYTES = 8 * HTB, NXCD = 8, WGM = 8;
__host__ __device__ __forceinline__ int lds_byte(int r, int c) { const int st = (r >> 4) * 2 + (c >> 5), rr = r & 15, cc = c & 31, ob = rr * 64 + cc * 2; return st * 1024 + (ob ^ (((ob >> 9) & 1) << 5)); }
__host__ __device__ __forceinline__ void stage_rc(int b, int& R, int& C) { const int st = b / 1024, sb = b % 1024, swz = sb ^ (((sb >> 9) & 1) << 5); R = (st >> 1) * 16 + swz / 64; C = (st & 1) * 32 + (swz % 64) / 2; }
__host__ __device__ __forceinline__ int perm32(int rho) { const int n = rho >> 4, i = rho & 15; return 8 * (i >> 2) + 4 * n + (i & 3); }
struct Unit { int pm, pn, ks; };
struct Gemm { const bf16_t* A; const bf16_t* Bt; int M, N, K; int lda, ldb; };
struct StaticOrder {
    int nM, nN, nwg, G, c, KS;
    __host__ __device__ void init(int M, int N, int G_, int c_) { nM = M / BM; nN = N / BM; nwg = nM * nN; G = G_; c = c_; KS = 1; }
    __host__ __device__ void init_ks(int M, int N, int KS_, int G_, int c_) { nM = M / BM; nN = N / BM; KS = KS_; nwg = nM * nN * KS; G = G_; c = c_; }
    __host__ __device__ bool next(int i, Unit& u) const {
        const long L = (long)i * G + c; if (L >= nwg) return false;
        u.ks = 0;
        if (KS > 1) { const int l = (int)L; u.ks = l % KS; const int t = l / KS; u.pm = t % nM; u.pn = t / nM; return true; }
        int wgid = (int)L; { const int q = nwg / NXCD, r = nwg % NXCD, xcd = wgid % NXCD, off = wgid / NXCD; wgid = (xcd < r ? xcd * (q + 1) : r * (q + 1) + (xcd - r) * q) + off; }
        const int nig = WGM * nN, gid = wgid / nig, fm = gid * WGM, gsz = (nM - fm) < WGM ? (nM - fm) : WGM;
        u.pm = fm + ((wgid % nig) % gsz); u.pn = (wgid % nig) / gsz; return true;
    }
};

template <class Epi, bool ALIGN_EPI = true>
__device__ __forceinline__ void gemm_phase(PG8_LAS unsigned char* lds, const Gemm g, const StaticOrder& S, const Epi& E) {
    const int tid = ltid(), wid = __builtin_amdgcn_readfirstlane(tid >> 6), lane = tid & 63, wr = wid >> 2, wc = wid & 3, fr = lane & 15, fq = lane >> 4;
    const int K = g.K, nt = K / BK;
    unsigned voffA[2], voffB[2];
#pragma unroll
    for (int i = 0; i < 2; ++i) { int R, C; stage_rc(tid * 16 + i * 8192, R, C); const int Rb = Epi::PERM ? ((R & ~31) + perm32(R & 31)) : R;
        voffA[i] = (unsigned)(R * g.lda + C) * 2u; voffB[i] = (unsigned)(Rb * g.ldb + C) * 2u; }
    const size_t kstep = (size_t)(BK * 2);
    const size_t hstepA = (size_t)HALF * g.lda * 2, hstepB = (size_t)HALF * g.ldb * 2;
    const size_t tstepA = 2 * hstepA, tstepB = 2 * hstepB, ksA = (size_t)K * 2;
    const unsigned ldsw = (unsigned)wid * 1024u;
    const int aoff = lds_byte(wr * 64 + fr, fq * 8), boff = lds_byte(wc * 32 + fr, fq * 8);
#define PG8_SA(b, h) (((b) * 2 + (h)) * HTB)
#define PG8_SB(b, h) ((4 + (b) * 2 + (h)) * HTB)
#define PG8_STAGE(bufoff, gbase, voff) do { _Pragma("unroll") for (int _i = 0; _i < 2; ++_i) \
        __builtin_amdgcn_global_load_lds((const unsigned*)((const char*)(gbase) + (voff)[_i]), (PG8_LAS unsigned*)(lds + (bufoff) + ldsw + _i * 8192), 16, 0, 0); } while (0)
#define PG8_LDA(dst, b, h) do { _Pragma("unroll") for (int m = 0; m < 4; ++m) _Pragma("unroll") for (int k = 0; k < 2; ++k) dst[m][k] = *(const PG8_LAS bf16x8*)(lds + PG8_SA(b, h) + aoff + m * 2048 + k * 1024); } while (0)
#define PG8_LDB(dst, b, h) do { _Pragma("unroll") for (int n = 0; n < 2; ++n) _Pragma("unroll") for (int k = 0; k < 2; ++k) dst[n][k] = *(const PG8_LAS bf16x8*)(lds + PG8_SB(b, h) + boff + n * 2048 + k * 1024); } while (0)
#define PG8_MMA(ai, bj, At, Bt) do { __builtin_amdgcn_s_setprio(1); _Pragma("unroll") for (int m = 0; m < 4; ++m) _Pragma("unroll") for (int n = 0; n < 2; ++n) _Pragma("unroll") for (int k = 0; k < 2; ++k) \
        acc[ai][bj][m][n] = Epi::SWAP ? __builtin_amdgcn_mfma_f32_16x16x32_bf16(Bt[n][k], At[m][k], acc[ai][bj][m][n], 0, 0, 0) \
                                      : __builtin_amdgcn_mfma_f32_16x16x32_bf16(At[m][k], Bt[n][k], acc[ai][bj][m][n], 0, 0, 0); __builtin_amdgcn_s_setprio(0); } while (0)
#define PG8_WAIT_V(n) asm volatile("s_waitcnt vmcnt(" #n ")" ::: "memory")
#define PG8_WAIT_L(n) asm volatile("s_waitcnt lgkmcnt(" #n ")" ::: "memory")
#define PG8_BAR __builtin_amdgcn_s_barrier()
#define PG8_SCHED __builtin_amdgcn_sched_barrier(0)
    Unit cur, nxt; int ui = 0;
    if (!S.next(0, cur)) return;
    f32x4 acc[2][2][4][2];
#pragma unroll
    for (int a = 0; a < 2; ++a)
#pragma unroll
        for (int b = 0; b < 2; ++b)
#pragma unroll
            for (int m = 0; m < 4; ++m)
#pragma unroll
                for (int n = 0; n < 2; ++n) acc[a][b][m][n] = (f32x4){0.f, 0.f, 0.f, 0.f};
    bf16x8 At[4][2], B0[2][2], B1[2][2];
    const char* cA = (const char*)g.A + (size_t)cur.pm * tstepA + (size_t)cur.ks * ksA; const char* cB = (const char*)g.Bt + (size_t)cur.pn * tstepB + (size_t)cur.ks * ksA;
    PG8_STAGE(PG8_SB(0, 0), cB, voffB); PG8_STAGE(PG8_SB(0, 1), cB + hstepB, voffB); PG8_STAGE(PG8_SA(0, 0), cA, voffA); PG8_STAGE(PG8_SA(0, 1), cA + hstepA, voffA);
    if (wr == 1) PG8_BAR;
    PG8_WAIT_V(2); PG8_BAR;
    PG8_STAGE(PG8_SB(1, 0), cB + kstep, voffB); PG8_STAGE(PG8_SA(1, 0), cA + kstep, voffA); PG8_STAGE(PG8_SB(1, 1), cB + hstepB + kstep, voffB);
    PG8_WAIT_V(6); PG8_BAR;
    for (;;) {
        const bool has_next = S.next(ui + 1, nxt);
        const char* nA = has_next ? (const char*)g.A + (size_t)nxt.pm * tstepA + (size_t)nxt.ks * ksA : cA; const char* nB = has_next ? (const char*)g.Bt + (size_t)nxt.pn * tstepB + (size_t)nxt.ks * ksA : cB;
        for (int t = 0; t < nt; t += 2) {
            const bool last = (t == nt - 2);
            const char* a1 = cA + (size_t)(t + 1) * kstep;
            const char* a2 = last ? nA : cA + (size_t)(t + 2) * kstep; const char* b2 = last ? nB : cB + (size_t)(t + 2) * kstep;
            const char* a3 = a2 + kstep; const char* b3 = b2 + kstep;
            PG8_LDB(B0, 0, 0); PG8_LDB(B1, 0, 1); PG8_SCHED; PG8_LDA(At, 0, 0); PG8_STAGE(PG8_SA(1, 1), a1 + hstepA, voffA);
            PG8_WAIT_V(8); PG8_WAIT_L(0); PG8_BAR; PG8_MMA(0, 0, At, B0); PG8_MMA(0, 1, At, B1); PG8_BAR; PG8_SCHED;
            PG8_LDA(At, 0, 1); PG8_STAGE(PG8_SB(0, 0), b2, voffB); PG8_STAGE(PG8_SB(0, 1), b2 + hstepB, voffB); PG8_STAGE(PG8_SA(0, 0), a2, voffA);
            PG8_WAIT_V(8); PG8_WAIT_L(0); PG8_BAR; PG8_MMA(1, 0, At, B0); PG8_MMA(1, 1, At, B1); PG8_BAR; PG8_SCHED;
            PG8_LDB(B0, 1, 0); PG8_LDB(B1, 1, 1); PG8_SCHED; PG8_LDA(At, 1, 0); PG8_STAGE(PG8_SA(0, 1), a2 + hstepA, voffA);
            PG8_WAIT_V(8); PG8_WAIT_L(0); PG8_BAR; PG8_MMA(0, 0, At, B0); PG8_MMA(0, 1, At, B1); PG8_BAR; PG8_SCHED;
            PG8_LDA(At, 1, 1); PG8_STAGE(PG8_SB(1, 0), b3, voffB); PG8_STAGE(PG8_SB(1, 1), b3 + hstepB, voffB); PG8_STAGE(PG8_SA(1, 0), a3, voffA);
            PG8_WAIT_V(8); PG8_WAIT_L(0); PG8_BAR; PG8_MMA(1, 0, At, B0); PG8_MMA(1, 1, At, B1); PG8_BAR; PG8_SCHED;
        }
        if constexpr (ALIGN_EPI) { if (wr == 0) PG8_BAR; }
        E(acc, cur, wr, wc, fr, fq);
        if (!has_next) break;
#pragma unroll
        for (int a = 0; a < 2; ++a)
#pragma unroll
            for (int b = 0; b < 2; ++b)
#pragma unroll
                for (int m = 0; m < 4; ++m)
#pragma unroll
                    for (int n = 0; n < 2; ++n) acc[a][b][m][n] = (f32x4){0.f, 0.f, 0.f, 0.f};
        cur = nxt; cA = nA; cB = nB; ++ui;
        if constexpr (ALIGN_EPI) { if (wr == 1) PG8_BAR; }
    }
    PG8_WAIT_V(0);
    if constexpr (!ALIGN_EPI) { if (wr == 0) PG8_BAR; }
    PG8_BAR;
#undef PG8_SA
#undef PG8_SB
#undef PG8_STAGE
#undef PG8_LDA
#undef PG8_LDB
#undef PG8_MMA
#undef PG8_WAIT_V
#undef PG8_WAIT_L
#undef PG8_BAR
#undef PG8_SCHED
}
}

struct EpiHyIn {
    static constexpr bool PERM = false, SWAP = false;
    bf16_t* XT; const u64* rowss;
    __device__ __forceinline__ void operator()(const f32x4 (&acc)[2][2][4][2], const pg8::Unit& u, int wr, int wc, int fr, int fq) const {
        constexpr size_t REGION = (size_t)(WS_R2 - WS_R1) / 2;
#pragma unroll
        for (int ai = 0; ai < 2; ++ai)
#pragma unroll
            for (int m = 0; m < 4; ++m) {
                const int row0 = u.pm * 256 + ai * 128 + wr * 64 + m * 16;
                if (row0 >= MREAL) continue;
                const u64x2 s01 = *(const u64x2*)(rowss + row0 + 4 * fq), s23 = *(const u64x2*)(rowss + row0 + 4 * fq + 2);
                f32x4 ri; ri[0] = ss_rinv(s01[0]); ri[1] = ss_rinv(s01[1]); ri[2] = ss_rinv(s23[0]); ri[3] = ss_rinv(s23[1]);
                int s, p0, L; row_decode(row0, s, p0, L);
                const size_t so = seq_off_ch(s); const int LS = seq_LS(s);
#pragma unroll
                for (int bj = 0; bj < 2; ++bj)
#pragma unroll
                    for (int n = 0; n < 2; ++n) {
                        const int col = u.pn * 256 + bj * 128 + wc * 32 + n * 16 + fr;
                        const int part = col >> 10, ch = col & 1023;
                        const f32x4 v = acc[ai][bj][m][n] * ri;
                        u32x2 w; w.x = cvtpk(v[0], v[1]); w.y = cvtpk(v[2], v[3]);
                        *(u32x2*)(XT + (size_t)part * REGION + so + (size_t)ch * LS + XPAD + p0 + 4 * fq) = w;
                    }
            }
    }
};
template <int MODE> struct EpiRow {
    static constexpr bool PERM = true, SWAP = true;
    bf16_t* O; bf16_t* VT; const u64* rowss; int row_base;
    __device__ __forceinline__ void operator()(const f32x4 (&acc)[2][2][4][2], const pg8::Unit& u, int wr, int wc, int fr, int fq) const {
#pragma unroll
        for (int ai = 0; ai < 2; ++ai)
#pragma unroll
            for (int m = 0; m < 4; ++m) {
                const int lrow = u.pm * 256 + ai * 128 + wr * 64 + m * 16 + fr, grow = row_base + lrow;
                if (grow >= MREAL) continue;
                const float ri = ss_rinv(rowss[grow]);
#pragma unroll
                for (int bj = 0; bj < 2; ++bj) {
                    const int col0 = u.pn * 256 + bj * 128 + wc * 32 + 8 * fq;
                    f32x4 v0 = acc[ai][bj][m][0] * ri, v1 = acc[ai][bj][m][1] * ri;
                    if (MODE == 1) {
#pragma unroll
                        for (int i = 0; i < 4; ++i) { const float a = fmaxf(v0[i], 0.f), b = fmaxf(v1[i], 0.f); v0[i] = a * a; v1[i] = b * b; }
                        u32x4 w; w.x = cvtpk(v0[0], v0[1]); w.y = cvtpk(v0[2], v0[3]); w.z = cvtpk(v1[0], v1[1]); w.w = cvtpk(v1[2], v1[3]);
                        *(u32x4*)(O + (size_t)lrow * DFF + col0) = w;
                    } else {
                        if (col0 < 1280) {
                            u32x4 w; w.x = cvtpk(v0[0], v0[1]); w.y = cvtpk(v0[2], v0[3]); w.z = cvtpk(v1[0], v1[1]); w.w = cvtpk(v1[2], v1[3]);
                            *(u32x4*)(O + (size_t)grow * 1280 + col0) = w;
                        } else {
                            int s, p, L; row_decode(grow, s, p, L);
                            const int LS = seq_LS(s);
                            bf16_t* dst = VT + seq_off_ch(s) / 4 + (size_t)(col0 - 1280) * LS + XPAD + p;
#pragma unroll
                            for (int i = 0; i < 4; ++i) { dst[(size_t)i * LS] = (bf16_t)(cvtpk(v0[i], 0.f) & 0xffffu); dst[(size_t)(4 + i) * LS] = (bf16_t)(cvtpk(v1[i], 0.f) & 0xffffu); }
                        }
                    }
                }
            }
    }
};
struct EpiResid {
    static constexpr bool PERM = true, SWAP = true;
    const float* srcA; const float* srcB; const float* srcM; int meta_mask;
    float* dstMain; float* dstM; bf16_t* P; u64* rowss_next; int row_base;
    __device__ __forceinline__ void operator()(const f32x4 (&acc)[2][2][4][2], const pg8::Unit& u, int wr, int wc, int fr, int fq) const {
#pragma unroll
        for (int ai = 0; ai < 2; ++ai)
#pragma unroll
            for (int m = 0; m < 4; ++m) {
                const int grow = row_base + u.pm * 256 + ai * 128 + wr * 64 + m * 16 + fr;
                const bool ok = grow < MREAL;
                float ss = 0.f;
                if (ok) {
                    const float* src; float* dst;
                    if (grow < ROWS_P) { src = srcA + (size_t)grow * DM; dst = dstMain + (size_t)grow * DM; }
                    else if (grow < ROWS_MAIN) { src = srcB + (size_t)(grow - ROWS_P) * DM; dst = dstMain + (size_t)grow * DM; }
                    else { const int mr = grow - ROWS_MAIN; src = srcM + (size_t)(mr & meta_mask) * DM; dst = dstM + (size_t)mr * DM; }
#pragma unroll
                    for (int bj = 0; bj < 2; ++bj) {
                        const int col0 = u.pn * 256 + bj * 128 + wc * 32 + 8 * fq;
                        const f32x4 h0 = *(const f32x4*)(src + col0) + acc[ai][bj][m][0];
                        const f32x4 h1 = *(const f32x4*)(src + col0 + 4) + acc[ai][bj][m][1];
                        *(f32x4*)(dst + col0) = h0; *(f32x4*)(dst + col0 + 4) = h1;
                        if (P) { u32x4 w; w.x = cvtpk(h0[0], h0[1]); w.y = cvtpk(h0[2], h0[3]); w.z = cvtpk(h1[0], h1[1]); w.w = cvtpk(h1[2], h1[3]);
                            *(u32x4*)(P + (size_t)grow * DM + col0) = w; }
                        ss += (h0[0] * h0[0] + h0[1] * h0[1]) + (h0[2] * h0[2] + h0[3] * h0[3]) + (h1[0] * h1[0] + h1[1] * h1[1]) + (h1[2] * h1[2] + h1[3] * h1[3]);
                    }
                }
                ss += __shfl_xor(ss, 16); ss += __shfl_xor(ss, 32);
                if (ok && fq == 0 && rowss_next) atomicAdd(rowss_next + grow, (u64)(ss * SS_SCALE));
            }
    }
};

struct EpiPartial {
    static constexpr bool PERM = true, SWAP = true;
    float* PART;
    __device__ __forceinline__ void operator()(const f32x4 (&acc)[2][2][4][2], const pg8::Unit& u, int wr, int wc, int fr, int fq) const {
#pragma unroll
        for (int ai = 0; ai < 2; ++ai)
#pragma unroll
            for (int m = 0; m < 4; ++m) {
                const int lrow = u.pm * 256 + ai * 128 + wr * 64 + m * 16 + fr;
                float* dst = PART + ((size_t)u.ks * 512 + lrow) * DM + u.pn * 256 + wc * 32 + 8 * fq;
#pragma unroll
                for (int bj = 0; bj < 2; ++bj) { *(f32x4*)(dst + bj * 128) = acc[ai][bj][m][0]; *(f32x4*)(dst + bj * 128 + 4) = acc[ai][bj][m][1]; }
            }
    }
};
constexpr int DOWN_KS = 16;
__device__ __forceinline__ void meta_reduce(const float* PART, float* metah, bf16_t* P, u64* rowss_next, int gw, int NGW, int lane) {
    for (int lrow = gw; lrow < MREAL - ROWS_MAIN; lrow += NGW) {
        float ss = 0.f;
#pragma unroll
        for (int k = 0; k < 4; ++k) {
            const int col = k * 256 + lane * 4;
            f32x4 sum = *(const f32x4*)(metah + (size_t)lrow * DM + col);
#pragma unroll
            for (int ks = 0; ks < DOWN_KS; ++ks) sum += *(const f32x4*)(PART + ((size_t)ks * 512 + lrow) * DM + col);
            *(f32x4*)(metah + (size_t)lrow * DM + col) = sum;
            if (P) { u32x2 pk; pk.x = cvtpk(sum[0], sum[1]); pk.y = cvtpk(sum[2], sum[3]); *(u32x2*)(P + (size_t)(ROWS_MAIN + lrow) * DM + col) = pk; }
            ss += (sum[0] * sum[0] + sum[1] * sum[1]) + (sum[2] * sum[2] + sum[3] * sum[3]);
        }
        ss = wave_sum(ss);
        if (lane == 0 && rowss_next) rowss_next[ROWS_MAIN + lrow] = (u64)(ss * SS_SCALE);
    }
}

__device__ __forceinline__ void transpose_item(const float* W, const float* gain, int K, int N, bf16_t* WT, LAS float* scr, int item, int lane) {
    const int nblk = N / 32, kb = item / nblk, nb = item % nblk, k0 = 64 * kb, n0 = 32 * nb;
    {
        const int kr = lane >> 3, n4 = (lane & 7) * 4;
        f32x4 wv[8]; float gv[8];
#pragma unroll
        for (int i = 0; i < 8; ++i) { wv[i] = *(const f32x4*)(W + (size_t)(k0 + 8 * i + kr) * N + n0 + n4); gv[i] = gain ? gain[k0 + 8 * i + kr] : 1.0f; }
#pragma unroll
        for (int i = 0; i < 8; ++i) { LAS float* d = scr + (8 * i + kr) * 33 + n4; const f32x4 v = wv[i] * gv[i]; d[0] = v[0]; d[1] = v[1]; d[2] = v[2]; d[3] = v[3]; }
    }
    asm volatile("s_waitcnt lgkmcnt(0)" ::: "memory");
    const int c = lane & 7;
#pragma unroll
    for (int j = 0; j < 4; ++j) { const int n = (lane >> 3) + 8 * j; const LAS float* s = scr + (8 * c) * 33 + n;
        u32x4 o; o.x = cvtpk(s[0 * 33], s[1 * 33]); o.y = cvtpk(s[2 * 33], s[3 * 33]); o.z = cvtpk(s[4 * 33], s[5 * 33]); o.w = cvtpk(s[6 * 33], s[7 * 33]);
        *(u32x4*)(WT + (size_t)(n0 + n) * K + k0 + 8 * c) = o; }
    asm volatile("s_waitcnt lgkmcnt(0)" ::: "memory");
}
__device__ __forceinline__ void convert_matrix(const float* W, const float* gain, int K, int N, bf16_t* WT, LAS float* scr, int gw, int NGW, int lane) {
    const int nitems = (K / 64) * (N / 32);
    for (int it = gw; it < nitems; it += NGW) transpose_item(W, gain, K, N, WT, scr, it, lane);
}

__device__ __forceinline__ void h2_features(LAS unsigned char* lds, const Args& a, int j, int npr, int tid) {
    LAS float* hs = (LAS float*)lds;
    float* H2T = (float*)(a.ws + WS_H2T);
    const bool hvalid = npr < H2N;
    const int np = hvalid ? npr : H2N - 1;
    const int L = np < L_P ? L_P : L_S, n = np < L_P ? np : np - L_P;
    const float* w1 = a.in[9] + j * 33 * 64; const float* b1 = a.in[10] + j * 64; const float* fr1 = a.in[11] + j * 64;
    const float* w2 = a.in[12] + j * 64 * 64; const float* b2 = a.in[13] + j * 64; const float* fr2 = a.in[14] + j * 64;
    const float t = (float)n * (1.0f / (float)(L - 1));
    const float w = (6.283185307179586f / (float)L) * (float)n;
    float acc[64];
#pragma unroll
    for (int m = 0; m < 64; ++m) acc[m] = b1[m] + t * w1[m];
    for (int e = 0; e < 16; ++e) {
        const float f = 1e-4f + (float)e * ((15.0f - 1e-4f) / 15.0f);
        float s, c; my_sincos(f * w, s, c);
        const float* wc = w1 + (1 + e) * 64; const float* wsn = w1 + (17 + e) * 64;
#pragma unroll
        for (int m = 0; m < 64; ++m) acc[m] = fmaf(c, wc[m], fmaf(-s, wsn[m], acc[m]));
    }
#pragma unroll
    for (int m = 0; m < 64; ++m) hs[m * 64 + tid] = my_sin(fr1[m] * acc[m]);
#pragma unroll
    for (int m = 0; m < 64; ++m) acc[m] = b2[m];
    for (int e = 0; e < 64; ++e) {
        const float h = hs[e * 64 + tid]; const float* wr_ = w2 + e * 64;
#pragma unroll
        for (int m = 0; m < 64; ++m) acc[m] = fmaf(h, wr_[m], acc[m]);
    }
    if (hvalid) {
#pragma unroll
        for (int m = 0; m < 64; ++m) H2T[((size_t)j * H2N + np) * 64 + m] = my_sin(fr2[m] * acc[m]);
    }
}

__device__ __forceinline__ void split8(const f32x4 a, const f32x4 b, bf16x8& hi, bf16x8& lo) {
    u32x4 h, l;
    h.x = cvtpk(a[0], a[1]); h.y = cvtpk(a[2], a[3]); h.z = cvtpk(b[0], b[1]); h.w = cvtpk(b[2], b[3]);
    l.x = cvtpk(a[0] - bflo(h.x), a[1] - bfhi(h.x)); l.y = cvtpk(a[2] - bflo(h.y), a[3] - bfhi(h.y));
    l.z = cvtpk(b[0] - bflo(h.z), b[1] - bfhi(h.z)); l.w = cvtpk(b[2] - bflo(h.w), b[3] - bfhi(h.w));
    hi = __builtin_bit_cast(bf16x8, h); lo = __builtin_bit_cast(bf16x8, l);
}
__device__ __forceinline__ void fk_compute(const Args& a, int j, int gw, int NGW, int lane) {
    const float* H2 = (const float*)(a.ws + WS_H2T) + (size_t)j * H2N * 64;
    const float* w3 = a.in[15] + (size_t)j * 64 * 4096;
    const float* skip = a.in[16] + j * 2 * 1024;
    bf16_t* FK = (bf16_t*)(a.ws + WS_FK);
    const int n16 = lane & 15, g = lane >> 4;
#pragma unroll 1
    for (int it = gw; it < 2048; it += NGW) {
        const int pq = it & 3, cht = (it >> 2) & 63, dir = (it >> 8) & 1, o = (it >> 9) & 1, set = it >> 10;
        const int L = set ? L_S : L_P, offs = set ? FK_OFFS_S : FK_OFFS_P, len = set ? FK_LEN_S : FK_LEN_P, nbase = set ? L_P : 0;
        bf16_t* base = FK + (set ? FK_SAMPLE_OFF : 0);
        const int ch = cht * 16 + n16;
        bf16x8 Bh0, Bl0, Bh1, Bl1;
        {
            const float* wp = w3 + (o * 2 + dir) * 1024 + ch;
            f32x4 w0, w1, w2, w3v;
#pragma unroll
            for (int i = 0; i < 4; ++i) { w0[i] = wp[(size_t)(8 * g + i) * 4096]; w1[i] = wp[(size_t)(8 * g + 4 + i) * 4096];
                w2[i] = wp[(size_t)(32 + 8 * g + i) * 4096]; w3v[i] = wp[(size_t)(36 + 8 * g + i) * 4096]; }
            split8(w0, w1, Bh0, Bl0); split8(w2, w3v, Bh1, Bl1);
        }
        const float mind = -3.0701134573253944f, maxd = -15.350567286626972f;
        const float delta = fabsf(mind + (maxd - mind) * ((float)ch * (1.0f / 1023.0f)));
        const float skipv = skip[o * 1024 + ch];
        const float tinv = 1.0f / (float)(L - 1);
        bf16_t* rowp = base + ((size_t)o * 1024 + ch) * len;
        const int tq = offs / 64;
#pragma unroll 2
        for (int tile = pq * tq; tile < (pq + 1) * tq; ++tile) {
            const int n0 = tile * 16 + dir;
            const int nr = n0 + n16, nrc = nr < L ? nr : L - 1;
            const float* hp = H2 + (size_t)(nbase + nrc) * 64 + 8 * g;
            const f32x4 h0 = *(const f32x4*)hp, h1 = *(const f32x4*)(hp + 4), h2 = *(const f32x4*)(hp + 32), h3 = *(const f32x4*)(hp + 36);
            bf16x8 Ah0, Al0, Ah1, Al1; split8(h0, h1, Ah0, Al0); split8(h2, h3, Ah1, Al1);
            f32x4 acc = (f32x4){0.f, 0.f, 0.f, 0.f};
            acc = __builtin_amdgcn_mfma_f32_16x16x32_bf16(Al0, Bh0, acc, 0, 0, 0);
            acc = __builtin_amdgcn_mfma_f32_16x16x32_bf16(Al1, Bh1, acc, 0, 0, 0);
            acc = __builtin_amdgcn_mfma_f32_16x16x32_bf16(Ah0, Bl0, acc, 0, 0, 0);
            acc = __builtin_amdgcn_mfma_f32_16x16x32_bf16(Ah1, Bl1, acc, 0, 0, 0);
            acc = __builtin_amdgcn_mfma_f32_16x16x32_bf16(Ah0, Bh0, acc, 0, 0, 0);
            acc = __builtin_amdgcn_mfma_f32_16x16x32_bf16(Ah1, Bh1, acc, 0, 0, 0);
            float v[4];
#pragma unroll
            for (int ii = 0; ii < 4; ++ii) {
                const int n = n0 + 4 * g + ii;
                float x = acc[ii] * __expf(-((float)n * tinv) * delta);
                if (dir == 0 && n == 0) x += skipv;
                v[ii] = n < L ? x : 0.f;
            }
            u32x2 pk;
            if (dir == 0) { pk.x = cvtpk(v[0], v[1]); pk.y = cvtpk(v[2], v[3]); *(u32x2*)(rowp + offs + n0 + 4 * g) = pk; }
            else { pk.x = cvtpk(v[3], v[2]); pk.y = cvtpk(v[1], v[0]); *(u32x2*)(rowp + offs - (n0 + 4 * g + 3)) = pk; }
        }
    }
}

__device__ __forceinline__ u32x2 cld8(const void* p) { u32x2 v; asm volatile("global_load_dwordx2 %0, %1, off sc0 sc1\n\ts_waitcnt vmcnt(0)" : "=v"(v) : "v"(p) : "memory"); return v; }
__device__ __forceinline__ u32x4 cld16(const void* p) { u32x4 v; asm volatile("global_load_dwordx4 %0, %1, off sc0 sc1\n\ts_waitcnt vmcnt(0)" : "=v"(v) : "v"(p) : "memory"); return v; }
__device__ __forceinline__ unsigned short cld2(const void* p) { unsigned v; asm volatile("global_load_ushort %0, %1, off sc0 sc1\n\ts_waitcnt vmcnt(0)" : "=v"(v) : "v"(p) : "memory"); return (unsigned short)v; }
__device__ __forceinline__ f32x4 gate4(const bf16_t* xrow, int m, int L, float w0, float w1, float w2, float bb) {
    const u32x2 raw = *(const u32x2*)(xrow + m);
    const float x0 = bflo(raw.x), x1 = bfhi(raw.x), x2 = bflo(raw.y), x3 = bfhi(raw.y);
    const float xm = m > 0 ? bf2f(xrow[m - 1]) : 0.f, xp = (m + 4 < L) ? bf2f(xrow[m + 4]) : 0.f;
    f32x4 r;
    r[0] = w0 * xm + w1 * x0 + w2 * x1 + bb; r[1] = w0 * x0 + w1 * x1 + w2 * x2 + bb;
    r[2] = w0 * x1 + w1 * x2 + w2 * x3 + bb; r[3] = w0 * x2 + w1 * x3 + w2 * xp + bb;
    return r;
}
struct GateRaw { u32x2 raw; unsigned halo; };
__device__ __forceinline__ GateRaw gate_load(const bf16_t* xrow, int m, int L) {
    GateRaw r; r.raw = *(const u32x2*)(xrow + m);
    const unsigned xm = m > 0 ? (unsigned)xrow[m - 1] : 0u, xp = (m + 4 < L) ? (unsigned)xrow[m + 4] : 0u;
    r.halo = xm | (xp << 16); return r;
}
__device__ __forceinline__ f32x4 gate_eval(const GateRaw& gr, float w0, float w1, float w2, float bb) {
    const float x0 = bflo(gr.raw.x), x1 = bfhi(gr.raw.x), x2 = bflo(gr.raw.y), x3 = bfhi(gr.raw.y), xm = bflo(gr.halo), xp = bfhi(gr.halo);
    f32x4 r;
    r[0] = w0 * xm + w1 * x0 + w2 * x1 + bb; r[1] = w0 * x0 + w1 * x1 + w2 * x2 + bb;
    r[2] = w0 * x1 + w1 * x2 + w2 * x3 + bb; r[3] = w0 * x2 + w1 * x3 + w2 * xp + bb;
    return r;
}
template <int NQ, int NB, int L>
__device__ __forceinline__ void conv_unit(LAS unsigned char* lds, const Args& a, int j, int seq0, int c, int tid) {
    constexpr int QS = 64, GS = QS * NQ, WS = 4 * GS, PADL = 224;
    constexpr int LS = (NQ == 4) ? LS_P : LS_S;
    constexpr int LPD = (NQ == 4) ? 8720 : 4616;
    constexpr int OFFS = (NQ == 4) ? FK_OFFS_P : FK_OFFS_S, LEN = (NQ == 4) ? FK_LEN_P : FK_LEN_S;
    constexpr int S_LO = -QS * (NQ - 1), S_HI = ((L - 1) / 32) * 32;
    constexpr int U_OFF = 0, FKL_OFF = 77824, RED_OFF = 112640;
    static_assert(NB * LPD * 2 <= FKL_OFF && FKL_OFF + LEN * 2 <= RED_OFF, "conv LDS map");
    const int lane = tid & 63, w = __builtin_amdgcn_readfirstlane(tid >> 6);
    const bf16_t* X1 = (const bf16_t*)(a.ws + WS_R1); const bf16_t* X2 = (const bf16_t*)(a.ws + WS_R2); bf16_t* V = (bf16_t*)(a.ws + WS_R3);
    const bf16_t* FK = (const bf16_t*)(a.ws + WS_FK) + ((NQ == 4) ? 0 : FK_SAMPLE_OFF);
    const float* cw = a.in[7] + (size_t)j * 3 * 3072; const float* cb = a.in[8] + (size_t)j * 3072;
    constexpr int NF = (LEN / 8 + 511) / 512;
    u32x4 fkr[NF];
    {
        const u32x4* src = (const u32x4*)(FK + (size_t)c * LEN);
#pragma unroll
        for (int it = 0; it < NF; ++it) { const int i = it * 512 + tid; fkr[it] = src[i < LEN / 8 ? i : 0]; }
    }
    {
        const float w0 = cw[2048 + c], w1 = cw[3072 + 2048 + c], w2 = cw[2 * 3072 + 2048 + c], bb = cb[2048 + c];
        constexpr int NCH = LPD / 8, NIT = (NB * NCH + 511) / 512;
        u32x4 raws[NIT]; unsigned halos[NIT];
#pragma unroll
        for (int it = 0; it < NIT; ++it) {
            const int idx = it * 512 + tid; const int b = idx / NCH, ch = idx % NCH, p = ch * 8 - PADL;
            raws[it] = (u32x4){0u, 0u, 0u, 0u}; halos[it] = 0u;
            if (idx < NB * NCH && p >= 0 && p < L) {
                const bf16_t* row = V + seq_off_ch(seq0 + b) + (size_t)c * LS + XPAD + p;
                raws[it] = *(const u32x4*)row;
                const unsigned xm = p > 0 ? (unsigned)row[-1] : 0u, xp = (p + 8 < L) ? (unsigned)row[8] : 0u;
                halos[it] = xm | (xp << 16);
            }
        }
#pragma unroll
        for (int it = 0; it < NIT; ++it) {
            const int idx = it * 512 + tid; const int b = idx / NCH, ch = idx % NCH, p = ch * 8 - PADL;
            u32x4 o = {0u, 0u, 0u, 0u};
            if (p >= 0 && p < L) {
                const u32x4 raw = raws[it];
                float x[10];
                x[0] = bflo(halos[it]); x[9] = bfhi(halos[it]);
                x[1] = bflo(raw.x); x[2] = bfhi(raw.x); x[3] = bflo(raw.y); x[4] = bfhi(raw.y); x[5] = bflo(raw.z); x[6] = bfhi(raw.z); x[7] = bflo(raw.w); x[8] = bfhi(raw.w);
                float y[8];
#pragma unroll
                for (int i = 0; i < 8; ++i) y[i] = w0 * x[i] + w1 * x[i + 1] + w2 * x[i + 2] + bb;
                o.x = cvtpk(y[0], y[1]); o.y = cvtpk(y[2], y[3]); o.z = cvtpk(y[4], y[5]); o.w = cvtpk(y[6], y[7]);
            }
            if (idx < NB * NCH) *(LAS u32x4*)(lds + U_OFF + (b * LPD + ch * 8) * 2) = o;
        }
    }
    const int n = lane & 15, g = lane >> 4;
    const int q = (NQ == 4) ? (n >> 2) : (n >> 3), b = (NQ == 4) ? (n & 3) : (n & 7);
    const int ub = U_OFF + (b * LPD + PADL + QS * q + 8 * g) * 2;
    const int ubm = U_OFF + (b * LPD + PADL + 8 * g) * 2;
    const int pe = (1 + n) & 1;
    const int abr = FKL_OFF + (LEN - 1 - OFFS - n + 8 * g - pe) * 2;
    const unsigned sh = pe * 16;
    const int mw = 16 + WS * w;
    const int d_lo = mw - S_HI, d_hi = mw + 3 * GS - S_LO;
    const size_t xrow_off = seq_off_ch(seq0 + b) + (size_t)c * LS + XPAD;
#define ARAW(d, lagoff) do { const LAS unsigned* _p = (const LAS unsigned*)(lds + abr - (lagoff) * 2); d[0] = _p[0]; d[1] = _p[1]; d[2] = _p[2]; d[3] = _p[3]; d[4] = _p[4]; } while (0)
#define AFIN(dst, d) do { u32x4 _o; _o.x = __builtin_amdgcn_alignbit(d[1], d[0], sh); _o.y = __builtin_amdgcn_alignbit(d[2], d[1], sh); \
        _o.z = __builtin_amdgcn_alignbit(d[3], d[2], sh); _o.w = __builtin_amdgcn_alignbit(d[4], d[3], sh); dst = __builtin_bit_cast(bf16x8, _o); } while (0)
#define GATHER(dst, lagoff) do { unsigned _d[5]; ARAW(_d, lagoff); AFIN(dst, _d); } while (0)
#pragma unroll 1
    for (int o = 0; o < 2; ++o) {
#pragma unroll
        for (int it = 0; it < NF; ++it) { const int i = it * 512 + tid; const u32x4 v = fkr[it]; u32x4 r;
            r.x = __builtin_amdgcn_alignbit(v.w, v.w, 16); r.y = __builtin_amdgcn_alignbit(v.z, v.z, 16);
            r.z = __builtin_amdgcn_alignbit(v.y, v.y, 16); r.w = __builtin_amdgcn_alignbit(v.x, v.x, 16);
            if (i < LEN / 8) *(LAS u32x4*)(lds + FKL_OFF + (LEN / 8 - 1 - i) * 16) = r; }
        __syncthreads();
        if (o == 0) {
            const u32x4* src = (const u32x4*)(FK + ((size_t)1024 + c) * LEN);
#pragma unroll
            for (int it = 0; it < NF; ++it) { const int i = it * 512 + tid; fkr[it] = src[i < LEN / 8 ? i : 0]; }
        }
        f32x4 acc[4][4];
#pragma unroll
        for (int gi = 0; gi < 4; ++gi)
#pragma unroll
            for (int t = 0; t < 4; ++t) acc[gi][t] = (f32x4){0.f, 0.f, 0.f, 0.f};
        bf16x8 A0, A1, A2, A3, Bc[4], Bn[4];
        GATHER(A0, d_lo); GATHER(A1, d_lo + 16); GATHER(A2, d_lo + 32); GATHER(A3, d_lo + 48);
        int baddr = ub + 2 * (mw - d_lo);
#pragma unroll
        for (int gi = 0; gi < 4; ++gi) Bc[gi] = *(const LAS bf16x8*)(lds + baddr + 2 * GS * gi);
#define CONV_STEP(BCUR, BNXT, DL, CHECK) do { \
            unsigned r2[5], r3[5]; ARAW(r2, (DL) + 64); ARAW(r3, (DL) + 80); \
            baddr -= 64; \
            _Pragma("unroll") for (int gi = 0; gi < 4; ++gi) BNXT[gi] = *(const LAS bf16x8*)(lds + baddr + 2 * GS * gi); \
            __builtin_amdgcn_s_setprio(1); \
            _Pragma("unroll") for (int gi = 0; gi < 4; ++gi) { \
                const int s0 = mw + GS * gi - (DL); \
                if (!(CHECK) || ((s0 >= S_LO) && (s0 <= S_HI))) { \
                    acc[gi][0] = __builtin_amdgcn_mfma_f32_16x16x32_bf16(A0, BCUR[gi], acc[gi][0], 0, 0, 0); \
                    acc[gi][1] = __builtin_amdgcn_mfma_f32_16x16x32_bf16(A1, BCUR[gi], acc[gi][1], 0, 0, 0); \
                    acc[gi][2] = __builtin_amdgcn_mfma_f32_16x16x32_bf16(A2, BCUR[gi], acc[gi][2], 0, 0, 0); \
                    acc[gi][3] = __builtin_amdgcn_mfma_f32_16x16x32_bf16(A3, BCUR[gi], acc[gi][3], 0, 0, 0); \
                } \
            } \
            __builtin_amdgcn_s_setprio(0); \
            A0 = A2; A1 = A3; AFIN(A2, r2); AFIN(A3, r3); } while (0)
        const int dl_a = mw + 3 * GS - S_HI, dl_b = mw - S_LO;
        static_assert(((3 * GS / 32) % 2 == 0) && (((S_HI - S_LO - 3 * GS) / 32 + 1) % 2 == 1), "conv step-count parity");
#pragma unroll 1
        for (int dl = d_lo; dl < dl_a; dl += 64) { CONV_STEP(Bc, Bn, dl, true); CONV_STEP(Bn, Bc, dl + 32, true); }
#pragma unroll 1
        for (int dl = dl_a; dl < dl_b; dl += 64) { CONV_STEP(Bc, Bn, dl, false); CONV_STEP(Bn, Bc, dl + 32, false); }
        CONV_STEP(Bc, Bn, dl_b, false);
#pragma unroll 1
        for (int dl = dl_b + 32; dl <= d_hi; dl += 64) { CONV_STEP(Bn, Bc, dl, true); CONV_STEP(Bc, Bn, dl + 32, true); }
#undef CONV_STEP
        const bf16_t* X = (o == 0 ? X1 : X2) + xrow_off;
        const float w0 = cw[o * 1024 + c], w1 = cw[3072 + o * 1024 + c], w2 = cw[2 * 3072 + o * 1024 + c], bb = cb[o * 1024 + c];
        GateRaw gt[4][4];
        {
            const int mb = mw + QS * q + 4 * g; const bf16_t* Xb = X + mb;
#pragma unroll
            for (int gi = 0; gi < 4; ++gi)
#pragma unroll
                for (int t = 0; t < 4; ++t) { constexpr int dummy = 0; (void)dummy; const int off = GS * gi + 16 * t;
                    GateRaw r; r.raw = *(const u32x2*)(Xb + off);
                    const unsigned xm = (unsigned)Xb[off - 1]; unsigned xp = (unsigned)Xb[off + 4];
                    if (mb + off + 4 >= L) xp = 0u;
                    r.halo = xm | (xp << 16); gt[gi][t] = r; }
        }
        const GateRaw gtm = gate_load(X, 4 * g, L);
        f32x4 macc = (f32x4){0.f, 0.f, 0.f, 0.f};
#pragma unroll 1
        for (int t = w; t <= S_HI / 32; t += 8) {
            bf16x8 Am; GATHER(Am, -32 * t);
            const bf16x8 B = *(const LAS bf16x8*)(lds + ubm + t * 64);
            macc = __builtin_amdgcn_mfma_f32_16x16x32_bf16(Am, B, macc, 0, 0, 0);
        }
        *(LAS f32x4*)(lds + RED_OFF + (w * 64 + lane) * 16) = macc;
        __syncthreads();
        if (w == 0 && q == 0) {
            f32x4 s = (f32x4){0.f, 0.f, 0.f, 0.f};
#pragma unroll
            for (int ww = 0; ww < 8; ++ww) s += *(const LAS f32x4*)(lds + RED_OFF + (ww * 64 + lane) * 16);
            const int m = 4 * g;
            const f32x4 z = gate_eval(gtm, w0, w1, w2, bb) * s;
            u32x2 pk; pk.x = cvtpk(z[0], z[1]); pk.y = cvtpk(z[2], z[3]);
            if (o == 0) *(LAS u32x2*)(lds + U_OFF + (b * LPD + PADL + m) * 2) = pk;
            else *(u32x2*)(V + xrow_off + m) = pk;
        }
#pragma unroll
        for (int gi = 0; gi < 4; ++gi)
#pragma unroll
            for (int t = 0; t < 4; ++t) {
                const int m = mw + GS * gi + 16 * t + QS * q + 4 * g;
                const f32x4 z = gate_eval(gt[gi][t], w0, w1, w2, bb) * acc[gi][t];
                u32x2 pk; pk.x = cvtpk(z[0], z[1]); pk.y = cvtpk(z[2], z[3]);
                if (o == 0) *(LAS u32x2*)(lds + U_OFF + (b * LPD + PADL + m) * 2) = pk;
                else *(u32x2*)(V + xrow_off + m) = pk;
            }
        __syncthreads();
    }
#undef GATHER
#undef ARAW
#undef AFIN
}
__device__ __forceinline__ void conv_phase(LAS unsigned char* lds, const Args& a, int j, int bid, int G, int tid) {
#pragma unroll 1
    for (int u0 = bid; u0 < 3072; u0 += G) {
        const int u = u0;
        int tl = tid; asm volatile("" : "+v"(tl));
        if (u < 1024) conv_unit<4, 4, L_P>(lds, a, j, 0, u, tl);
        else { const int v = u - 1024; conv_unit<2, 8, L_S>(lds, a, j, 4 + 8 * (v & 1), v >> 1, tl); }
    }
}

__device__ __forceinline__ void transpose_phase(LAS unsigned char* lds, const Args& a, int bid, int G, int tid) {
    const bf16_t* ZT = (const bf16_t*)(a.ws + WS_R3); bf16_t* OUT = (bf16_t*)(a.ws + WS_R1);
    constexpr int TP = 129, TS = 65, UP = 4 * TP * 4, US = 16 * TS * 4, TILEB = 256 * 72 * 2;
#define TR_DECODE(u, s, p0, np, c0) do { int _cq, _tt; if ((u) < UP) { _cq = (u) & 3; const int _v = (u) >> 2; s = _v / TP; _tt = _v % TP; } \
        else { const int _r = (u) - UP; _cq = _r & 3; const int _v = _r >> 2; s = 4 + _v / TS; _tt = _v % TS; } \
        p0 = _tt == 0 ? 0 : 16 + 64 * (_tt - 1); np = _tt == 0 ? 16 : 64; c0 = _cq * 256; } while (0)
#define TR_LOAD(u) do { int _s, _p0, _np, _c0; TR_DECODE(u, _s, _p0, _np, _c0); const int _LS = seq_LS(_s), _nq = _np / 4; \
        const bf16_t* _src = ZT + seq_off_ch(_s) + (size_t)_c0 * _LS + XPAD + _p0; \
        _Pragma("unroll") for (int _k = 0; _k < 8; ++_k) { const int _task = _k * 512 + tid; const int _ch = _task / _nq, _pc = _task % _nq; \
            rg[_k] = (_task < 256 * _nq) ? *(const u32x2*)(_src + (size_t)_ch * _LS + 4 * _pc) : (u32x2){0u, 0u}; } } while (0)
    u32x2 rg[8];
    int u = bid, par = 0;
    if (u < UP + US) TR_LOAD(u);
#pragma unroll 1
    for (; u < UP + US; u += G, par ^= 1) {
        int s, p0, np, c0; TR_DECODE(u, s, p0, np, c0);
        const int nq = np / 4; LAS unsigned char* tile = lds + par * TILEB;
#pragma unroll
        for (int k = 0; k < 8; ++k) { const int task = k * 512 + tid; const int ch = task / nq, pc = task % nq;
            if (task < 256 * nq) *(LAS u32x2*)(tile + (ch * 72 + 4 * pc) * 2) = rg[k]; }
        __syncthreads();
        if (u + G < UP + US) TR_LOAD(u + G);
        for (int task = tid; task < np * 32; task += 512) { const int pos = task % np, cc = task / np;
            const LAS unsigned short* t = (const LAS unsigned short*)(tile + ((8 * cc) * 72 + pos) * 2);
            u32x4 o; o.x = (unsigned)t[0] | ((unsigned)t[72] << 16); o.y = (unsigned)t[144] | ((unsigned)t[216] << 16);
            o.z = (unsigned)t[288] | ((unsigned)t[360] << 16); o.w = (unsigned)t[432] | ((unsigned)t[504] << 16);
            *(u32x4*)(OUT + (size_t)seq_row(s, p0 + pos) * DM + c0 + 8 * cc) = o; }
    }
    __syncthreads();
#undef TR_DECODE
#undef TR_LOAD
}

__device__ __forceinline__ void attn_qfrag(const u32x4 r0, const u32x4 r1, const float* qg, int g, bf16x8& qf0, bf16x8& qf1) {
    float x[16] = {bflo(r0.x), bfhi(r0.x), bflo(r0.y), bfhi(r0.y), bflo(r0.z), bfhi(r0.z), bflo(r0.w), bfhi(r0.w),
                   bflo(r1.x), bfhi(r1.x), bflo(r1.y), bfhi(r1.y), bflo(r1.z), bfhi(r1.z), bflo(r1.w), bfhi(r1.w)};
    float ss = 0.f;
#pragma unroll
    for (int i = 0; i < 16; ++i) ss += x[i] * x[i];
    ss += __shfl_xor(ss, 16); ss += __shfl_xor(ss, 32);
    const float ri = __builtin_amdgcn_rsqf(ss * (1.0f / 64.0f) + EPS) * (0.125f * 1.4426950408889634f);
    const f32x4 ga = *(const f32x4*)(qg + 8 * g), gb = *(const f32x4*)(qg + 8 * g + 4), gc = *(const f32x4*)(qg + 32 + 8 * g), gd = *(const f32x4*)(qg + 36 + 8 * g);
    u32x4 p0, p1;
    p0.x = cvtpk(x[0] * ri * ga[0], x[1] * ri * ga[1]); p0.y = cvtpk(x[2] * ri * ga[2], x[3] * ri * ga[3]);
    p0.z = cvtpk(x[4] * ri * gb[0], x[5] * ri * gb[1]); p0.w = cvtpk(x[6] * ri * gb[2], x[7] * ri * gb[3]);
    p1.x = cvtpk(x[8] * ri * gc[0], x[9] * ri * gc[1]); p1.y = cvtpk(x[10] * ri * gc[2], x[11] * ri * gc[3]);
    p1.z = cvtpk(x[12] * ri * gd[0], x[13] * ri * gd[1]); p1.w = cvtpk(x[14] * ri * gd[2], x[15] * ri * gd[3]);
    qf0 = __builtin_bit_cast(bf16x8, p0); qf1 = __builtin_bit_cast(bf16x8, p1);
}
__device__ __forceinline__ bf16x8 attn_scores(const f32x4 s0, const f32x4 s1, const LAS float* bt, int cs, bool interior, bool metal, int g, int qpos, int L, float& den) {
    float p[8];
    if (interior) {
#pragma unroll
        for (int e = 0; e < 8; ++e) { const float sv = e < 4 ? s0[e & 3] : s1[e & 3]; p[e] = __builtin_amdgcn_exp2f(sv + bt[cs + e]); den += p[e]; }
    } else {
#pragma unroll
        for (int e = 0; e < 8; ++e) {
            const float sv = e < 4 ? s0[e & 3] : s1[e & 3];
            const int relb = cs + e, pos = relb + qpos;
            const int relm = 8 * g + e - qpos;
            const bool bvalid = ((unsigned)(relb + 128) <= 256u) && ((unsigned)(pos - 16) < (unsigned)(L - 16));
            const int rel = metal ? relm : relb;
            const bool valid = metal || bvalid;
            const int relc = rel < -128 ? -128 : (rel > 128 ? 128 : rel);
            const float val = __builtin_amdgcn_exp2f(sv + bt[relc]);
            p[e] = valid ? val : 0.f;
            den += p[e];
        }
    }
    u32x4 pp; pp.x = cvtpk(p[0], p[1]); pp.y = cvtpk(p[2], p[3]); pp.z = cvtpk(p[4], p[5]); pp.w = cvtpk(p[6], p[7]);
    return __builtin_bit_cast(bf16x8, pp);
}
__device__ __forceinline__ void attn_store(const f32x4 (&oacc)[4], float den, float sk, float shift, bf16_t* O, int seq, int q0, int g, int r, int head) {
    den += __shfl_xor(den, 16); den += __shfl_xor(den, 32);
    den += __builtin_amdgcn_exp2f((sk - shift) * 1.4426950408889634f);
    const float inv = 1.0f / den;
#pragma unroll
    for (int ii = 0; ii < 4; ++ii) {
        const float iv = __shfl(inv, 4 * g + ii);
        bf16_t* op = O + (size_t)seq_row(seq, q0 + 4 * g + ii) * DM + head * 64 + r;
#pragma unroll
        for (int dt = 0; dt < 4; ++dt) op[dt * 16] = (bf16_t)(cvtpk(oacc[dt][ii] * iv, 0.f) & 0xffffu);
    }
}
__device__ __forceinline__ void attn_phase(LAS unsigned char* lds, const Args& a, int j, int bid, int G, int tid) {
    constexpr int KN_OFF = 0, KSTR = 144, VT_OFF = 59904, VSTR = 848, BT_OFF = 114176;
    const bf16_t* QK = (const bf16_t*)(a.ws + WS_R1); const bf16_t* VTg = (const bf16_t*)(a.ws + WS_VT); bf16_t* O = (bf16_t*)(a.ws + WS_R3);
    const float* rel_bias = a.in[3]; const float* qg = a.in[19] + j * 64; const float* kg = a.in[20] + j * 64; const float* sink = a.in[21] + j * 16;
    const int lane = tid & 63, w = __builtin_amdgcn_readfirstlane(tid >> 6), r = lane & 15, g = lane >> 4;
    LAS float* BT = (LAS float*)(lds + BT_OFF);
    if (tid < 64) { float mq = fabsf(qg[tid]), mk = fabsf(kg[tid]);
#pragma unroll
        for (int o = 1; o < 64; o <<= 1) { mq = fmaxf(mq, __shfl_xor(mq, o)); mk = fmaxf(mk, __shfl_xor(mk, o)); }
        if (tid == 0) BT[16 * 257] = 8.0f * mq * mk; }
    __syncthreads();
    {
        const float shift0 = BT[16 * 257];
        for (int i = tid; i < 16 * 257; i += 512) { const int h = i / 257, rel = i % 257 - 128; BT[i] = (rel_bias[t5_bucket(rel) * 16 + h] - shift0) * 1.4426950408889634f; }
    }
    __syncthreads();
    constexpr int NU = (4 * 65 + 16 * 33) * 4;
    for (int u = bid; u < NU; u += G) {
        const int hk = u & 3; int v = u >> 2, seq, qb, L;
        if (v < 260) { seq = v / 65; qb = v % 65; L = L_P; } else { v -= 260; seq = 4 + v / 33; qb = v % 33; L = L_S; }
        const int start = qb * 128 - 128;
        {
            const bf16_t* vb = VTg + seq_off_ch(seq) / 4 + (size_t)(hk * 64) * seq_LS(seq) + XPAD;
            const int LS = seq_LS(seq);
            u32x4 kraw[7], vraw[7];
#pragma unroll
            for (int it = 0; it < 7; ++it) {
                const int idx = it * 512 + tid;
                { const int slot = idx >> 3, dc = idx & 7; const int pos = slot < 16 ? slot : start + slot - 16;
                  const bool valid = (idx < 416 * 8) && (slot < 16 || (slot < 400 && pos >= 16 && pos < L));
                  kraw[it] = (u32x4){0u, 0u, 0u, 0u};
                  if (valid) kraw[it] = *(const u32x4*)(QK + (size_t)seq_row(seq, pos) * 1280 + 1024 + hk * 64 + dc * 8); }
                { const int d = idx / 52, c8 = idx % 52; const int pos0 = c8 < 2 ? 8 * c8 : start + 8 * c8 - 16;
                  const bool valid = (idx < 64 * 52) && (c8 < 2 || (c8 < 50 && pos0 >= 16 && pos0 < L));
                  vraw[it] = (u32x4){0u, 0u, 0u, 0u};
                  if (valid) vraw[it] = *(const u32x4*)(vb + (size_t)d * LS + pos0); }
            }
#pragma unroll
            for (int it = 0; it < 7; ++it) {
                const int idx = it * 512 + tid;
                const int slot = idx >> 3, dc = idx & 7;
                const u32x4 raw = kraw[it];
                float x[8] = {bflo(raw.x), bfhi(raw.x), bflo(raw.y), bfhi(raw.y), bflo(raw.z), bfhi(raw.z), bflo(raw.w), bfhi(raw.w)};
                float ss = 0.f;
#pragma unroll
                for (int i = 0; i < 8; ++i) ss += x[i] * x[i];
                ss += __shfl_xor(ss, 1); ss += __shfl_xor(ss, 2); ss += __shfl_xor(ss, 4);
                const float ri = __builtin_amdgcn_rsqf(ss * (1.0f / 64.0f) + EPS);
                const f32x4 g0 = *(const f32x4*)(kg + dc * 8), g1 = *(const f32x4*)(kg + dc * 8 + 4);
                u32x4 o; o.x = cvtpk(x[0] * ri * g0[0], x[1] * ri * g0[1]); o.y = cvtpk(x[2] * ri * g0[2], x[3] * ri * g0[3]);
                o.z = cvtpk(x[4] * ri * g1[0], x[5] * ri * g1[1]); o.w = cvtpk(x[6] * ri * g1[2], x[7] * ri * g1[3]);
                if (idx < 416 * 8) *(LAS u32x4*)(lds + KN_OFF + slot * KSTR + dc * 16) = o;
                const int d = idx / 52, c8 = idx % 52;
                if (idx < 64 * 52) *(LAS u32x4*)(lds + VT_OFF + d * VSTR + c8 * 16) = vraw[it];
            }
        }
        __syncthreads();
        const int q0 = qb * 128 + 16 * w;
        if (q0 < L) {
            const int qpos = q0 + r;
            const int fb = (16 + 16 * w) >> 5, cb = fb < 1 ? 1 : fb;
            const bf16_t* qrow = QK + (size_t)seq_row(seq, qpos) * 1280 + hk * 256;
            const float shift = BT[16 * 257];
            const int lkoff = KN_OFF + (8 * (r >> 2) + (r & 3)) * KSTR + 16 * g;
            const int lvoff = VT_OFF + r * VSTR + 16 * g;
            const int lb = 8 * g - r;
            {
                bf16x8 qf0[4], qf1[4]; const LAS float* bt[4]; float den[4]; f32x4 oh[4][4];
#pragma unroll
                for (int h = 0; h < 4; ++h) {
                    const bf16_t* qa = qrow + h * 64;
                    const u32x4 a0 = *(const u32x4*)(qa + 8 * g), a1 = *(const u32x4*)(qa + 32 + 8 * g);
                    attn_qfrag(a0, a1, qg, g, qf0[h], qf1[h]);
                    bt[h] = BT + (hk * 4 + h) * 257 + 128; den[h] = 0.f;
#pragma unroll
                    for (int dt = 0; dt < 4; ++dt) oh[h][dt] = (f32x4){0.f, 0.f, 0.f, 0.f};
                }
#pragma unroll 1
                for (int i = 0; i < 10; ++i) {
                    const int chunk = i == 0 ? 0 : cb + i - 1;
                    const int kb = lkoff + 32 * chunk * KSTR;
                    const bf16x8 k00 = *(const LAS bf16x8*)(lds + kb), k01 = *(const LAS bf16x8*)(lds + kb + 64);
                    const bf16x8 k10 = *(const LAS bf16x8*)(lds + kb + 4 * KSTR), k11 = *(const LAS bf16x8*)(lds + kb + 4 * KSTR + 64);
                    const f32x4 z4 = (f32x4){0.f, 0.f, 0.f, 0.f};
                    f32x4 s0[4], s1[4];
#pragma unroll
                    for (int h = 0; h < 4; ++h) { s0[h] = __builtin_amdgcn_mfma_f32_16x16x32_bf16(k00, qf0[h], z4, 0, 0, 0); s1[h] = __builtin_amdgcn_mfma_f32_16x16x32_bf16(k10, qf0[h], z4, 0, 0, 0); }
#pragma unroll
                    for (int h = 0; h < 4; ++h) { s0[h] = __builtin_amdgcn_mfma_f32_16x16x32_bf16(k01, qf1[h], s0[h], 0, 0, 0); s1[h] = __builtin_amdgcn_mfma_f32_16x16x32_bf16(k11, qf1[h], s1[h], 0, 0, 0); }
                    const int cs = start - 16 - q0 + 32 * chunk + lb;
                    const int pmin = start + 32 * chunk - 16;
                    const bool interior = (chunk > 0) && (pmin >= q0 + 15 - 128) && (pmin + 31 <= q0 + 128) && (pmin >= 16) && (pmin + 31 < L);
                    const bool metal = (chunk == 0) && (g < 2);
                    bf16x8 pa[4];
#pragma unroll
                    for (int h = 0; h < 4; ++h) pa[h] = attn_scores(s0[h], s1[h], bt[h], cs, interior, metal, g, qpos, L, den[h]);
                    const int vbo = lvoff + 64 * chunk;
#pragma unroll
                    for (int dt = 0; dt < 4; ++dt) {
                        const bf16x8 vb = *(const LAS bf16x8*)(lds + vbo + dt * 16 * VSTR);
#pragma unroll
                        for (int h = 0; h < 4; ++h) oh[h][dt] = __builtin_amdgcn_mfma_f32_16x16x32_bf16(pa[h], vb, oh[h][dt], 0, 0, 0);
                    }
                }
#pragma unroll
                for (int h = 0; h < 4; ++h) attn_store(oh[h], den[h], sink[hk * 4 + h], shift, O, seq, q0, g, r, hk * 4 + h);
            }
        }
        __syncthreads();
    }
}

#define XB_TMO      128
#define XB_XCNT(j)  (256  + 64 * (j))
#define XB_XSUB(j)  (1280 + 64 * (j))
#define XB_XGEN(j)  (2304 + 64 * (j))
#define XB_TOP      3328
#define XB_TOPGEN   3392
#define XCD_BAR_WORDS 3456
#define XB_SPIN_CAP (1u << 18)

__device__ __forceinline__ unsigned xb_ld(unsigned* p)              { return __hip_atomic_load(p, __ATOMIC_RELAXED, __HIP_MEMORY_SCOPE_AGENT); }
__device__ __forceinline__ unsigned xb_add(unsigned* p, unsigned v) { return __hip_atomic_fetch_add(p, v, __ATOMIC_RELAXED, __HIP_MEMORY_SCOPE_AGENT); }
__device__ __forceinline__ unsigned xb_xcc_id() { return (unsigned)__builtin_amdgcn_s_getreg((3 << 11) | 20) & 0xFu; }
#define XB_SPIN(cond, bar) do { unsigned _sp = 0; while (cond) { __builtin_amdgcn_s_sleep(1); \
    if ((++_sp & 255u) == 0u) { if (xb_ld(&(bar)[XB_TMO])) break; if (_sp > XB_SPIN_CAP) { atomicAdd(&(bar)[XB_TMO], 1u); break; } } } } while (0)

struct XcdBarrier {
    unsigned* bar; unsigned x;
    volatile LAS unsigned* st;
};

__device__ __forceinline__ XcdBarrier xcd_barrier_post(unsigned* bar, volatile LAS unsigned* st) {
    XcdBarrier b; b.bar = bar; b.x = xb_xcc_id(); b.st = st;
    if (threadIdx.x == 0) (void)xb_add(&bar[XB_XCNT(b.x)], 1u);
    return b;
}
__device__ __forceinline__ void xcd_barrier_complete(unsigned* bar, unsigned x, unsigned& nloc, unsigned& nx) {
    const unsigned G = gridDim.x * gridDim.y * gridDim.z;
    unsigned sum, cnt, mine, sp = 0u;
    for (;;) {
        sum = 0u; cnt = 0u; mine = 0u;
#pragma unroll
        for (unsigned j = 0; j < 16; ++j) { const unsigned c = xb_ld(&bar[XB_XCNT(j)]); sum += c; cnt += (c > 0u) ? 1u : 0u; mine = (j == x) ? c : mine; }
        if (sum == G) break;
        __builtin_amdgcn_s_sleep(1);
        if ((++sp & 255u) == 0u) { if (xb_ld(&bar[XB_TMO])) break; if (sp > XB_SPIN_CAP) { atomicAdd(&bar[XB_TMO], 1u); break; } }
    }
    nloc = mine > 0u ? mine : 1u; nx = cnt > 0u ? cnt : 1u;
}

__device__ __forceinline__ void xcd_barrier(const XcdBarrier& b) {
    asm volatile("s_waitcnt vmcnt(0)" ::: "memory");
    __syncthreads();
    if (threadIdx.x == 0) {
        unsigned* bar = b.bar;
        __builtin_amdgcn_s_waitcnt(0);
        unsigned nloc = b.st[0], nx = b.st[1];
        if (nloc == 0u) { xcd_barrier_complete(bar, b.x, nloc, nx); b.st[0] = nloc; b.st[1] = nx; }
        const unsigned old = xb_add(&bar[XB_XSUB(b.x)], 1u);
        const unsigned gen = old / nloc;
        if (old + 1u == (gen + 1u) * nloc) {
            __builtin_amdgcn_fence(__ATOMIC_RELEASE, "agent");
            asm volatile("s_waitcnt vmcnt(0)" ::: "memory");
            const unsigned og = xb_add(&bar[XB_TOP], 1u);
            const unsigned tg = og / nx;
            if (og + 1u == (tg + 1u) * nx) xb_add(&bar[XB_TOPGEN], 1u);
            else XB_SPIN(xb_ld(&bar[XB_TOPGEN]) == tg, bar);
            __builtin_amdgcn_fence(__ATOMIC_ACQUIRE, "agent");
            xb_add(&bar[XB_XGEN(b.x)], 1u);
            asm volatile("s_waitcnt vmcnt(0)" ::: "memory");
        } else {
            XB_SPIN(xb_ld(&bar[XB_XGEN(b.x)]) == gen, bar);
            __builtin_amdgcn_fence(__ATOMIC_ACQUIRE, "agent");
            asm volatile("s_waitcnt vmcnt(0)" ::: "memory");
        }
    }
    __syncthreads();
}

constexpr int LDS_XB_OFF = 147456 - 64;
#ifndef PHMASK
#define PHMASK 0xFFFF
#endif
#define PH(b) if constexpr ((PHMASK >> (b)) & 1)
#define GRID_SYNC() do { XcdBarrier _b; { kargs_t _p = (kargs_t)__builtin_amdgcn_kernarg_segment_ptr(); asm volatile("" : "+s"(_p)); _b.bar = (unsigned*)_p->ws; } _b.x = xb_xcc_id(); _b.st = (volatile LAS unsigned*)(lds + LDS_XB_OFF); xcd_barrier(_b); } while (0)
#define GRID_SYNC_CG() do { asm volatile("s_waitcnt vmcnt(0) lgkmcnt(0)" ::: "memory"); grid.sync(); if ((threadIdx.x >> 6) == 0) { __builtin_amdgcn_fence(__ATOMIC_ACQUIRE, "agent"); asm volatile("s_waitcnt vmcnt(0)" ::: "memory"); } __syncthreads(); } while (0)
typedef const __attribute__((address_space(4))) Args* kargs_t;
__device__ __forceinline__ Args get_args() {
    kargs_t p = (kargs_t)__builtin_amdgcn_kernarg_segment_ptr();
    asm volatile("" : "+s"(p));
    Args a;
#pragma unroll
    for (int i = 0; i < 25; ++i) a.in[i] = p->in[i];
    a.out = p->out; a.ws = p->ws; a.layer_lo = p->layer_lo; a.layer_hi = p->layer_hi;
    return a;
}
__device__ __forceinline__ EpiResid make_resid(const Args& a, int layer, int which  , int rb) {
    u64* rowss = (u64*)(a.ws + WS_ROWSS); float* metah = (float*)(a.ws + WS_METAH);
    EpiResid e;
    const bool first = (layer == 0 && which == 0);
    e.srcA = first ? a.in[0] : a.out; e.srcB = first ? a.in[1] : a.out + (size_t)ROWS_P * DM; e.srcM = first ? a.in[2] : metah; e.meta_mask = first ? 15 : 0xffff;
    e.dstMain = a.out; e.dstM = metah;
    const int nxt = 2 * layer + 1 + which;
    e.P = nxt < 8 ? (bf16_t*)(a.ws + WS_P) : nullptr; e.rowss_next = nxt < 8 ? rowss + (size_t)nxt * MPAD : nullptr; e.row_base = rb;
    return e;
}
__global__ void __launch_bounds__(512, 2) fwd_megakernel(Args a_unused) {
    extern __shared__ __attribute__((aligned(16))) unsigned char lds_raw[];
    LAS unsigned char* lds = (LAS unsigned char*)lds_raw;
    cg::grid_group grid = cg::this_grid();
    const int G0 = gridDim.x, bid0 = blockIdx.x;
    volatile LAS unsigned* xst = (volatile LAS unsigned*)(lds + LDS_XB_OFF);
    if (threadIdx.x < 2) xst[threadIdx.x] = 0u;
    __syncthreads();
    (void)xcd_barrier_post((unsigned*)a_unused.ws, xst);

    const int layer_lo = a_unused.layer_lo, layer_hi = a_unused.layer_hi;
    if (layer_lo == 0) {
        const Args a = get_args(); const int tid = ltid(), G = lsg(G0), bid = lsg(bid0);
        const int lane = tid & 63, wave = __builtin_amdgcn_readfirstlane(tid >> 6);
        const int gw = bid * 7 + wave, NGW = G * 7;
        u64* rowss = (u64*)(a.ws + WS_ROWSS);
        bf16_t* Wb = (bf16_t*)(a.ws + WS_W);
        bf16_t* P = (bf16_t*)(a.ws + WS_P);
        for (size_t i = (size_t)bid * 512 + tid; i < (size_t)7 * MPAD; i += (size_t)G * 512) rowss[MPAD + i] = 0ull;
        if (wave == 7) {
            PH(1) for (int task = bid; task < 2 * 193; task += G) h2_features(lds + 7 * 16384, a, task / 193, (task % 193) * 64 + lane, lane);
        } else
        PH(0) {
        LAS float* scr = (LAS float*)(lds + wave * 16384);
#pragma unroll 1
        for (int j = 0; j < 2; ++j) {
            convert_matrix(a.in[6] + (size_t)j * 1024 * 3072, a.in[4] + (2 * j) * 1024, 1024, 3072, (bf16_t*)((char*)Wb + W_IN + (size_t)j * 6 * MiB), scr, gw, NGW, lane);
            convert_matrix(a.in[17] + (size_t)j * 1024 * 1024, nullptr, 1024, 1024, (bf16_t*)((char*)Wb + W_HOUT + (size_t)j * 2 * MiB), scr, gw, NGW, lane);
            convert_matrix(a.in[18] + (size_t)j * 1024 * 1536, a.in[4] + (2 * j + 1) * 1024, 1024, 1536, (bf16_t*)((char*)Wb + W_QKV + (size_t)j * 3 * MiB), scr, gw, NGW, lane);
            convert_matrix(a.in[22] + (size_t)j * 1024 * 1024, nullptr, 1024, 1024, (bf16_t*)((char*)Wb + W_AOUT + (size_t)j * 2 * MiB), scr, gw, NGW, lane);
        }
#pragma unroll 1
        for (int i = 0; i < 4; ++i) {
            convert_matrix(a.in[23] + (size_t)i * 1024 * 4096, a.in[5] + i * 1024, 1024, 4096, (bf16_t*)((char*)Wb + W_UP + (size_t)i * 8 * MiB), scr, gw, NGW, lane);
            convert_matrix(a.in[24] + (size_t)i * 4096 * 1024, nullptr, 4096, 1024, (bf16_t*)((char*)Wb + W_DN + (size_t)i * 8 * MiB), scr, gw, NGW, lane);
        }
        for (int row0 = gw; row0 < MREAL; row0 += 4 * NGW) {
            f32x4 v[4][4];
#pragma unroll
            for (int rr = 0; rr < 4; ++rr) {
                const int row = row0 + rr * NGW, rowc = row < MREAL ? row : MREAL - 1;
                const float* src = rowc < ROWS_P ? a.in[0] + (size_t)rowc * DM : (rowc < ROWS_MAIN ? a.in[1] + (size_t)(rowc - ROWS_P) * DM : a.in[2] + (size_t)((rowc - ROWS_MAIN) & 15) * DM);
#pragma unroll
                for (int k = 0; k < 4; ++k) v[rr][k] = *(const f32x4*)(src + k * 256 + lane * 4);
            }
#pragma unroll
            for (int rr = 0; rr < 4; ++rr) {
                const int row = row0 + rr * NGW;
                float ss = 0.f;
#pragma unroll
                for (int k = 0; k < 4; ++k) { const f32x4 x = v[rr][k];
                    ss += (x[0] * x[0] + x[1] * x[1]) + (x[2] * x[2] + x[3] * x[3]);
                    u32x2 pk; pk.x = cvtpk(x[0], x[1]); pk.y = cvtpk(x[2], x[3]);
                    if (row < MREAL) *(u32x2*)(P + (size_t)row * DM + k * 256 + lane * 4) = pk; }
                ss = wave_sum(ss);
                if (lane == 0 && row < MREAL) rowss[row] = (u64)(ss * SS_SCALE);
            }
        }
        }
        GRID_SYNC_CG();
    }

#pragma unroll 1
    for (int layer = layer_lo; layer < layer_hi; ++layer) {
        if ((layer & 1) == 0) {
            {
                const Args a = get_args(); const int tid = ltid(), G = lsg(G0), bid = lsg(bid0); const int j = layer >> 1;
                PH(2) fk_compute(a, j, bid * 8 + __builtin_amdgcn_readfirstlane(tid >> 6), G * 8, tid & 63);
                PH(3) {
                pg8::Gemm g{(const bf16_t*)(a.ws + WS_P), (const bf16_t*)(a.ws + WS_W + W_IN + (size_t)j * 6 * MiB), MPAD, 3072, 1024, 1024, 1024}; pg8::StaticOrder S; S.init(MPAD, 3072, G, bid);
                EpiHyIn E{(bf16_t*)(a.ws + WS_R1), (const u64*)(a.ws + WS_ROWSS) + (size_t)(2 * layer) * MPAD};
                pg8::gemm_phase<EpiHyIn>(lds, g, S, E);
                }
            }
            GRID_SYNC();
            { const Args a = get_args(); const int tid = ltid(), G = lsg(G0), bid = lsg(bid0); PH(4) conv_phase(lds, a, layer >> 1, bid, G, tid); }
            GRID_SYNC();
            { const Args a = get_args(); const int tid = ltid(), G = lsg(G0), bid = lsg(bid0); PH(5) transpose_phase(lds, a, bid, G, tid); }
            GRID_SYNC();
            {
                const Args a = get_args(); const int tid = ltid(), G = lsg(G0), bid = lsg(bid0); const int j = layer >> 1;
                PH(6) {
                pg8::Gemm g{(const bf16_t*)(a.ws + WS_R1), (const bf16_t*)(a.ws + WS_W + W_HOUT + (size_t)j * 2 * MiB), MPAD, 1024, 1024, 1024, 1024}; pg8::StaticOrder S; S.init(MPAD, 1024, G, bid);
                const EpiResid er = make_resid(a, layer, 0, 0);
                pg8::gemm_phase<EpiResid>(lds, g, S, er);
                }
            }
            GRID_SYNC();
        } else {
            {
                const Args a = get_args(); const int tid = ltid(), G = lsg(G0), bid = lsg(bid0); const int j = layer >> 1;
                PH(7) {
                pg8::Gemm g{(const bf16_t*)(a.ws + WS_P), (const bf16_t*)(a.ws + WS_W + W_QKV + (size_t)j * 3 * MiB), MPAD, 1536, 1024, 1024, 1024}; pg8::StaticOrder S; S.init(MPAD, 1536, G, bid);
                EpiRow<0> E{(bf16_t*)(a.ws + WS_R1), (bf16_t*)(a.ws + WS_VT), (const u64*)(a.ws + WS_ROWSS) + (size_t)(2 * layer) * MPAD, 0};
                pg8::gemm_phase<EpiRow<0>>(lds, g, S, E);
                }
            }
            GRID_SYNC();
            { const Args a = get_args(); const int tid = ltid(), G = lsg(G0), bid = lsg(bid0); PH(8) attn_phase(lds, a, layer >> 1, bid, G, tid); }
            GRID_SYNC();
            {
                const Args a = get_args(); const int tid = ltid(), G = lsg(G0), bid = lsg(bid0); const int j = layer >> 1;
                PH(9) {
                pg8::Gemm g{(const bf16_t*)(a.ws + WS_R3), (const bf16_t*)(a.ws + WS_W + W_AOUT + (size_t)j * 2 * MiB), MPAD, 1024, 1024, 1024, 1024}; pg8::StaticOrder S; S.init(MPAD, 1024, G, bid);
                const EpiResid er = make_resid(a, layer, 0, 0);
                pg8::gemm_phase<EpiResid>(lds, g, S, er);
                }
            }
            GRID_SYNC();
        }
#pragma unroll 1
        for (int half = 0; half < 2; ++half) {
            const int rb = half * MT_H0 * 256; const int mrows = (half == 0 ? MT_H0 : MT_H1) * 256;
            {
                const Args a = get_args(); const int tid = ltid(), G = lsg(G0), bid = lsg(bid0);
                PH(10) {
                pg8::Gemm g{(const bf16_t*)(a.ws + WS_P) + (size_t)rb * DM, (const bf16_t*)(a.ws + WS_W + W_UP + (size_t)layer * 8 * MiB), mrows, 4096, 1024, 1024, 1024}; pg8::StaticOrder S; S.init(mrows, 4096, G, bid);
                EpiRow<1> E{(bf16_t*)(a.ws + WS_R1), nullptr, (const u64*)(a.ws + WS_ROWSS) + (size_t)(2 * layer + 1) * MPAD, rb};
                pg8::gemm_phase<EpiRow<1>>(lds, g, S, E);
                }
            }
            GRID_SYNC();
            {
                const Args a = get_args(); const int tid = ltid(), G = lsg(G0), bid = lsg(bid0);
                PH(11) {
                const int drows = MT_H0 * 256;
                pg8::Gemm g{(const bf16_t*)(a.ws + WS_R1), (const bf16_t*)(a.ws + WS_W + W_DN + (size_t)layer * 8 * MiB), drows, 1024, 4096, 4096, 4096}; pg8::StaticOrder S; S.init(drows, 1024, G, bid);
                const EpiResid e2 = make_resid(a, layer, 1, rb);
                pg8::gemm_phase<EpiResid>(lds, g, S, e2);
                }
            }
            if (half == 1) {
                {
                    const Args a = get_args(); const int G = lsg(G0), bid = lsg(bid0);
                    PH(11) {
                    pg8::Gemm g2{(const bf16_t*)(a.ws + WS_R1) + (size_t)(MT_H0 * 256) * DFF, (const bf16_t*)(a.ws + WS_W + W_DN + (size_t)layer * 8 * MiB), 512, 1024, 4096 / DOWN_KS, 4096, 4096};
                    pg8::StaticOrder S2; S2.init_ks(512, 1024, DOWN_KS, G, bid);
                    EpiPartial ep{(float*)(a.ws + WS_R3)};
                    pg8::gemm_phase<EpiPartial>(lds, g2, S2, ep);
                    }
                }
                GRID_SYNC();
                const Args a = get_args(); const int tid = ltid(), G = lsg(G0), bid = lsg(bid0);
                const int nxt = 2 * layer + 2;
                meta_reduce((const float*)(a.ws + WS_R3), (float*)(a.ws + WS_METAH), nxt < 8 ? (bf16_t*)(a.ws + WS_P) : nullptr,
                            nxt < 8 ? (u64*)(a.ws + WS_ROWSS) + (size_t)nxt * MPAD : nullptr, bid * 8 + (tid >> 6), G * 8, tid & 63);
            }
            if (!(layer == layer_hi - 1 && half == 1)) GRID_SYNC();
        }
    }
}

constexpr int LDS_BYTES = 147456;
extern "C" void kernel_launch(void* const* d_in, const int* in_sizes, int n_in, void* d_out, int out_size, void* d_ws, size_t ws_size, hipStream_t stream) {
    static int grid = 0;
    if (grid == 0) {
        if (n_in != 25 || ws_size < WS_END) { fprintf(stderr, "kernel_launch: unexpected n_in %d or ws_size %zu (need %zu)\n", n_in, ws_size, (size_t)WS_END); grid = -1; return; }
        int dev = 0, cus = 0, per_cu = 0;
        (void)hipGetDevice(&dev);
        (void)hipDeviceGetAttribute(&cus, hipDeviceAttributeMultiprocessorCount, dev);
        if (hipFuncSetAttribute((const void*)fwd_megakernel, hipFuncAttributeMaxDynamicSharedMemorySize, LDS_BYTES) != hipSuccess) { fprintf(stderr, "kernel_launch: hipFuncSetAttribute failed\n"); grid = -1; return; }
        if (hipOccupancyMaxActiveBlocksPerMultiprocessor(&per_cu, (const void*)fwd_megakernel, 512, LDS_BYTES) != hipSuccess || per_cu < 1) { fprintf(stderr, "kernel_launch: occupancy query gives %d\n", per_cu); per_cu = 1; }
        (void)hipGetLastError();
        grid = cus * 1;
        fprintf(stderr, "kernel_launch: cus %d per_cu %d grid %d\n", cus, per_cu, grid);
    }
    if (grid < 0) return;
    Args a{};
    for (int i = 0; i < 25; ++i) a.in[i] = (const float*)d_in[i];
    a.out = (float*)d_out; a.ws = (unsigned char*)d_ws;
#ifndef NSPLIT
#define NSPLIT 1
#endif
    (void)hipMemsetAsync(d_ws, 0, 16384, stream);
    for (int part = 0; part < NSPLIT; ++part) {
        a.layer_lo = part * (4 / NSPLIT); a.layer_hi = (part + 1) * (4 / NSPLIT);
        void* args[] = {&a};
        hipError_t e = hipLaunchCooperativeKernel((const void*)fwd_megakernel, dim3(grid), dim3(512), args, LDS_BYTES, stream);
        if (e != hipSuccess) fprintf(stderr, "cooperative launch failed: %s (grid %d)\n", hipGetErrorString(e), grid);
    }
}
```

```cpp
#include <hip/hip_runtime.h>
#include <hip/hip_cooperative_groups.h>
#include <cstdio>
#include <cstdint>
namespace cg = cooperative_groups;

#define LAS __attribute__((address_space(3)))
typedef unsigned short bf16_t;
typedef short bf16x8 __attribute__((ext_vector_type(8)));
typedef float f32x4 __attribute__((ext_vector_type(4)));
typedef float f32x2 __attribute__((ext_vector_type(2)));
typedef unsigned u32x4 __attribute__((ext_vector_type(4)));
typedef unsigned u32x2 __attribute__((ext_vector_type(2)));
typedef __bf16 bf16x2_t __attribute__((ext_vector_type(2)));
typedef unsigned long long u64;
typedef unsigned long long u64x2 __attribute__((ext_vector_type(2)));
constexpr float SS_SCALE = 1048576.0f, SS_INV = 1.0f / (1048576.0f * 1024.0f);
__device__ __forceinline__ float ss_rinv(u64 v) { return __builtin_amdgcn_rsqf((float)v * SS_INV + 1e-6f); }

constexpr int DM = 1024, DFF = 4096;
constexpr int L_P = 8208, L_S = 4112;
constexpr int LS_P = 8256, LS_S = 4160, XPAD = 48;
constexpr int ROWS_P = 32768, ROWS_MAIN = 98304, MREAL = 98624, MPAD = 98816;
constexpr int MT_ALL = MPAD / 256;
constexpr int MT_H0 = 192, MT_H1 = MT_ALL - MT_H0;
constexpr float EPS = 1e-6f;

constexpr size_t MiB = 1u << 20;
constexpr size_t WS_ROWSS = 1 * MiB;
constexpr size_t WS_METAH = 8 * MiB;
constexpr size_t WS_H2T = 10 * MiB;
constexpr size_t WS_W = 17 * MiB;
constexpr size_t WS_FK = 107 * MiB;
constexpr size_t WS_P = 211 * MiB;
constexpr size_t WS_R1 = 404 * MiB, WS_R2 = 599 * MiB, WS_R3 = 794 * MiB, WS_END = 989 * MiB;
constexpr size_t WS_VT = 703 * MiB;
constexpr size_t W_IN = 0, W_HOUT = 12 * MiB, W_QKV = 16 * MiB, W_AOUT = 22 * MiB, W_UP = 26 * MiB, W_DN = 58 * MiB;
constexpr int H2N = 12320;
constexpr int FK_OFFS_P = 8704, FK_LEN_P = 17408, FK_OFFS_S = 4608, FK_LEN_S = 9216;
constexpr size_t FK_SAMPLE_OFF = (size_t)2 * 1024 * FK_LEN_P;

struct Args { const float* in[25]; float* out; unsigned char* ws; int layer_lo, layer_hi; };

__device__ __forceinline__ unsigned cvtpk(float lo, float hi) { f32x2 v = {lo, hi}; bf16x2_t b = __builtin_convertvector(v, bf16x2_t); return __builtin_bit_cast(unsigned, b); }
__device__ __forceinline__ float bf2f(unsigned short x) { return __builtin_bit_cast(float, (unsigned)x << 16); }
__device__ __forceinline__ float bflo(unsigned x) { return __builtin_bit_cast(float, x << 16); }
__device__ __forceinline__ float bfhi(unsigned x) { return __builtin_bit_cast(float, x & 0xffff0000u); }
__device__ __forceinline__ int ltid() { int t = threadIdx.x; asm volatile("" : "+v"(t)); return t; }
__device__ __forceinline__ int lsg(int x) { asm volatile("" : "+s"(x)); return x; }
__device__ __forceinline__ int seq_L(int s) { return s < 4 ? L_P : L_S; }
__device__ __forceinline__ int seq_LS(int s) { return s < 4 ? LS_P : LS_S; }
__device__ __forceinline__ size_t seq_off_ch(int s) { return s < 4 ? (size_t)s * 1024 * LS_P : (size_t)4 * 1024 * LS_P + (size_t)(s - 4) * 1024 * LS_S; }
__device__ __forceinline__ int seq_row(int s, int p) { return p < 16 ? ROWS_MAIN + 16 * s + p : (s < 4 ? s * 8192 : 32768 + (s - 4) * 4096) + p - 16; }
__device__ __forceinline__ void row_decode(int row0, int& s, int& p0, int& L) {
    if (row0 < ROWS_P) { s = row0 >> 13; p0 = 16 + (row0 & 8191); L = L_P; }
    else if (row0 < ROWS_MAIN) { const int r = row0 - ROWS_P; s = 4 + (r >> 12); p0 = 16 + (r & 4095); L = L_S; }
    else { const int r = row0 - ROWS_MAIN; s = r >> 4; p0 = r & 15; L = s < 4 ? L_P : L_S; }
}
__device__ __forceinline__ float wave_sum(float v) {
#pragma unroll
    for (int o = 1; o < 64; o <<= 1) v += __shfl_xor(v, o);
    return v;
}
__device__ __forceinline__ void my_sincos(float x, float& s, float& c) {
    const float k = rintf(x * 0.636619772367581f);
    float r = fmaf(-k, 1.57079625129699707031f, x);
    r = fmaf(-k, 7.54978941586159635335e-08f, r);
    r = fmaf(-k, 5.39030285815811905290e-15f, r);
    const float r2 = r * r;
    const float sp = r + r * r2 * (-1.6666654611e-1f + r2 * (8.3321608736e-3f + r2 * -1.9515295891e-4f));
    const float cp = 1.0f - 0.5f * r2 + r2 * r2 * (4.166664568298827e-2f + r2 * (-1.388731625493765e-3f + r2 * 2.443315711809948e-5f));
    const int n = ((int)k) & 3;
    s = (n == 0) ? sp : (n == 1) ? cp : (n == 2) ? -sp : -cp;
    c = (n == 0) ? cp : (n == 1) ? -sp : (n == 2) ? -cp : sp;
}
__device__ __forceinline__ float my_sin(float x) { float s, c; my_sincos(x, s, c); return s; }
__device__ __forceinline__ int t5_bucket(int rel) {
    const int n = rel < 0 ? -rel : rel; int b;
    if (n < 8) b = n; else if (n < 12) b = 8; else if (n < 16) b = 9; else if (n < 23) b = 10; else if (n < 32) b = 11;
    else if (n < 46) b = 12; else if (n < 64) b = 13; else if (n < 91) b = 14; else b = 15;
    return (rel > 0 ? 16 : 0) + b;
}

namespace pg8 {
#define PG8_LAS __attribute__((address_space(3)))
constexpr int BM = 256, BK = 64, HALF = 128, HTB = HALF * BK * 2, STAGE_BYTES = 8 * HTB, NXCD = 8, WGM = 8;
__host__ __device__ __forceinline__ int lds_byte(int r, int c) { const int st = (r >> 4) * 2 + (c >> 5), rr = r & 15, cc = c & 31, ob = rr * 64 + cc * 2; return st * 1024 + (ob ^ (((ob >> 9) & 1) << 5)); }
__host__ __device__ __forceinline__ void stage_rc(int b, int& R, int& C) { const int st = b / 1024, sb = b % 1024, swz = sb ^ (((sb >> 9) & 1) << 5); R = (st >> 1) * 16 + swz / 64; C = (st & 1) * 32 + (swz % 64) / 2; }
__host__ __device__ __forceinline__ int perm32(int rho) { const int n = rho >> 4, i = rho & 15; return 8 * (i >> 2) + 4 * n + (i & 3); }
struct Unit { int pm, pn, ks; };
struct Gemm { const bf16_t* A; const bf16_t* Bt; int M, N, K; int lda, ldb; };
struct StaticOrder {
    int nM, nN, nwg, G, c, KS;
    __host__ __device__ void init(int M, int N, int G_, int c_) { nM = M / BM; nN = N / BM; nwg = nM * nN; G = G_; c = c_; KS = 1; }
    __host__ __device__ void init_ks(int M, int N, int KS_, int G_, int c_) { nM = M / BM; nN = N / BM; KS = KS_; nwg = nM * nN * KS; G = G_; c = c_; }
    __host__ __device__ bool next(int i, Unit& u) const {
        const long L = (long)i * G + c; if (L >= nwg) return false;
        u.ks = 0;
        if (KS > 1) { const int l = (int)L; u.ks = l % KS; const int t = l / KS; u.pm = t % nM; u.pn = t / nM; return true; }
        int wgid = (int)L; { const int q = nwg / NXCD, r = nwg % NXCD, xcd = wgid % NXCD, off = wgid / NXCD; wgid = (xcd < r ? xcd * (q + 1) : r * (q + 1) + (xcd - r) * q) + off; }
        const int nig = WGM * nN, gid = wgid / nig, fm = gid * WGM, gsz = (nM - fm) < WGM ? (nM - fm) : WGM;
        u.pm = fm + ((wgid % nig) % gsz); u.pn = (wgid % nig) / gsz; return true;
    }
};

template <class Epi, bool ALIGN_EPI = true>
__device__ __forceinline__ void gemm_phase(PG8_LAS unsigned char* lds, const Gemm g, const StaticOrder& S, const Epi& E) {
    const int tid = ltid(), wid = __builtin_amdgcn_readfirstlane(tid >> 6), lane = tid & 63, wr = wid >> 2, wc = wid & 3, fr = lane & 15, fq = lane >> 4;
    const int K = g.K, nt = K / BK;
    unsigned voffA[2], voffB[2];
#pragma unroll
    for (int i = 0; i < 2; ++i) { int R, C; stage_rc(tid * 16 + i * 8192, R, C); const int Rb = Epi::PERM ? ((R & ~31) + perm32(R & 31)) : R;
        voffA[i] = (unsigned)(R * g.lda + C) * 2u; voffB[i] = (unsigned)(Rb * g.ldb + C) * 2u; }
    const size_t kstep = (size_t)(BK * 2);
    const size_t hstepA = (size_t)HALF * g.lda * 2, hstepB = (size_t)HALF * g.ldb * 2;
    const size_t tstepA = 2 * hstepA, tstepB = 2 * hstepB, ksA = (size_t)K * 2;
    const unsigned ldsw = (unsigned)wid * 1024u;
    const int aoff = lds_byte(wr * 64 + fr, fq * 8), boff = lds_byte(wc * 32 + fr, fq * 8);
#define PG8_SA(b, h) (((b) * 2 + (h)) * HTB)
#define PG8_SB(b, h) ((4 + (b) * 2 + (h)) * HTB)
#define PG8_STAGE(bufoff, gbase, voff) do { _Pragma("unroll") for (int _i = 0; _i < 2; ++_i) \
        __builtin_amdgcn_global_load_lds((const unsigned*)((const char*)(gbase) + (voff)[_i]), (PG8_LAS unsigned*)(lds + (bufoff) + ldsw + _i * 8192), 16, 0, 0); } while (0)
#define PG8_LDA(dst, b, h) do { _Pragma("unroll") for (int m = 0; m < 4; ++m) _Pragma("unroll") for (int k = 0; k < 2; ++k) dst[m][k] = *(const PG8_LAS bf16x8*)(lds + PG8_SA(b, h) + aoff + m * 2048 + k * 1024); } while (0)
#define PG8_LDB(dst, b, h) do { _Pragma("unroll") for (int n = 0; n < 2; ++n) _Pragma("unroll") for (int k = 0; k < 2; ++k) dst[n][k] = *(const PG8_LAS bf16x8*)(lds + PG8_SB(b, h) + boff + n * 2048 + k * 1024); } while (0)
#define PG8_MMA(ai, bj, At, Bt) do { __builtin_amdgcn_s_setprio(1); _Pragma("unroll") for (int m = 0; m < 4; ++m) _Pragma("unroll") for (int n = 0; n < 2; ++n) _Pragma("unroll") for (int k = 0; k < 2; ++k) \
        acc[ai][bj][m][n] = Epi::SWAP ? __builtin_amdgcn_mfma_f32_16x16x32_bf16(Bt[n][k], At[m][k], acc[ai][bj][m][n], 0, 0, 0) \
                                      : __builtin_amdgcn_mfma_f32_16x16x32_bf16(At[m][k], Bt[n][k], acc[ai][bj][m][n], 0, 0, 0); __builtin_amdgcn_s_setprio(0); } while (0)
#define PG8_WAIT_V(n) asm volatile("s_waitcnt vmcnt(" #n ")" ::: "memory")
#define PG8_WAIT_L(n) asm volatile("s_waitcnt lgkmcnt(" #n ")" ::: "memory")
#define PG8_BAR __builtin_amdgcn_s_barrier()
#define PG8_SCHED __builtin_amdgcn_sched_barrier(0)
    Unit cur, nxt; int ui = 0;
    if (!S.next(0, cur)) return;
    f32x4 acc[2][2][4][2];
#pragma unroll
    for (int a = 0; a < 2; ++a)
#pragma unroll
        for (int b = 0; b < 2; ++b)
#pragma unroll
            for (int m = 0; m < 4; ++m)
#pragma unroll
                for (int n = 0; n < 2; ++n) acc[a][b][m][n] = (f32x4){0.f, 0.f, 0.f, 0.f};
    bf16x8 At[4][2], B0[2][2], B1[2][2];
    const char* cA = (const char*)g.A + (size_t)cur.pm * tstepA + (size_t)cur.ks * ksA; const char* cB = (const char*)g.Bt + (size_t)cur.pn * tstepB + (size_t)cur.ks * ksA;
    PG8_STAGE(PG8_SB(0, 0), cB, voffB); PG8_STAGE(PG8_SB(0, 1), cB + hstepB, voffB); PG8_STAGE(PG8_SA(0, 0), cA, voffA); PG8_STAGE(PG8_SA(0, 1), cA + hstepA, voffA);
    if (wr == 1) PG8_BAR;
    PG8_WAIT_V(2); PG8_BAR;
    PG8_STAGE(PG8_SB(1, 0), cB + kstep, voffB); PG8_STAGE(PG8_SA(1, 0), cA + kstep, voffA); PG8_STAGE(PG8_SB(1, 1), cB + hstepB + kstep, voffB);
    PG8_WAIT_V(6); PG8_BAR;
    for (;;) {
        const bool has_next = S.next(ui + 1, nxt);
        const char* nA = has_next ? (const char*)g.A + (size_t)nxt.pm * tstepA + (size_t)nxt.ks * ksA : cA; const char* nB = has_next ? (const char*)g.Bt + (size_t)nxt.pn * tstepB + (size_t)nxt.ks * ksA : cB;
        for (int t = 0; t < nt; t += 2) {
            const bool last = (t == nt - 2);
            const char* a1 = cA + (size_t)(t + 1) * kstep;
            const char* a2 = last ? nA : cA + (size_t)(t + 2) * kstep; const char* b2 = last ? nB : cB + (size_t)(t + 2) * kstep;
            const char* a3 = a2 + kstep; const char* b3 = b2 + kstep;
            PG8_LDB(B0, 0, 0); PG8_LDB(B1, 0, 1); PG8_SCHED; PG8_LDA(At, 0, 0); PG8_STAGE(PG8_SA(1, 1), a1 + hstepA, voffA);
            PG8_WAIT_V(8); PG8_WAIT_L(0); PG8_BAR; PG8_MMA(0, 0, At, B0); PG8_MMA(0, 1, At, B1); PG8_BAR; PG8_SCHED;
            PG8_LDA(At, 0, 1); PG8_STAGE(PG8_SB(0, 0), b2, voffB); PG8_STAGE(PG8_SB(0, 1), b2 + hstepB, voffB); PG8_STAGE(PG8_SA(0, 0), a2, voffA);
            PG8_WAIT_V(8); PG8_WAIT_L(0); PG8_BAR; PG8_MMA(1, 0, At, B0); PG8_MMA(1, 1, At, B1); PG8_BAR; PG8_SCHED;
            PG8_LDB(B0, 1, 0); PG8_LDB(B1, 1, 1); PG8_SCHED; PG8_LDA(At, 1, 0); PG8_STAGE(PG8_SA(0, 1), a2 + hstepA, voffA);
            PG8_WAIT_V(8); PG8_WAIT_L(0); PG8_BAR; PG8_MMA(0, 0, At, B0); PG8_MMA(0, 1, At, B1); PG8_BAR; PG8_SCHED;
            PG8_LDA(At, 1, 1); PG8_STAGE(PG8_SB(1, 0), b3, voffB); PG8_STAGE(PG8_SB(1, 1), b3 + hstepB, voffB); PG8_STAGE(PG8_SA(1, 0), a3, voffA);
            PG8_WAIT_V(8); PG8_WAIT_L(0); PG8_BAR; PG8_MMA(1, 0, At, B0); PG8_MMA(1, 1, At, B1); PG8_BAR; PG8_SCHED;
        }
        if constexpr (ALIGN_EPI) { if (wr == 0) PG8_BAR; }
        E(acc, cur, wr, wc, fr, fq);
        if (!has_next) break;
#pragma unroll
        for (int a = 0; a < 2; ++a)
#pragma unroll
            for (int b = 0; b < 2; ++b)
#pragma unroll
                for (int m = 0; m < 4; ++m)
#pragma unroll
                    for (int n = 0; n < 2; ++n) acc[a][b][m][n] = (f32x4){0.f, 0.f, 0.f, 0.f};
        cur = nxt; cA = nA; cB = nB; ++ui;
        if constexpr (ALIGN_EPI) { if (wr == 1) PG8_BAR; }
    }
    PG8_WAIT_V(0);
    if constexpr (!ALIGN_EPI) { if (wr == 0) PG8_BAR; }
    PG8_BAR;
#undef PG8_SA
#undef PG8_SB
#undef PG8_STAGE
#undef PG8_LDA
#undef PG8_LDB
#undef PG8_MMA
#undef PG8_WAIT_V
#undef PG8_WAIT_L
#undef PG8_BAR
#undef PG8_SCHED
}
}

struct EpiHyIn {
    static constexpr bool PERM = false, SWAP = false;
    bf16_t* XT; const u64* rowss;
    __device__ __forceinline__ void operator()(const f32x4 (&acc)[2][2][4][2], const pg8::Unit& u, int wr, int wc, int fr, int fq) const {
        constexpr size_t REGION = (size_t)(WS_R2 - WS_R1) / 2;
#pragma unroll
        for (int ai = 0; ai < 2; ++ai)
#pragma unroll
            for (int m = 0; m < 4; ++m) {
                const int row0 = u.pm * 256 + ai * 128 + wr * 64 + m * 16;
                if (row0 >= MREAL) continue;
                const u64x2 s01 = *(const u64x2*)(rowss + row0 + 4 * fq), s23 = *(const u64x2*)(rowss + row0 + 4 * fq + 2);
                f32x4 ri; ri[0] = ss_rinv(s01[0]); ri[1] = ss_rinv(s01[1]); ri[2] = ss_rinv(s23[0]); ri[3] = ss_rinv(s23[1]);
                int s, p0, L; row_decode(row0, s, p0, L);
                const size_t so = seq_off_ch(s); const int LS = seq_LS(s);
#pragma unroll
                for (int bj = 0; bj < 2; ++bj)
#pragma unroll
                    for (int n = 0; n < 2; ++n) {
                        const int col = u.pn * 256 + bj * 128 + wc * 32 + n * 16 + fr;
                        const int part = col >> 10, ch = col & 1023;
                        const f32x4 v = acc[ai][bj][m][n] * ri;
                        u32x2 w; w.x = cvtpk(v[0], v[1]); w.y = cvtpk(v[2], v[3]);
                        *(u32x2*)(XT + (size_t)part * REGION + so + (size_t)ch * LS + XPAD + p0 + 4 * fq) = w;
                    }
            }
    }
};
template <int MODE> struct EpiRow {
    static constexpr bool PERM = true, SWAP = true;
    bf16_t* O; bf16_t* VT; const u64* rowss; int row_base;
    __device__ __forceinline__ void operator()(const f32x4 (&acc)[2][2][4][2], const pg8::Unit& u, int wr, int wc, int fr, int fq) const {
#pragma unroll
        for (int ai = 0; ai < 2; ++ai)
#pragma unroll
            for (int m = 0; m < 4; ++m) {
                const int lrow = u.pm * 256 + ai * 128 + wr * 64 + m * 16 + fr, grow = row_base + lrow;
                if (grow >= MREAL) continue;
                const float ri = ss_rinv(rowss[grow]);
#pragma unroll
                for (int bj = 0; bj < 2; ++bj) {
                    const int col0 = u.pn * 256 + bj * 128 + wc * 32 + 8 * fq;
                    f32x4 v0 = acc[ai][bj][m][0] * ri, v1 = acc[ai][bj][m][1] * ri;
                    if (MODE == 1) {
#pragma unroll
                        for (int i = 0; i < 4; ++i) { const float a = fmaxf(v0[i], 0.f), b = fmaxf(v1[i], 0.f); v0[i] = a * a; v1[i] = b * b; }
                        u32x4 w; w.x = cvtpk(v0[0], v0[1]); w.y = cvtpk(v0[2], v0[3]); w.z = cvtpk(v1[0], v1[1]); w.w = cvtpk(v1[2], v1[3]);
                        *(u32x4*)(O + (size_t)lrow * DFF + col0) = w;
                    } else {
                        if (col0 < 1280) {
                            u32x4 w; w.x = cvtpk(v0[0], v0[1]); w.y = cvtpk(v0[2], v0[3]); w.z = cvtpk(v1[0], v1[1]); w.w = cvtpk(v1[2], v1[3]);
                            *(u32x4*)(O + (size_t)grow * 1280 + col0) = w;
                        } else {
                            int s, p, L; row_decode(grow, s, p, L);
                            const int LS = seq_LS(s);
                            bf16_t* dst = VT + seq_off_ch(s) / 4 + (size_t)(col0 - 1280) * LS + XPAD + p;
#pragma unroll
                            for (int i = 0; i < 4; ++i) { dst[(size_t)i * LS] = (bf16_t)(cvtpk(v0[i], 0.f) & 0xffffu); dst[(size_t)(4 + i) * LS] = (bf16_t)(cvtpk(v1[i], 0.f) & 0xffffu); }
                        }
                    }
                }
            }
    }
};
struct EpiResid {
    static constexpr bool PERM = true, SWAP = true;
    const float* srcA; const float* srcB; const float* srcM; int meta_mask;
    float* dstMain; float* dstM; bf16_t* P; u64* rowss_next; int row_base;
    __device__ __forceinline__ void operator()(const f32x4 (&acc)[2][2][4][2], const pg8::Unit& u, int wr, int wc, int fr, int fq) const {
#pragma unroll
        for (int ai = 0; ai < 2; ++ai)
#pragma unroll
            for (int m = 0; m < 4; ++m) {
                const int grow = row_base + u.pm * 256 + ai * 128 + wr * 64 + m * 16 + fr;
                const bool ok = grow < MREAL;
                float ss = 0.f;
                if (ok) {
                    const float* src; float* dst;
                    if (grow < ROWS_P) { src = srcA + (size_t)grow * DM; dst = dstMain + (size_t)grow * DM; }
                    else if (grow < ROWS_MAIN) { src = srcB + (size_t)(grow - ROWS_P) * DM; dst = dstMain + (size_t)grow * DM; }
                    else { const int mr = grow - ROWS_MAIN; src = srcM + (size_t)(mr & meta_mask) * DM; dst = dstM + (size_t)mr * DM; }
#pragma unroll
                    for (int bj = 0; bj < 2; ++bj) {
                        const int col0 = u.pn * 256 + bj * 128 + wc * 32 + 8 * fq;
                        const f32x4 h0 = *(const f32x4*)(src + col0) + acc[ai][bj][m][0];
                        const f32x4 h1 = *(const f32x4*)(src + col0 + 4) + acc[ai][bj][m][1];
                        *(f32x4*)(dst + col0) = h0; *(f32x4*)(dst + col0 + 4) = h1;
                        if (P) { u32x4 w; w.x = cvtpk(h0[0], h0[1]); w.y = cvtpk(h0[2], h0[3]); w.z = cvtpk(h1[0], h1[1]); w.w = cvtpk(h1[2], h1[3]);
                            *(u32x4*)(P + (size_t)grow * DM + col0) = w; }
                        ss += (h0[0] * h0[0] + h0[1] * h0[1]) + (h0[2] * h0[2] + h0[3] * h0[3]) + (h1[0] * h1[0] + h1[1] * h1[1]) + (h1[2] * h1[2] + h1[3] * h1[3]);
                    }
                }
                ss += __shfl_xor(ss, 16); ss += __shfl_xor(ss, 32);
                if (ok && fq == 0 && rowss_next) atomicAdd(rowss_next + grow, (u64)(ss * SS_SCALE));
            }
    }
};

struct EpiPartial {
    static constexpr bool PERM = true, SWAP = true;
    float* PART;
    __device__ __forceinline__ void operator()(const f32x4 (&acc)[2][2][4][2], const pg8::Unit& u, int wr, int wc, int fr, int fq) const {
#pragma unroll
        for (int ai = 0; ai < 2; ++ai)
#pragma unroll
            for (int m = 0; m < 4; ++m) {
                const int lrow = u.pm * 256 + ai * 128 + wr * 64 + m * 16 + fr;
                float* dst = PART + ((size_t)u.ks * 512 + lrow) * DM + u.pn * 256 + wc * 32 + 8 * fq;
#pragma unroll
                for (int bj = 0; bj < 2; ++bj) { *(f32x4*)(dst + bj * 128) = acc[ai][bj][m][0]; *(f32x4*)(dst + bj * 128 + 4) = acc[ai][bj][m][1]; }
            }
    }
};
constexpr int DOWN_KS = 16;
__device__ __forceinline__ void meta_reduce(const float* PART, float* metah, bf16_t* P, u64* rowss_next, int gw, int NGW, int lane) {
    for (int lrow = gw; lrow < MREAL - ROWS_MAIN; lrow += NGW) {
        float ss = 0.f;
#pragma unroll
        for (int k = 0; k < 4; ++k) {
            const int col = k * 256 + lane * 4;
            f32x4 sum = *(const f32x4*)(metah + (size_t)lrow * DM + col);
#pragma unroll
            for (int ks = 0; ks < DOWN_KS; ++ks) sum += *(const f32x4*)(PART + ((size_t)ks * 512 + lrow) * DM + col);
            *(f32x4*)(metah + (size_t)lrow * DM + col) = sum;
            if (P) { u32x2 pk; pk.x = cvtpk(sum[0], sum[1]); pk.y = cvtpk(sum[2], sum[3]); *(u32x2*)(P + (size_t)(ROWS_MAIN + lrow) * DM + col) = pk; }
            ss += (sum[0] * sum[0] + sum[1] * sum[1]) + (sum[2] * sum[2] + sum[3] * sum[3]);
        }
        ss = wave_sum(ss);
        if (lane == 0 && rowss_next) rowss_next[ROWS_MAIN + lrow] = (u64)(ss * SS_SCALE);
    }
}

__device__ __forceinline__ void transpose_item(const float* W, const float* gain, int K, int N, bf16_t* WT, LAS float* scr, int item, int lane) {
    const int nblk = N / 32, kb = item / nblk, nb = item % nblk, k0 = 64 * kb, n0 = 32 * nb;
    {
        const int kr = lane >> 3, n4 = (lane & 7) * 4;
        f32x4 wv[8]; float gv[8];
#pragma unroll
        for (int i = 0; i < 8; ++i) { wv[i] = *(const f32x4*)(W + (size_t)(k0 + 8 * i + kr) * N + n0 + n4); gv[i] = gain ? gain[k0 + 8 * i + kr] : 1.0f; }
#pragma unroll
        for (int i = 0; i < 8; ++i) { LAS float* d = scr + (8 * i + kr) * 33 + n4; const f32x4 v = wv[i] * gv[i]; d[0] = v[0]; d[1] = v[1]; d[2] = v[2]; d[3] = v[3]; }
    }
    asm volatile("s_waitcnt lgkmcnt(0)" ::: "memory");
    const int c = lane & 7;
#pragma unroll
    for (int j = 0; j < 4; ++j) { const int n = (lane >> 3) + 8 * j; const LAS float* s = scr + (8 * c) * 33 + n;
        u32x4 o; o.x = cvtpk(s[0 * 33], s[1 * 33]); o.y = cvtpk(s[2 * 33], s[3 * 33]); o.z = cvtpk(s[4 * 33], s[5 * 33]); o.w = cvtpk(s[6 * 33], s[7 * 33]);
        *(u32x4*)(WT + (size_t)(n0 + n) * K + k0 + 8 * c) = o; }
    asm volatile("s_waitcnt lgkmcnt(0)" ::: "memory");
}
__device__ __forceinline__ void convert_matrix(const float* W, const float* gain, int K, int N, bf16_t* WT, LAS float* scr, int gw, int NGW, int lane) {
    const int nitems = (K / 64) * (N / 32);
    for (int it = gw; it < nitems; it += NGW) transpose_item(W, gain, K, N, WT, scr, it, lane);
}

__device__ __forceinline__ void h2_features(LAS unsigned char* lds, const Args& a, int j, int npr, int tid) {
    LAS float* hs = (LAS float*)lds;
    float* H2T = (float*)(a.ws + WS_H2T);
    const bool hvalid = npr < H2N;
    const int np = hvalid ? npr : H2N - 1;
    const int L = np < L_P ? L_P : L_S, n = np < L_P ? np : np - L_P;
    const float* w1 = a.in[9] + j * 33 * 64; const float* b1 = a.in[10] + j * 64; const float* fr1 = a.in[11] + j * 64;
    const float* w2 = a.in[12] + j * 64 * 64; const float* b2 = a.in[13] + j * 64; const float* fr2 = a.in[14] + j * 64;
    const float t = (float)n * (1.0f / (float)(L - 1));
    const float w = (6.283185307179586f / (float)L) * (float)n;
    float acc[64];
#pragma unroll
    for (int m = 0; m < 64; ++m) acc[m] = b1[m] + t * w1[m];
    for (int e = 0; e < 16; ++e) {
        const float f = 1e-4f + (float)e * ((15.0f - 1e-4f) / 15.0f);
        float s, c; my_sincos(f * w, s, c);
        const float* wc = w1 + (1 + e) * 64; const float* wsn = w1 + (17 + e) * 64;
#pragma unroll
        for (int m = 0; m < 64; ++m) acc[m] = fmaf(c, wc[m], fmaf(-s, wsn[m], acc[m]));
    }
#pragma unroll
    for (int m = 0; m < 64; ++m) hs[m * 64 + tid] = my_sin(fr1[m] * acc[m]);
#pragma unroll
    for (int m = 0; m < 64; ++m) acc[m] = b2[m];
    for (int e = 0; e < 64; ++e) {
        const float h = hs[e * 64 + tid]; const float* wr_ = w2 + e * 64;
#pragma unroll
        for (int m = 0; m < 64; ++m) acc[m] = fmaf(h, wr_[m], acc[m]);
    }
    if (hvalid) {
#pragma unroll
        for (int m = 0; m < 64; ++m) H2T[((size_t)j * H2N + np) * 64 + m] = my_sin(fr2[m] * acc[m]);
    }
}

__device__ __forceinline__ void split8(const f32x4 a, const f32x4 b, bf16x8& hi, bf16x8& lo) {
    u32x4 h, l;
    h.x = cvtpk(a[0], a[1]); h.y = cvtpk(a[2], a[3]); h.z = cvtpk(b[0], b[1]); h.w = cvtpk(b[2], b[3]);
    l.x = cvtpk(a[0] - bflo(h.x), a[1] - bfhi(h.x)); l.y = cvtpk(a[2] - bflo(h.y), a[3] - bfhi(h.y));
    l.z = cvtpk(b[0] - bflo(h.z), b[1] - bfhi(h.z)); l.w = cvtpk(b[2] - bflo(h.w), b[3] - bfhi(h.w));
    hi = __builtin_bit_cast(bf16x8, h); lo = __builtin_bit_cast(bf16x8, l);
}
__device__ __forceinline__ void fk_compute(const Args& a, int j, int gw, int NGW, int lane) {
    const float* H2 = (const float*)(a.ws + WS_H2T) + (size_t)j * H2N * 64;
    const float* w3 = a.in[15] + (size_t)j * 64 * 4096;
    const float* skip = a.in[16] + j * 2 * 1024;
    bf16_t* FK = (bf16_t*)(a.ws + WS_FK);
    const int n16 = lane & 15, g = lane >> 4;
#pragma unroll 1
    for (int it = gw; it < 2048; it += NGW) {
        const int pq = it & 3, cht = (it >> 2) & 63, dir = (it >> 8) & 1, o = (it >> 9) & 1, set = it >> 10;
        const int L = set ? L_S : L_P, offs = set ? FK_OFFS_S : FK_OFFS_P, len = set ? FK_LEN_S : FK_LEN_P, nbase = set ? L_P : 0;
        bf16_t* base = FK + (set ? FK_SAMPLE_OFF : 0);
        const int ch = cht * 16 + n16;
        bf16x8 Bh0, Bl0, Bh1, Bl1;
        {
            const float* wp = w3 + (o * 2 + dir) * 1024 + ch;
            f32x4 w0, w1, w2, w3v;
#pragma unroll
            for (int i = 0; i < 4; ++i) { w0[i] = wp[(size_t)(8 * g + i) * 4096]; w1[i] = wp[(size_t)(8 * g + 4 + i) * 4096];
                w2[i] = wp[(size_t)(32 + 8 * g + i) * 4096]; w3v[i] = wp[(size_t)(36 + 8 * g + i) * 4096]; }
            split8(w0, w1, Bh0, Bl0); split8(w2, w3v, Bh1, Bl1);
        }
        const float mind = -3.0701134573253944f, maxd = -15.350567286626972f;
        const float delta = fabsf(mind + (maxd - mind) * ((float)ch * (1.0f / 1023.0f)));
        const float skipv = skip[o * 1024 + ch];
        const float tinv = 1.0f / (float)(L - 1);
        bf16_t* rowp = base + ((size_t)o * 1024 + ch) * len;
        const int tq = offs / 64;
#pragma unroll 2
        for (int tile = pq * tq; tile < (pq + 1) * tq; ++tile) {
            const int n0 = tile * 16 + dir;
            const int nr = n0 + n16, nrc = nr < L ? nr : L - 1;
            const float* hp = H2 + (size_t)(nbase + nrc) * 64 + 8 * g;
            const f32x4 h0 = *(const f32x4*)hp, h1 = *(const f32x4*)(hp + 4), h2 = *(const f32x4*)(hp + 32), h3 = *(const f32x4*)(hp + 36);
            bf16x8 Ah0, Al0, Ah1, Al1; split8(h0, h1, Ah0, Al0); split8(h2, h3, Ah1, Al1);
            f32x4 acc = (f32x4){0.f, 0.f, 0.f, 0.f};
            acc = __builtin_amdgcn_mfma_f32_16x16x32_bf16(Al0, Bh0, acc, 0, 0, 0);
            acc = __builtin_amdgcn_mfma_f32_16x16x32_bf16(Al1, Bh1, acc, 0, 0, 0);
            acc = __builtin_amdgcn_mfma_f32_16x16x32_bf16(Ah0, Bl0, acc, 0, 0, 0);
            acc = __builtin_amdgcn_mfma_f32_16x16x32_bf16(Ah1, Bl1, acc, 0, 0, 0);
            acc = __builtin_amdgcn_mfma_f32_16x16x32_bf16(Ah0, Bh0, acc, 0, 0, 0);
            acc = __builtin_amdgcn_mfma_f32_16x16x32_bf16(Ah1, Bh1, acc, 0, 0, 0);
            float v[4];
#pragma unroll
            for (int ii = 0; ii < 4; ++ii) {
                const int n = n0 + 4 * g + ii;
                float x = acc[ii] * __expf(-((float)n * tinv) * delta);
                if (dir == 0 && n == 0) x += skipv;
                v[ii] = n < L ? x : 0.f;
            }
            u32x2 pk;
            if (dir == 0) { pk.x = cvtpk(v[0], v[1]); pk.y = cvtpk(v[2], v[3]); *(u32x2*)(rowp + offs + n0 + 4 * g) = pk; }
            else { pk.x = cvtpk(v[3], v[2]); pk.y = cvtpk(v[1], v[0]); *(u32x2*)(rowp + offs - (n0 + 4 * g + 3)) = pk; }
        }
    }
}

__device__ __forceinline__ u32x2 cld8(const void* p) { u32x2 v; asm volatile("global_load_dwordx2 %0, %1, off sc0 sc1\n\ts_waitcnt vmcnt(0)" : "=v"(v) : "v"(p) : "memory"); return v; }
__device__ __forceinline__ u32x4 cld16(const void* p) { u32x4 v; asm volatile("global_load_dwordx4 %0, %1, off sc0 sc1\n\ts_waitcnt vmcnt(0)" : "=v"(v) : "v"(p) : "memory"); return v; }
__device__ __forceinline__ unsigned short cld2(const void* p) { unsigned v; asm volatile("global_load_ushort %0, %1, off sc0 sc1\n\ts_waitcnt vmcnt(0)" : "=v"(v) : "v"(p) : "memory"); return (unsigned short)v; }
__device__ __forceinline__ f32x4 gate4(const bf16_t* xrow, int m, int L, float w0, float w1, float w2, float bb) {
    const u32x2 raw = *(const u32x2*)(xrow + m);
    const float x0 = bflo(raw.x), x1 = bfhi(raw.x), x2 = bflo(raw.y), x3 = bfhi(raw.y);
    const float xm = m > 0 ? bf2f(xrow[m - 1]) : 0.f, xp = (m + 4 < L) ? bf2f(xrow[m + 4]) : 0.f;
    f32x4 r;
    r[0] = w0 * xm + w1 * x0 + w2 * x1 + bb; r[1] = w0 * x0 + w1 * x1 + w2 * x2 + bb;
    r[2] = w0 * x1 + w1 * x2 + w2 * x3 + bb; r[3] = w0 * x2 + w1 * x3 + w2 * xp + bb;
    return r;
}
struct GateRaw { u32x2 raw; unsigned halo; };
__device__ __forceinline__ GateRaw gate_load(const bf16_t* xrow, int m, int L) {
    GateRaw r; r.raw = *(const u32x2*)(xrow + m);
    const unsigned xm = m > 0 ? (unsigned)xrow[m - 1] : 0u, xp = (m + 4 < L) ? (unsigned)xrow[m + 4] : 0u;
    r.halo = xm | (xp << 16); return r;
}
__device__ __forceinline__ f32x4 gate_eval(const GateRaw& gr, float w0, float w1, float w2, float bb) {
    const float x0 = bflo(gr.raw.x), x1 = bfhi(gr.raw.x), x2 = bflo(gr.raw.y), x3 = bfhi(gr.raw.y), xm = bflo(gr.halo), xp = bfhi(gr.halo);
    f32x4 r;
    r[0] = w0 * xm + w1 * x0 + w2 * x1 + bb; r[1] = w0 * x0 + w1 * x1 + w2 * x2 + bb;
    r[2] = w0 * x1 + w1 * x2 + w2 * x3 + bb; r[3] = w0 * x2 + w1 * x3 + w2 * xp + bb;
    return r;
}
template <int NQ, int NB, int L>
__device__ __forceinline__ void conv_unit(LAS unsigned char* lds, const Args& a, int j, int seq0, int c, int tid) {
    constexpr int QS = 64, GS = QS * NQ, WS = 4 * GS, PADL = 224;
    constexpr int LS = (NQ == 4) ? LS_P : LS_S;
    constexpr int LPD = (NQ == 4) ? 8720 : 4616;
    constexpr int OFFS = (NQ == 4) ? FK_OFFS_P : FK_OFFS_S, LEN = (NQ == 4) ? FK_LEN_P : FK_LEN_S;
    constexpr int S_LO = -QS * (NQ - 1), S_HI = ((L - 1) / 32) * 32;
    constexpr int U_OFF = 0, FKL_OFF = 77824, RED_OFF = 112640;
    static_assert(NB * LPD * 2 <= FKL_OFF && FKL_OFF + LEN * 2 <= RED_OFF, "conv LDS map");
    const int lane = tid & 63, w = __builtin_amdgcn_readfirstlane(tid >> 6);
    const bf16_t* X1 = (const bf16_t*)(a.ws + WS_R1); const bf16_t* X2 = (const bf16_t*)(a.ws + WS_R2); bf16_t* V = (bf16_t*)(a.ws + WS_R3);
    const bf16_t* FK = (const bf16_t*)(a.ws + WS_FK) + ((NQ == 4) ? 0 : FK_SAMPLE_OFF);
    const float* cw = a.in[7] + (size_t)j * 3 * 3072; const float* cb = a.in[8] + (size_t)j * 3072;
    constexpr int NF = (LEN / 8 + 511) / 512;
    u32x4 fkr[NF];
    {
        const u32x4* src = (const u32x4*)(FK + (size_t)c * LEN);
#pragma unroll
        for (int it = 0; it < NF; ++it) { const int i = it * 512 + tid; fkr[it] = src[i < LEN / 8 ? i : 0]; }
    }
    {
        const float w0 = cw[2048 + c], w1 = cw[3072 + 2048 + c], w2 = cw[2 * 3072 + 2048 + c], bb = cb[2048 + c];
        constexpr int NCH = LPD / 8, NIT = (NB * NCH + 511) / 512;
        u32x4 raws[NIT]; unsigned halos[NIT];
#pragma unroll
        for (int it = 0; it < NIT; ++it) {
            const int idx = it * 512 + tid; const int b = idx / NCH, ch = idx % NCH, p = ch * 8 - PADL;
            raws[it] = (u32x4){0u, 0u, 0u, 0u}; halos[it] = 0u;
            if (idx < NB * NCH && p >= 0 && p < L) {
                const bf16_t* row = V + seq_off_ch(seq0 + b) + (size_t)c * LS + XPAD + p;
                raws[it] = *(const u32x4*)row;
                const unsigned xm = p > 0 ? (unsigned)row[-1] : 0u, xp = (p + 8 < L) ? (unsigned)row[8] : 0u;
                halos[it] = xm | (xp << 16);
            }
        }
#pragma unroll
        for (int it = 0; it < NIT; ++it) {
            const int idx = it * 512 + tid; const int b = idx / NCH, ch = idx % NCH, p = ch * 8 - PADL;
            u32x4 o = {0u, 0u, 0u, 0u};
            if (p >= 0 && p < L) {
                const u32x4 raw = raws[it];
                float x[10];
                x[0] = bflo(halos[it]); x[9] = bfhi(halos[it]);
                x[1] = bflo(raw.x); x[2] = bfhi(raw.x); x[3] = bflo(raw.y); x[4] = bfhi(raw.y); x[5] = bflo(raw.z); x[6] = bfhi(raw.z); x[7] = bflo(raw.w); x[8] = bfhi(raw.w);
                float y[8];
#pragma unroll
                for (int i = 0; i < 8; ++i) y[i] = w0 * x[i] + w1 * x[i + 1] + w2 * x[i + 2] + bb;
                o.x = cvtpk(y[0], y[1]); o.y = cvtpk(y[2], y[3]); o.z = cvtpk(y[4], y[5]); o.w = cvtpk(y[6], y[7]);
            }
            if (idx < NB * NCH) *(LAS u32x4*)(lds + U_OFF + (b * LPD + ch * 8) * 2) = o;
        }
    }
    const int n = lane & 15, g = lane >> 4;
    const int q = (NQ == 4) ? (n >> 2) : (n >> 3), b = (NQ == 4) ? (n & 3) : (n & 7);
    const int ub = U_OFF + (b * LPD + PADL + QS * q + 8 * g) * 2;
    const int ubm = U_OFF + (b * LPD + PADL + 8 * g) * 2;
    const int pe = (1 + n) & 1;
    const int abr = FKL_OFF + (LEN - 1 - OFFS - n + 8 * g - pe) * 2;
    const unsigned sh = pe * 16;
    const int mw = 16 + WS * w;
    const int d_lo = mw - S_HI, d_hi = mw + 3 * GS - S_LO;
    const size_t xrow_off = seq_off_ch(seq0 + b) + (size_t)c * LS + XPAD;
#define ARAW(d, lagoff) do { const LAS unsigned* _p = (const LAS unsigned*)(lds + abr - (lagoff) * 2); d[0] = _p[0]; d[1] = _p[1]; d[2] = _p[2]; d[3] = _p[3]; d[4] = _p[4]; } while (0)
#define AFIN(dst, d) do { u32x4 _o; _o.x = __builtin_amdgcn_alignbit(d[1], d[0], sh); _o.y = __builtin_amdgcn_alignbit(d[2], d[1], sh); \
        _o.z = __builtin_amdgcn_alignbit(d[3], d[2], sh); _o.w = __builtin_amdgcn_alignbit(d[4], d[3], sh); dst = __builtin_bit_cast(bf16x8, _o); } while (0)
#define GATHER(dst, lagoff) do { unsigned _d[5]; ARAW(_d, lagoff); AFIN(dst, _d); } while (0)
#pragma unroll 1
    for (int o = 0; o < 2; ++o) {
#pragma unroll
        for (int it = 0; it < NF; ++it) { const int i = it * 512 + tid; const u32x4 v = fkr[it]; u32x4 r;
            r.x = __builtin_amdgcn_alignbit(v.w, v.w, 16); r.y = __builtin_amdgcn_alignbit(v.z, v.z, 16);
            r.z = __builtin_amdgcn_alignbit(v.y, v.y, 16); r.w = __builtin_amdgcn_alignbit(v.x, v.x, 16);
            if (i < LEN / 8) *(LAS u32x4*)(lds + FKL_OFF + (LEN / 8 - 1 - i) * 16) = r; }
        __syncthreads();
        if (o == 0) {
            const u32x4* src = (const u32x4*)(FK + ((size_t)1024 + c) * LEN);
#pragma unroll
            for (int it = 0; it < NF; ++it) { const int i = it * 512 + tid; fkr[it] = src[i < LEN / 8 ? i : 0]; }
        }
        f32x4 acc[4][4];
#pragma unroll
        for (int gi = 0; gi < 4; ++gi)
#pragma unroll
            for (int t = 0; t < 4; ++t) acc[gi][t] = (f32x4){0.f, 0.f, 0.f, 0.f};
        bf16x8 A0, A1, A2, A3, Bc[4], Bn[4];
        GATHER(A0, d_lo); GATHER(A1, d_lo + 16); GATHER(A2, d_lo + 32); GATHER(A3, d_lo + 48);
        int baddr = ub + 2 * (mw - d_lo);
#pragma unroll
        for (int gi = 0; gi < 4; ++gi) Bc[gi] = *(const LAS bf16x8*)(lds + baddr + 2 * GS * gi);
#define CONV_STEP(BCUR, BNXT, DL, CHECK) do { \
            unsigned r2[5], r3[5]; ARAW(r2, (DL) + 64); ARAW(r3, (DL) + 80); \
            baddr -= 64; \
            _Pragma("unroll") for (int gi = 0; gi < 4; ++gi) BNXT[gi] = *(const LAS bf16x8*)(lds + baddr + 2 * GS * gi); \
            __builtin_amdgcn_s_setprio(1); \
            _Pragma("unroll") for (int gi = 0; gi < 4; ++gi) { \
                const int s0 = mw + GS * gi - (DL); \
                if (!(CHECK) || ((s0 >= S_LO) && (s0 <= S_HI))) { \
                    acc[gi][0] = __builtin_amdgcn_mfma_f32_16x16x32_bf16(A0, BCUR[gi], acc[gi][0], 0, 0, 0); \
                    acc[gi][1] = __builtin_amdgcn_mfma_f32_16x16x32_bf16(A1, BCUR[gi], acc[gi][1], 0, 0, 0); \
                    acc[gi][2] = __builtin_amdgcn_mfma_f32_16x16x32_bf16(A2, BCUR[gi], acc[gi][2], 0, 0, 0); \
                    acc[gi][3] = __builtin_amdgcn_mfma_f32_16x16x32_bf16(A3, BCUR[gi], acc[gi][3], 0, 0, 0); \
                } \
            } \
            __builtin_amdgcn_s_setprio(0); \
            A0 = A2; A1 = A3; AFIN(A2, r2); AFIN(A3, r3); } while (0)
        const int dl_a = mw + 3 * GS - S_HI, dl_b = mw - S_LO;
        static_assert(((3 * GS / 32) % 2 == 0) && (((S_HI - S_LO - 3 * GS) / 32 + 1) % 2 == 1), "conv step-count parity");
#pragma unroll 1
        for (int dl = d_lo; dl < dl_a; dl += 64) { CONV_STEP(Bc, Bn, dl, true); CONV_STEP(Bn, Bc, dl + 32, true); }
#pragma unroll 1
        for (int dl = dl_a; dl < dl_b; dl += 64) { CONV_STEP(Bc, Bn, dl, false); CONV_STEP(Bn, Bc, dl + 32, false); }
        CONV_STEP(Bc, Bn, dl_b, false);
#pragma unroll 1
        for (int dl = dl_b + 32; dl <= d_hi; dl += 64) { CONV_STEP(Bn, Bc, dl, true); CONV_STEP(Bc, Bn, dl + 32, true); }
#undef CONV_STEP
        const bf16_t* X = (o == 0 ? X1 : X2) + xrow_off;
        const float w0 = cw[o * 1024 + c], w1 = cw[3072 + o * 1024 + c], w2 = cw[2 * 3072 + o * 1024 + c], bb = cb[o * 1024 + c];
        GateRaw gt[4][4];
        {
            const int mb = mw + QS * q + 4 * g; const bf16_t* Xb = X + mb;
#pragma unroll
            for (int gi = 0; gi < 4; ++gi)
#pragma unroll
                for (int t = 0; t < 4; ++t) { constexpr int dummy = 0; (void)dummy; const int off = GS * gi + 16 * t;
                    GateRaw r; r.raw = *(const u32x2*)(Xb + off);
                    const unsigned xm = (unsigned)Xb[off - 1]; unsigned xp = (unsigned)Xb[off + 4];
                    if (mb + off + 4 >= L) xp = 0u;
                    r.halo = xm | (xp << 16); gt[gi][t] = r; }
        }
        const GateRaw gtm = gate_load(X, 4 * g, L);
        f32x4 macc = (f32x4){0.f, 0.f, 0.f, 0.f};
#pragma unroll 1
        for (int t = w; t <= S_HI / 32; t += 8) {
            bf16x8 Am; GATHER(Am, -32 * t);
            const bf16x8 B = *(const LAS bf16x8*)(lds + ubm + t * 64);
            macc = __builtin_amdgcn_mfma_f32_16x16x32_bf16(Am, B, macc, 0, 0, 0);
        }
        *(LAS f32x4*)(lds + RED_OFF + (w * 64 + lane) * 16) = macc;
        __syncthreads();
        if (w == 0 && q == 0) {
            f32x4 s = (f32x4){0.f, 0.f, 0.f, 0.f};
#pragma unroll
            for (int ww = 0; ww < 8; ++ww) s += *(const LAS f32x4*)(lds + RED_OFF + (ww * 64 + lane) * 16);
            const int m = 4 * g;
            const f32x4 z = gate_eval(gtm, w0, w1, w2, bb) * s;
            u32x2 pk; pk.x = cvtpk(z[0], z[1]); pk.y = cvtpk(z[2], z[3]);
            if (o == 0) *(LAS u32x2*)(lds + U_OFF + (b * LPD + PADL + m) * 2) = pk;
            else *(u32x2*)(V + xrow_off + m) = pk;
        }
#pragma unroll
        for (int gi = 0; gi < 4; ++gi)
#pragma unroll
            for (int t = 0; t < 4; ++t) {
                const int m = mw + GS * gi + 16 * t + QS * q + 4 * g;
                const f32x4 z = gate_eval(gt[gi][t], w0, w1, w2, bb) * acc[gi][t];
                u32x2 pk; pk.x = cvtpk(z[0], z[1]); pk.y = cvtpk(z[2], z[3]);
                if (o == 0) *(LAS u32x2*)(lds + U_OFF + (b * LPD + PADL + m) * 2) = pk;
                else *(u32x2*)(V + xrow_off + m) = pk;
            }
        __syncthreads();
    }
#undef GATHER
#undef ARAW
#undef AFIN
}
__device__ __forceinline__ void conv_phase(LAS unsigned char* lds, const Args& a, int j, int bid, int G, int tid) {
#pragma unroll 1
    for (int u0 = bid; u0 < 3072; u0 += G) {
        const int u = u0;
        int tl = tid; asm volatile("" : "+v"(tl));
        if (u < 1024) conv_unit<4, 4, L_P>(lds, a, j, 0, u, tl);
        else { const int v = u - 1024; conv_unit<2, 8, L_S>(lds, a, j, 4 + 8 * (v & 1), v >> 1, tl); }
    }
}

__device__ __forceinline__ void transpose_phase(LAS unsigned char* lds, const Args& a, int bid, int G, int tid) {
    const bf16_t* ZT = (const bf16_t*)(a.ws + WS_R3); bf16_t* OUT = (bf16_t*)(a.ws + WS_R1);
    constexpr int TP = 129, TS = 65, UP = 4 * TP * 4, US = 16 * TS * 4, TILEB = 256 * 72 * 2;
#define TR_DECODE(u, s, p0, np, c0) do { int _cq, _tt; if ((u) < UP) { _cq = (u) & 3; const int _v = (u) >> 2; s = _v / TP; _tt = _v % TP; } \
        else { const int _r = (u) - UP; _cq = _r & 3; const int _v = _r >> 2; s = 4 + _v / TS; _tt = _v % TS; } \
        p0 = _tt == 0 ? 0 : 16 + 64 * (_tt - 1); np = _tt == 0 ? 16 : 64; c0 = _cq * 256; } while (0)
#define TR_LOAD(u) do { int _s, _p0, _np, _c0; TR_DECODE(u, _s, _p0, _np, _c0); const int _LS = seq_LS(_s), _nq = _np / 4; \
        const bf16_t* _src = ZT + seq_off_ch(_s) + (size_t)_c0 * _LS + XPAD + _p0; \
        _Pragma("unroll") for (int _k = 0; _k < 8; ++_k) { const int _task = _k * 512 + tid; const int _ch = _task / _nq, _pc = _task % _nq; \
            rg[_k] = (_task < 256 * _nq) ? *(const u32x2*)(_src + (size_t)_ch * _LS + 4 * _pc) : (u32x2){0u, 0u}; } } while (0)
    u32x2 rg[8];
    int u = bid, par = 0;
    if (u < UP + US) TR_LOAD(u);
#pragma unroll 1
    for (; u < UP + US; u += G, par ^= 1) {
        int s, p0, np, c0; TR_DECODE(u, s, p0, np, c0);
        const int nq = np / 4; LAS unsigned char* tile = lds + par * TILEB;
#pragma unroll
        for (int k = 0; k < 8; ++k) { const int task = k * 512 + tid; const int ch = task / nq, pc = task % nq;
            if (task < 256 * nq) *(LAS u32x2*)(tile + (ch * 72 + 4 * pc) * 2) = rg[k]; }
        __syncthreads();
        if (u + G < UP + US) TR_LOAD(u + G);
        for (int task = tid; task < np * 32; task += 512) { const int pos = task % np, cc = task / np;
            const LAS unsigned short* t = (const LAS unsigned short*)(tile + ((8 * cc) * 72 + pos) * 2);
            u32x4 o; o.x = (unsigned)t[0] | ((unsigned)t[72] << 16); o.y = (unsigned)t[144] | ((unsigned)t[216] << 16);
            o.z = (unsigned)t[288] | ((unsigned)t[360] << 16); o.w = (unsigned)t[432] | ((unsigned)t[504] << 16);
            *(u32x4*)(OUT + (size_t)seq_row(s, p0 + pos) * DM + c0 + 8 * cc) = o; }
    }
    __syncthreads();
#undef TR_DECODE
#undef TR_LOAD
}

__device__ __forceinline__ void attn_qfrag(const u32x4 r0, const u32x4 r1, const float* qg, int g, bf16x8& qf0, bf16x8& qf1) {
    float x[16] = {bflo(r0.x), bfhi(r0.x), bflo(r0.y), bfhi(r0.y), bflo(r0.z), bfhi(r0.z), bflo(r0.w), bfhi(r0.w),
                   bflo(r1.x), bfhi(r1.x), bflo(r1.y), bfhi(r1.y), bflo(r1.z), bfhi(r1.z), bflo(r1.w), bfhi(r1.w)};
    float ss = 0.f;
#pragma unroll
    for (int i = 0; i < 16; ++i) ss += x[i] * x[i];
    ss += __shfl_xor(ss, 16); ss += __shfl_xor(ss, 32);
    const float ri = __builtin_amdgcn_rsqf(ss * (1.0f / 64.0f) + EPS) * (0.125f * 1.4426950408889634f);
    const f32x4 ga = *(const f32x4*)(qg + 8 * g), gb = *(const f32x4*)(qg + 8 * g + 4), gc = *(const f32x4*)(qg + 32 + 8 * g), gd = *(const f32x4*)(qg + 36 + 8 * g);
    u32x4 p0, p1;
    p0.x = cvtpk(x[0] * ri * ga[0], x[1] * ri * ga[1]); p0.y = cvtpk(x[2] * ri * ga[2], x[3] * ri * ga[3]);
    p0.z = cvtpk(x[4] * ri * gb[0], x[5] * ri * gb[1]); p0.w = cvtpk(x[6] * ri * gb[2], x[7] * ri * gb[3]);
    p1.x = cvtpk(x[8] * ri * gc[0], x[9] * ri * gc[1]); p1.y = cvtpk(x[10] * ri * gc[2], x[11] * ri * gc[3]);
    p1.z = cvtpk(x[12] * ri * gd[0], x[13] * ri * gd[1]); p1.w = cvtpk(x[14] * ri * gd[2], x[15] * ri * gd[3]);
    qf0 = __builtin_bit_cast(bf16x8, p0); qf1 = __builtin_bit_cast(bf16x8, p1);
}
__device__ __forceinline__ bf16x8 attn_scores(const f32x4 s0, const f32x4 s1, const LAS float* bt, int cs, bool interior, bool metal, int g, int qpos, int L, float& den) {
    float p[8];
    if (interior) {
#pragma unroll
        for (int e = 0; e < 8; ++e) { const float sv = e < 4 ? s0[e & 3] : s1[e & 3]; p[e] = __builtin_amdgcn_exp2f(sv + bt[cs + e]); den += p[e]; }
    } else {
#pragma unroll
        for (int e = 0; e < 8; ++e) {
            const float sv = e < 4 ? s0[e & 3] : s1[e & 3];
            const int relb = cs + e, pos = relb + qpos;
            const int relm = 8 * g + e - qpos;
            const bool bvalid = ((unsigned)(relb + 128) <= 256u) && ((unsigned)(pos - 16) < (unsigned)(L - 16));
            const int rel = metal ? relm : relb;
            const bool valid = metal || bvalid;
            const int relc = rel < -128 ? -128 : (rel > 128 ? 128 : rel);
            const float val = __builtin_amdgcn_exp2f(sv + bt[relc]);
            p[e] = valid ? val : 0.f;
            den += p[e];
        }
    }
    u32x4 pp; pp.x = cvtpk(p[0], p[1]); pp.y = cvtpk(p[2], p[3]); pp.z = cvtpk(p[4], p[5]); pp.w = cvtpk(p[6], p[7]);
    return __builtin_bit_cast(bf16x8, pp);
}
__device__ __forceinline__ void attn_store(const f32x4 (&oacc)[4], float den, float sk, float shift, bf16_t* O, int seq, int q0, int g, int r, int head) {
    den += __shfl_xor(den, 16); den += __shfl_xor(den, 32);
    den += __builtin_amdgcn_exp2f((sk - shift) * 1.4426950408889634f);
    const float inv = 1.0f / den;
#pragma unroll
    for (int ii = 0; ii < 4; ++ii) {
        const float iv = __shfl(inv, 4 * g + ii);
        bf16_t* op = O + (size_t)seq_row(seq, q0 + 4 * g + ii) * DM + head * 64 + r;
#pragma unroll
        for (int dt = 0; dt < 4; ++dt) op[dt * 16] = (bf16_t)(cvtpk(oacc[dt][ii] * iv, 0.f) & 0xffffu);
    }
}
__device__ __forceinline__ void attn_phase(LAS unsigned char* lds, const Args& a, int j, int bid, int G, int tid) {
    constexpr int KN_OFF = 0, KSTR = 144, VT_OFF = 59904, VSTR = 848, BT_OFF = 114176;
    const bf16_t* QK = (const bf16_t*)(a.ws + WS_R1); const bf16_t* VTg = (const bf16_t*)(a.ws + WS_VT); bf16_t* O = (bf16_t*)(a.ws + WS_R3);
    const float* rel_bias = a.in[3]; const float* qg = a.in[19] + j * 64; const float* kg = a.in[20] + j * 64; const float* sink = a.in[21] + j * 16;
    const int lane = tid & 63, w = __builtin_amdgcn_readfirstlane(tid >> 6), r = lane & 15, g = lane >> 4;
    LAS float* BT = (LAS float*)(lds + BT_OFF);
    if (tid < 64) { float mq = fabsf(qg[tid]), mk = fabsf(kg[tid]);
#pragma unroll
        for (int o = 1; o < 64; o <<= 1) { mq = fmaxf(mq, __shfl_xor(mq, o)); mk = fmaxf(mk, __shfl_xor(mk, o)); }
        if (tid == 0) BT[16 * 257] = 8.0f * mq * mk; }
    __syncthreads();
    {
        const float shift0 = BT[16 * 257];
        for (int i = tid; i < 16 * 257; i += 512) { const int h = i / 257, rel = i % 257 - 128; BT[i] = (rel_bias[t5_bucket(rel) * 16 + h] - shift0) * 1.4426950408889634f; }
    }
    __syncthreads();
    constexpr int NU = (4 * 65 + 16 * 33) * 4;
    for (int u = bid; u < NU; u += G) {
        int hk, seq, qb, L;
        if (u < 3072) { hk = u & 3; int v = u >> 2;
            if (v < 256) { seq = v >> 6; qb = v & 63; L = L_P; } else { v -= 256; seq = 4 + (v >> 5); qb = v & 31; L = L_S; } }
        else { const int t = u - 3072; hk = t & 3; seq = t >> 2; if (seq < 4) { qb = 64; L = L_P; } else { qb = 32; L = L_S; } }
        const int start = qb * 128 - 128;
        {
            const bf16_t* vb = VTg + seq_off_ch(seq) / 4 + (size_t)(hk * 64) * seq_LS(seq) + XPAD;
            const int LS = seq_LS(seq);
            u32x4 kraw[7], vraw[7];
#pragma unroll
            for (int it = 0; it < 7; ++it) {
                const int idx = it * 512 + tid;
                { const int slot = idx >> 3, dc = idx & 7; const int pos = slot < 16 ? slot : start + slot - 16;
                  const bool valid = (idx < 416 * 8) && (slot < 16 || (slot < 400 && pos >= 16 && pos < L));
                  kraw[it] = (u32x4){0u, 0u, 0u, 0u};
                  if (valid) kraw[it] = *(const u32x4*)(QK + (size_t)seq_row(seq, pos) * 1280 + 1024 + hk * 64 + dc * 8); }
                { const int d = idx / 52, c8 = idx % 52; const int pos0 = c8 < 2 ? 8 * c8 : start + 8 * c8 - 16;
                  const bool valid = (idx < 64 * 52) && (c8 < 2 || (c8 < 50 && pos0 >= 16 && pos0 < L));
                  vraw[it] = (u32x4){0u, 0u, 0u, 0u};
                  if (valid) vraw[it] = *(const u32x4*)(vb + (size_t)d * LS + pos0); }
            }
#pragma unroll
            for (int it = 0; it < 7; ++it) {
                const int idx = it * 512 + tid;
                const int slot = idx >> 3, dc = idx & 7;
                const u32x4 raw = kraw[it];
                float x[8] = {bflo(raw.x), bfhi(raw.x), bflo(raw.y), bfhi(raw.y), bflo(raw.z), bfhi(raw.z), bflo(raw.w), bfhi(raw.w)};
                float ss = 0.f;
#pragma unroll
                for (int i = 0; i < 8; ++i) ss += x[i] * x[i];
                ss += __shfl_xor(ss, 1); ss += __shfl_xor(ss, 2); ss += __shfl_xor(ss, 4);
                const float ri = __builtin_amdgcn_rsqf(ss * (1.0f / 64.0f) + EPS);
                const f32x4 g0 = *(const f32x4*)(kg + dc * 8), g1 = *(const f32x4*)(kg + dc * 8 + 4);
                u32x4 o; o.x = cvtpk(x[0] * ri * g0[0], x[1] * ri * g0[1]); o.y = cvtpk(x[2] * ri * g0[2], x[3] * ri * g0[3]);
                o.z = cvtpk(x[4] * ri * g1[0], x[5] * ri * g1[1]); o.w = cvtpk(x[6] * ri * g1[2], x[7] * ri * g1[3]);
                if (idx < 416 * 8) *(LAS u32x4*)(lds + KN_OFF + slot * KSTR + dc * 16) = o;
                const int d = idx / 52, c8 = idx % 52;
                if (idx < 64 * 52) *(LAS u32x4*)(lds + VT_OFF + d * VSTR + c8 * 16) = vraw[it];
            }
        }
        __syncthreads();
        const int q0 = qb * 128 + 16 * w;
        if (q0 < L) {
            const int qpos = q0 + r;
            const int fb = (16 + 16 * w) >> 5, cb = fb < 1 ? 1 : fb;
            const bf16_t* qrow = QK + (size_t)seq_row(seq, qpos) * 1280 + hk * 256;
            const float shift = BT[16 * 257];
            const int lkoff = KN_OFF + (8 * (r >> 2) + (r & 3)) * KSTR + 16 * g;
            const int lvoff = VT_OFF + r * VSTR + 16 * g;
            const int lb = 8 * g - r;
            {
                bf16x8 qf0[4], qf1[4]; const LAS float* bt[4]; float den[4]; f32x4 oh[4][4];
#pragma unroll
                for (int h = 0; h < 4; ++h) {
                    const bf16_t* qa = qrow + h * 64;
                    const u32x4 a0 = *(const u32x4*)(qa + 8 * g), a1 = *(const u32x4*)(qa + 32 + 8 * g);
                    attn_qfrag(a0, a1, qg, g, qf0[h], qf1[h]);
                    bt[h] = BT + (hk * 4 + h) * 257 + 128; den[h] = 0.f;
#pragma unroll
                    for (int dt = 0; dt < 4; ++dt) oh[h][dt] = (f32x4){0.f, 0.f, 0.f, 0.f};
                }
#pragma unroll 1
                for (int i = 0; i < 10; ++i) {
                    const int chunk = i == 0 ? 0 : cb + i - 1;
                    const int kb = lkoff + 32 * chunk * KSTR;
                    const bf16x8 k00 = *(const LAS bf16x8*)(lds + kb), k01 = *(const LAS bf16x8*)(lds + kb + 64);
                    const bf16x8 k10 = *(const LAS bf16x8*)(lds + kb + 4 * KSTR), k11 = *(const LAS bf16x8*)(lds + kb + 4 * KSTR + 64);
                    const f32x4 z4 = (f32x4){0.f, 0.f, 0.f, 0.f};
                    f32x4 s0[4], s1[4];
#pragma unroll
                    for (int h = 0; h < 4; ++h) { s0[h] = __builtin_amdgcn_mfma_f32_16x16x32_bf16(k00, qf0[h], z4, 0, 0, 0); s1[h] = __builtin_amdgcn_mfma_f32_16x16x32_bf16(k10, qf0[h], z4, 0, 0, 0); }
#pragma unroll
                    for (int h = 0; h < 4; ++h) { s0[h] = __builtin_amdgcn_mfma_f32_16x16x32_bf16(k01, qf1[h], s0[h], 0, 0, 0); s1[h] = __builtin_amdgcn_mfma_f32_16x16x32_bf16(k11, qf1[h], s1[h], 0, 0, 0); }
                    const int cs = start - 16 - q0 + 32 * chunk + lb;
                    const int pmin = start + 32 * chunk - 16;
                    const bool interior = (chunk > 0) && (pmin >= q0 + 15 - 128) && (pmin + 31 <= q0 + 128) && (pmin >= 16) && (pmin + 31 < L);
                    const bool metal = (chunk == 0) && (g < 2);
                    bf16x8 pa[4];
#pragma unroll
                    for (int h = 0; h < 4; ++h) pa[h] = attn_scores(s0[h], s1[h], bt[h], cs, interior, metal, g, qpos, L, den[h]);
                    const int vbo = lvoff + 64 * chunk;
#pragma unroll
                    for (int dt = 0; dt < 4; ++dt) {
                        const bf16x8 vb = *(const LAS bf16x8*)(lds + vbo + dt * 16 * VSTR);
#pragma unroll
                        for (int h = 0; h < 4; ++h) oh[h][dt] = __builtin_amdgcn_mfma_f32_16x16x32_bf16(pa[h], vb, oh[h][dt], 0, 0, 0);
                    }
                }
#pragma unroll
                for (int h = 0; h < 4; ++h) attn_store(oh[h], den[h], sink[hk * 4 + h], shift, O, seq, q0, g, r, hk * 4 + h);
            }
        }
        __syncthreads();
    }
}

#define XB_TMO      128
#define XB_XCNT(j)  (256  + 64 * (j))
#define XB_XSUB(j)  (1280 + 64 * (j))
#define XB_XGEN(j)  (2304 + 64 * (j))
#define XB_TOP      3328
#define XB_TOPGEN   3392
#define XCD_BAR_WORDS 3456
#define XB_SPIN_CAP (1u << 18)

__device__ __forceinline__ unsigned xb_ld(unsigned* p)              { return __hip_atomic_load(p, __ATOMIC_RELAXED, __HIP_MEMORY_SCOPE_AGENT); }
__device__ __forceinline__ unsigned xb_add(unsigned* p, unsigned v) { return __hip_atomic_fetch_add(p, v, __ATOMIC_RELAXED, __HIP_MEMORY_SCOPE_AGENT); }
__device__ __forceinline__ unsigned xb_xcc_id() { return (unsigned)__builtin_amdgcn_s_getreg((3 << 11) | 20) & 0xFu; }
#define XB_SPIN(cond, bar) do { unsigned _sp = 0; while (cond) { __builtin_amdgcn_s_sleep(1); \
    if ((++_sp & 255u) == 0u) { if (xb_ld(&(bar)[XB_TMO])) break; if (_sp > XB_SPIN_CAP) { atomicAdd(&(bar)[XB_TMO], 1u); break; } } } } while (0)

struct XcdBarrier {
    unsigned* bar; unsigned x;
    volatile LAS unsigned* st;
};

__device__ __forceinline__ XcdBarrier xcd_barrier_post(unsigned* bar, volatile LAS unsigned* st) {
    XcdBarrier b; b.bar = bar; b.x = xb_xcc_id(); b.st = st;
    if (threadIdx.x == 0) (void)xb_add(&bar[XB_XCNT(b.x)], 1u);
    return b;
}
__device__ __forceinline__ void xcd_barrier_complete(unsigned* bar, unsigned x, unsigned& nloc, unsigned& nx) {
    const unsigned G = gridDim.x * gridDim.y * gridDim.z;
    unsigned sum, cnt, mine, sp = 0u;
    for (;;) {
        sum = 0u; cnt = 0u; mine = 0u;
#pragma unroll
        for (unsigned j = 0; j < 16; ++j) { const unsigned c = xb_ld(&bar[XB_XCNT(j)]); sum += c; cnt += (c > 0u) ? 1u : 0u; mine = (j == x) ? c : mine; }
        if (sum == G) break;
        __builtin_amdgcn_s_sleep(1);
        if ((++sp & 255u) == 0u) { if (xb_ld(&bar[XB_TMO])) break; if (sp > XB_SPIN_CAP) { atomicAdd(&bar[XB_TMO], 1u); break; } }
    }
    nloc = mine > 0u ? mine : 1u; nx = cnt > 0u ? cnt : 1u;
}

__device__ __forceinline__ void xcd_barrier(const XcdBarrier& b) {
    asm volatile("s_waitcnt vmcnt(0)" ::: "memory");
    __syncthreads();
    if (threadIdx.x == 0) {
        unsigned* bar = b.bar;
        __builtin_amdgcn_s_waitcnt(0);
        unsigned nloc = b.st[0], nx = b.st[1];
        if (nloc == 0u) { xcd_barrier_complete(bar, b.x, nloc, nx); b.st[0] = nloc; b.st[1] = nx; }
        const unsigned old = xb_add(&bar[XB_XSUB(b.x)], 1u);
        const unsigned gen = old / nloc;
        if (old + 1u == (gen + 1u) * nloc) {
            __builtin_amdgcn_fence(__ATOMIC_RELEASE, "agent");
            asm volatile("s_waitcnt vmcnt(0)" ::: "memory");
            const unsigned og = xb_add(&bar[XB_TOP], 1u);
            const unsigned tg = og / nx;
            if (og + 1u == (tg + 1u) * nx) xb_add(&bar[XB_TOPGEN], 1u);
            else XB_SPIN(xb_ld(&bar[XB_TOPGEN]) == tg, bar);
            __builtin_amdgcn_fence(__ATOMIC_ACQUIRE, "agent");
            xb_add(&bar[XB_XGEN(b.x)], 1u);
            asm volatile("s_waitcnt vmcnt(0)" ::: "memory");
        } else {
            XB_SPIN(xb_ld(&bar[XB_XGEN(b.x)]) == gen, bar);
            __builtin_amdgcn_fence(__ATOMIC_ACQUIRE, "agent");
            asm volatile("s_waitcnt vmcnt(0)" ::: "memory");
        }
    }
    __syncthreads();
}

constexpr int LDS_XB_OFF = 147456 - 64;
#ifndef PHMASK
#define PHMASK 0xFFFF
#endif
#define PH(b) if constexpr ((PHMASK >> (b)) & 1)
#define GRID_SYNC() do { XcdBarrier _b; { kargs_t _p = (kargs_t)__builtin_amdgcn_kernarg_segment_ptr(); asm volatile("" : "+s"(_p)); _b.bar = (unsigned*)_p->ws; } _b.x = xb_xcc_id(); _b.st = (volatile LAS unsigned*)(lds + LDS_XB_OFF); xcd_barrier(_b); } while (0)
#define GRID_SYNC_CG() do { asm volatile("s_waitcnt vmcnt(0) lgkmcnt(0)" ::: "memory"); grid.sync(); if ((threadIdx.x >> 6) == 0) { __builtin_amdgcn_fence(__ATOMIC_ACQUIRE, "agent"); asm volatile("s_waitcnt vmcnt(0)" ::: "memory"); } __syncthreads(); } while (0)
typedef const __attribute__((address_space(4))) Args* kargs_t;
__device__ __forceinline__ Args get_args() {
    kargs_t p = (kargs_t)__builtin_amdgcn_kernarg_segment_ptr();
    asm volatile("" : "+s"(p));
    Args a;
#pragma unroll
    for (int i = 0; i < 25; ++i) a.in[i] = p->in[i];
    a.out = p->out; a.ws = p->ws; a.layer_lo = p->layer_lo; a.layer_hi = p->layer_hi;
    return a;
}
__device__ __forceinline__ EpiResid make_resid(const Args& a, int layer, int which  , int rb) {
    u64* rowss = (u64*)(a.ws + WS_ROWSS); float* metah = (float*)(a.ws + WS_METAH);
    EpiResid e;
    const bool first = (layer == 0 && which == 0);
    e.srcA = first ? a.in[0] : a.out; e.srcB = first ? a.in[1] : a.out + (size_t)ROWS_P * DM; e.srcM = first ? a.in[2] : metah; e.meta_mask = first ? 15 : 0xffff;
    e.dstMain = a.out; e.dstM = metah;
    const int nxt = 2 * layer + 1 + which;
    e.P = nxt < 8 ? (bf16_t*)(a.ws + WS_P) : nullptr; e.rowss_next = nxt < 8 ? rowss + (size_t)nxt * MPAD : nullptr; e.row_base = rb;
    return e;
}
__global__ void __launch_bounds__(512, 2) fwd_megakernel(Args a_unused) {
    extern __shared__ __attribute__((aligned(16))) unsigned char lds_raw[];
    LAS unsigned char* lds = (LAS unsigned char*)lds_raw;
    cg::grid_group grid = cg::this_grid();
    const int G0 = gridDim.x, bid0 = blockIdx.x;
    volatile LAS unsigned* xst = (volatile LAS unsigned*)(lds + LDS_XB_OFF);
    if (threadIdx.x < 2) xst[threadIdx.x] = 0u;
    __syncthreads();
    (void)xcd_barrier_post((unsigned*)a_unused.ws, xst);

    const int layer_lo = a_unused.layer_lo, layer_hi = a_unused.layer_hi;
    if (layer_lo == 0) {
        const Args a = get_args(); const int tid = ltid(), G = lsg(G0), bid = lsg(bid0);
        const int lane = tid & 63, wave = __builtin_amdgcn_readfirstlane(tid >> 6);
        const int gw = bid * 7 + wave, NGW = G * 7;
        u64* rowss = (u64*)(a.ws + WS_ROWSS);
        bf16_t* Wb = (bf16_t*)(a.ws + WS_W);
        bf16_t* P = (bf16_t*)(a.ws + WS_P);
        for (size_t i = (size_t)bid * 512 + tid; i < (size_t)7 * MPAD; i += (size_t)G * 512) rowss[MPAD + i] = 0ull;
        if (wave == 7) {
            PH(1) for (int task = bid; task < 2 * 193; task += G) h2_features(lds + 7 * 16384, a, task / 193, (task % 193) * 64 + lane, lane);
        } else
        PH(0) {
        LAS float* scr = (LAS float*)(lds + wave * 16384);
#pragma unroll 1
        for (int j = 0; j < 2; ++j) {
            convert_matrix(a.in[6] + (size_t)j * 1024 * 3072, a.in[4] + (2 * j) * 1024, 1024, 3072, (bf16_t*)((char*)Wb + W_IN + (size_t)j * 6 * MiB), scr, gw, NGW, lane);
            convert_matrix(a.in[17] + (size_t)j * 1024 * 1024, nullptr, 1024, 1024, (bf16_t*)((char*)Wb + W_HOUT + (size_t)j * 2 * MiB), scr, gw, NGW, lane);
            convert_matrix(a.in[18] + (size_t)j * 1024 * 1536, a.in[4] + (2 * j + 1) * 1024, 1024, 1536, (bf16_t*)((char*)Wb + W_QKV + (size_t)j * 3 * MiB), scr, gw, NGW, lane);
            convert_matrix(a.in[22] + (size_t)j * 1024 * 1024, nullptr, 1024, 1024, (bf16_t*)((char*)Wb + W_AOUT + (size_t)j * 2 * MiB), scr, gw, NGW, lane);
        }
#pragma unroll 1
        for (int i = 0; i < 4; ++i) {
            convert_matrix(a.in[23] + (size_t)i * 1024 * 4096, a.in[5] + i * 1024, 1024, 4096, (bf16_t*)((char*)Wb + W_UP + (size_t)i * 8 * MiB), scr, gw, NGW, lane);
            convert_matrix(a.in[24] + (size_t)i * 4096 * 1024, nullptr, 4096, 1024, (bf16_t*)((char*)Wb + W_DN + (size_t)i * 8 * MiB), scr, gw, NGW, lane);
        }
        for (int row0 = gw; row0 < MREAL; row0 += 4 * NGW) {
            f32x4 v[4][4];
#pragma unroll
            for (int rr = 0; rr < 4; ++rr) {
                const int row = row0 + rr * NGW, rowc = row < MREAL ? row : MREAL - 1;
                const float* src = rowc < ROWS_P ? a.in[0] + (size_t)rowc * DM : (rowc < ROWS_MAIN ? a.in[1] + (size_t)(rowc - ROWS_P) * DM : a.in[2] + (size_t)((rowc - ROWS_MAIN) & 15) * DM);
#pragma unroll
                for (int k = 0; k < 4; ++k) v[rr][k] = *(const f32x4*)(src + k * 256 + lane * 4);
            }
#pragma unroll
            for (int rr = 0; rr < 4; ++rr) {
                const int row = row0 + rr * NGW;
                float ss = 0.f;
#pragma unroll
                for (int k = 0; k < 4; ++k) { const f32x4 x = v[rr][k];
                    ss += (x[0] * x[0] + x[1] * x[1]) + (x[2] * x[2] + x[3] * x[3]);
                    u32x2 pk; pk.x = cvtpk(x[0], x[1]); pk.y = cvtpk(x[2], x[3]);
                    if (row < MREAL) *(u32x2*)(P + (size_t)row * DM + k * 256 + lane * 4) = pk; }
                ss = wave_sum(ss);
                if (lane == 0 && row < MREAL) rowss[row] = (u64)(ss * SS_SCALE);
            }
        }
        }
        GRID_SYNC_CG();
    }

#pragma unroll 1
    for (int layer = layer_lo; layer < layer_hi; ++layer) {
        if ((layer & 1) == 0) {
            {
                const Args a = get_args(); const int tid = ltid(), G = lsg(G0), bid = lsg(bid0); const int j = layer >> 1;
                PH(2) fk_compute(a, j, bid * 8 + __builtin_amdgcn_readfirstlane(tid >> 6), G * 8, tid & 63);
                PH(3) {
                pg8::Gemm g{(const bf16_t*)(a.ws + WS_P), (const bf16_t*)(a.ws + WS_W + W_IN + (size_t)j * 6 * MiB), MPAD, 3072, 1024, 1024, 1024}; pg8::StaticOrder S; S.init(MPAD, 3072, G, bid);
                EpiHyIn E{(bf16_t*)(a.ws + WS_R1), (const u64*)(a.ws + WS_ROWSS) + (size_t)(2 * layer) * MPAD};
                pg8::gemm_phase<EpiHyIn>(lds, g, S, E);
                }
            }
            GRID_SYNC();
            { const Args a = get_args(); const int tid = ltid(), G = lsg(G0), bid = lsg(bid0); PH(4) conv_phase(lds, a, layer >> 1, bid, G, tid); }
            GRID_SYNC();
            { const Args a = get_args(); const int tid = ltid(), G = lsg(G0), bid = lsg(bid0); PH(5) transpose_phase(lds, a, bid, G, tid); }
            GRID_SYNC();
            {
                const Args a = get_args(); const int tid = ltid(), G = lsg(G0), bid = lsg(bid0); const int j = layer >> 1;
                PH(6) {
                pg8::Gemm g{(const bf16_t*)(a.ws + WS_R1), (const bf16_t*)(a.ws + WS_W + W_HOUT + (size_t)j * 2 * MiB), MPAD, 1024, 1024, 1024, 1024}; pg8::StaticOrder S; S.init(MPAD, 1024, G, bid);
                const EpiResid er = make_resid(a, layer, 0, 0);
                pg8::gemm_phase<EpiResid>(lds, g, S, er);
                }
            }
            GRID_SYNC();
        } else {
            {
                const Args a = get_args(); const int tid = ltid(), G = lsg(G0), bid = lsg(bid0); const int j = layer >> 1;
                PH(7) {
                pg8::Gemm g{(const bf16_t*)(a.ws + WS_P), (const bf16_t*)(a.ws + WS_W + W_QKV + (size_t)j * 3 * MiB), MPAD, 1536, 1024, 1024, 1024}; pg8::StaticOrder S; S.init(MPAD, 1536, G, bid);
                EpiRow<0> E{(bf16_t*)(a.ws + WS_R1), (bf16_t*)(a.ws + WS_VT), (const u64*)(a.ws + WS_ROWSS) + (size_t)(2 * layer) * MPAD, 0};
                pg8::gemm_phase<EpiRow<0>>(lds, g, S, E);
                }
            }
            GRID_SYNC();
            { const Args a = get_args(); const int tid = ltid(), G = lsg(G0), bid = lsg(bid0); PH(8) attn_phase(lds, a, layer >> 1, bid, G, tid); }
            GRID_SYNC();
            {
                const Args a = get_args(); const int tid = ltid(), G = lsg(G0), bid = lsg(bid0); const int j = layer >> 1;
                PH(9) {
                pg8::Gemm g{(const bf16_t*)(a.ws + WS_R3), (const bf16_t*)(a.ws + WS_W + W_AOUT + (size_t)j * 2 * MiB), MPAD, 1024, 1024, 1024, 1024}; pg8::StaticOrder S; S.init(MPAD, 1024, G, bid);
                const EpiResid er = make_resid(a, layer, 0, 0);
                pg8::gemm_phase<EpiResid>(lds, g, S, er);
                }
            }
            GRID_SYNC();
        }
#pragma unroll 1
        for (int half = 0; half < 2; ++half) {
            const int rb = half * MT_H0 * 256; const int mrows = (half == 0 ? MT_H0 : MT_H1) * 256;
            {
                const Args a = get_args(); const int tid = ltid(), G = lsg(G0), bid = lsg(bid0);
                PH(10) {
                pg8::Gemm g{(const bf16_t*)(a.ws + WS_P) + (size_t)rb * DM, (const bf16_t*)(a.ws + WS_W + W_UP + (size_t)layer * 8 * MiB), mrows, 4096, 1024, 1024, 1024}; pg8::StaticOrder S; S.init(mrows, 4096, G, bid);
                EpiRow<1> E{(bf16_t*)(a.ws + WS_R1), nullptr, (const u64*)(a.ws + WS_ROWSS) + (size_t)(2 * layer + 1) * MPAD, rb};
                pg8::gemm_phase<EpiRow<1>>(lds, g, S, E);
                }
            }
            GRID_SYNC();
            {
                const Args a = get_args(); const int tid = ltid(), G = lsg(G0), bid = lsg(bid0);
                PH(11) {
                const int drows = MT_H0 * 256;
                pg8::Gemm g{(const bf16_t*)(a.ws + WS_R1), (const bf16_t*)(a.ws + WS_W + W_DN + (size_t)layer * 8 * MiB), drows, 1024, 4096, 4096, 4096}; pg8::StaticOrder S; S.init(drows, 1024, G, bid);
                const EpiResid e2 = make_resid(a, layer, 1, rb);
                pg8::gemm_phase<EpiResid>(lds, g, S, e2);
                }
            }
            if (half == 1) {
                {
                    const Args a = get_args(); const int G = lsg(G0), bid = lsg(bid0);
                    PH(11) {
                    pg8::Gemm g2{(const bf16_t*)(a.ws + WS_R1) + (size_t)(MT_H0 * 256) * DFF, (const bf16_t*)(a.ws + WS_W + W_DN + (size_t)layer * 8 * MiB), 512, 1024, 4096 / DOWN_KS, 4096, 4096};
                    pg8::StaticOrder S2; S2.init_ks(512, 1024, DOWN_KS, G, bid);
                    EpiPartial ep{(float*)(a.ws + WS_R3)};
                    pg8::gemm_phase<EpiPartial>(lds, g2, S2, ep);
                    }
                }
                GRID_SYNC();
                const Args a = get_args(); const int tid = ltid(), G = lsg(G0), bid = lsg(bid0);
                const int nxt = 2 * layer + 2;
                meta_reduce((const float*)(a.ws + WS_R3), (float*)(a.ws + WS_METAH), nxt < 8 ? (bf16_t*)(a.ws + WS_P) : nullptr,
                            nxt < 8 ? (u64*)(a.ws + WS_ROWSS) + (size_t)nxt * MPAD : nullptr, bid * 8 + (tid >> 6), G * 8, tid & 63);
            }
            if (!(layer == layer_hi - 1 && half == 1)) GRID_SYNC();
        }
    }
}

constexpr int LDS_BYTES = 147456;
extern "C" void kernel_launch(void* const* d_in, const int* in_sizes, int n_in, void* d_out, int out_size, void* d_ws, size_t ws_size, hipStream_t stream) {
    static int grid = 0;
    if (grid == 0) {
        if (n_in != 25 || ws_size < WS_END) { fprintf(stderr, "kernel_launch: unexpected n_in %d or ws_size %zu (need %zu)\n", n_in, ws_size, (size_t)WS_END); grid = -1; return; }
        int dev = 0, cus = 0, per_cu = 0;
        (void)hipGetDevice(&dev);
        (void)hipDeviceGetAttribute(&cus, hipDeviceAttributeMultiprocessorCount, dev);
        if (hipFuncSetAttribute((const void*)fwd_megakernel, hipFuncAttributeMaxDynamicSharedMemorySize, LDS_BYTES) != hipSuccess) { fprintf(stderr, "kernel_launch: hipFuncSetAttribute failed\n"); grid = -1; return; }
        if (hipOccupancyMaxActiveBlocksPerMultiprocessor(&per_cu, (const void*)fwd_megakernel, 512, LDS_BYTES) != hipSuccess || per_cu < 1) { fprintf(stderr, "kernel_launch: occupancy query gives %d\n", per_cu); per_cu = 1; }
        (void)hipGetLastError();
        grid = cus * 1;
        fprintf(stderr, "kernel_launch: cus %d per_cu %d grid %d\n", cus, per_cu, grid);
    }
    if (grid < 0) return;
    Args a{};
    for (int i = 0; i < 25; ++i) a.in[i] = (const float*)d_in[i];
    a.out = (float*)d_out; a.ws = (unsigned char*)d_ws;
#ifndef NSPLIT
#define NSPLIT 1
#endif
    (void)hipMemsetAsync(d_ws, 0, 16384, stream);
    for (int part = 0; part < NSPLIT; ++part) {
        a.layer_lo = part * (4 / NSPLIT); a.layer_hi = (part + 1) * (4 / NSPLIT);
        void* args[] = {&a};
        hipError_t e = hipLaunchCooperativeKernel((const void*)fwd_megakernel, dim3(grid), dim3(512), args, LDS_BYTES, stream);
        if (e != hipSuccess) fprintf(stderr, "cooperative launch failed: %s (grid %d)\n", hipGetErrorString(e), grid);
    }
}
```
